# Optimizing an MI355X kernel written in HIP

```python
import math
import jax, jax.numpy as jnp
from jax import lax
import numpy as np

D_MODEL = 1024
BATCH = 4
SEQ = 8192
DEPTH = 4

N_MIXERS = 2
DA_HEADS = 8
DA_HEAD_DIM = 64
DA_V_DIM = 2 * DA_HEAD_DIM
DA_Q_BLOCK = 128
DA_LAMBDA_STD = 0.1
RET_HEADS = 4
RET_QK_DIM = D_MODEL // RET_HEADS
RET_V_DIM = 2 * RET_QK_DIM
RET_CHUNK = 128
N_EXPERTS = 32
TOP_K = 4
D_FF = D_MODEL
SWIGLU_LIMIT = 7.0
SWIGLU_ALPHA = 1.702
MOE_BLOCK = 128
ROUTER_BIAS_STD = 0.01
LN_EPS = 1e-5
DEEPNORM_ALPHA = (2.0 * DEPTH) ** 0.25
DEEPNORM_BETA = (8.0 * DEPTH) ** -0.25
N_DA_LAYERS = (DEPTH + 1) // 2
N_RET_LAYERS = DEPTH // 2

kernel_name = "hybrid_diffattn_retnet_moe_deepnorm"


def layer_norm(x, g, b):
    xf = x.astype(jnp.float32)
    mu = jnp.mean(xf, axis=-1, keepdims=True)
    var = jnp.mean(jnp.square(xf - mu), axis=-1, keepdims=True)
    return ((xf - mu) * lax.rsqrt(var + LN_EPS)).astype(x.dtype) * g + b


def group_norm_no_affine(x):
    xf = x.astype(jnp.float32)
    mu = jnp.mean(xf, axis=-1, keepdims=True)
    var = jnp.mean(jnp.square(xf - mu), axis=-1, keepdims=True)
    return (xf - mu) * lax.rsqrt(var + LN_EPS)


def rms_norm(x, g):
    xf = x.astype(jnp.float32)
    ms = jnp.mean(jnp.square(xf), axis=-1, keepdims=True)
    return (xf * lax.rsqrt(ms + LN_EPS)).astype(x.dtype) * g


def alibi_slopes(n_heads):
    return jnp.asarray(2.0 ** (-8.0 * np.arange(1, n_heads + 1) / n_heads), dtype=jnp.float32)


def diff_attention(x, w_in, w_out, lam_q1, lam_k1, lam_q2, lam_k2, subln_g, lambda_init):
    B, S, _ = x.shape
    H, dh, dv, QB = DA_HEADS, DA_HEAD_DIM, DA_V_DIM, DA_Q_BLOCK
    nq = S // QB
    qkv = x @ w_in
    q, k, v = jnp.split(qkv, 3, axis=-1)
    q = q.reshape(B, S, H, 2, dh) * (dh ** -0.5)
    k = k.reshape(B, S, H, 2, dh)
    v = v.reshape(B, S, H, dv)
    lam = (jnp.exp(jnp.sum(lam_q1 * lam_k1).astype(jnp.float32))
           - jnp.exp(jnp.sum(lam_q2 * lam_k2).astype(jnp.float32)) + lambda_init)
    slopes = alibi_slopes(H)[:, None, None, None]
    key_pos = jnp.arange(S)
    q_blocks = jnp.moveaxis(q.reshape(B, nq, QB, H, 2, dh), 1, 0)

    def one_block(args):
        qb, blk = args
        q_pos = blk * QB + jnp.arange(QB)
        s = jnp.einsum('bqhmd,bkhmd->bhmqk', qb, k).astype(jnp.float32)
        dist = (q_pos[:, None] - key_pos[None, :]).astype(jnp.float32)
        bias = jnp.where(dist >= 0, -slopes * dist, -jnp.inf)
        p = jax.nn.softmax(s + bias[None], axis=-1)
        a = p[:, :, 0] - lam * p[:, :, 1]
        return jnp.einsum('bhqk,bkhd->bqhd', a.astype(v.dtype), v)

    o = lax.map(one_block, (q_blocks, jnp.arange(nq)))
    o = jnp.moveaxis(o, 0, 1).reshape(B, S, H, dv)
    o = rms_norm(o, subln_g) * (1.0 - lambda_init)
    return o.reshape(B, S, H * dv) @ w_out


def retention(x, w_in, w_out):
    B, S, _ = x.shape
    H, dk, dv, C = RET_HEADS, RET_QK_DIM, RET_V_DIM, RET_CHUNK
    n = S // C
    proj = x @ w_in
    q, k, v, g = jnp.split(proj, [H * dk, 2 * H * dk, 2 * H * dk + H * dv], axis=-1)
    q = q.reshape(B, n, C, H, dk)
    k = k.reshape(B, n, C, H, dk) * (dk ** -0.5)
    v = v.reshape(B, n, C, H, dv)
    log_gamma = jnp.log1p(-jnp.exp2(-5.0 - jnp.arange(H, dtype=jnp.float32)))
    pos = jnp.arange(C, dtype=jnp.float32)
    diff = pos[:, None] - pos[None, :]
    decay_mask = jnp.where(diff >= 0, jnp.exp(log_gamma[:, None, None] * jnp.maximum(diff, 0.0)), 0.0)
    sc = jnp.einsum('bnqhd,bnkhd->bnhqk', q, k) * decay_mask[None, None]
    inner = jnp.einsum('bnhqk,bnkhe->bnqhe', sc, v)
    q_decay = jnp.exp(log_gamma[None, :] * (pos[:, None] + 1.0))
    k_decay = jnp.exp(log_gamma[None, :] * (C - 1.0 - pos[:, None]))
    chunk_decay = jnp.exp(log_gamma * C)

    def step(state, inp):
        qc, kc, vc = inp
        cross = jnp.einsum('bqhd,bhde->bqhe', qc, state) * q_decay[None, :, :, None]
        state = (state * chunk_decay[None, :, None, None]
                 + jnp.einsum('bkhd,bkhe->bhde', kc * k_decay[None, :, :, None], vc))
        return state, cross

    init = jnp.zeros((B, H, dk, dv), jnp.float32)
    _, cross = lax.scan(step, init, (jnp.moveaxis(q, 1, 0), jnp.moveaxis(k, 1, 0), jnp.moveaxis(v, 1, 0)))
    o = inner + jnp.moveaxis(cross, 0, 1)
    o = group_norm_no_affine(o.reshape(B, S, H, dv)).astype(x.dtype)
    o = jax.nn.silu(g) * o.reshape(B, S, H * dv)
    return o @ w_out


def moe(x, w_router, b_router, w_gate_up, b_gate_up, w_down, b_down):
    B, S, D = x.shape
    T = B * S
    E, BLK = N_EXPERTS, MOE_BLOCK
    xt = x.reshape(T, D)
    logits = (xt @ w_router + b_router).astype(jnp.float32)
    top_vals, top_idx = lax.top_k(logits, TOP_K)
    top_w = jax.nn.softmax(top_vals, axis=-1)
    n_assign = T * TOP_K
    expert_of = top_idx.reshape(-1).astype(jnp.int32)
    token_of = jnp.arange(n_assign, dtype=jnp.int32) // TOP_K
    gate_of = top_w.reshape(-1)
    order = jnp.argsort(expert_of)
    sorted_expert = expert_of[order]
    counts = jnp.zeros((E,), jnp.int32).at[expert_of].add(1)
    group_start = jnp.cumsum(counts) - counts
    padded = (counts + BLK - 1) // BLK * BLK
    padded_end = jnp.cumsum(padded)
    padded_start = padded_end - padded
    rank = jnp.arange(n_assign, dtype=jnp.int32) - group_start[sorted_expert]
    dest = padded_start[sorted_expert] + rank
    n_slots = n_assign + E * BLK
    n_blocks = n_slots // BLK
    slot_token = jnp.zeros((n_slots,), jnp.int32).at[dest].set(token_of[order])
    slot_gate = jnp.zeros((n_slots,), jnp.float32).at[dest].set(gate_of[order])
    block_expert = jnp.minimum(
        jnp.searchsorted(padded_end, jnp.arange(n_blocks, dtype=jnp.int32) * BLK, side='right'), E - 1)
    x_slots = xt[slot_token].reshape(n_blocks, BLK, D)

    def expert_block(args):
        xb, e = args
        h = xb @ w_gate_up[e] + b_gate_up[e]
        gate, up = jnp.split(h, 2, axis=-1)
        gate = jnp.minimum(gate, SWIGLU_LIMIT)
        up = jnp.clip(up, -SWIGLU_LIMIT, SWIGLU_LIMIT)
        act = gate * jax.nn.sigmoid(SWIGLU_ALPHA * gate) * (up + 1.0)
        return act @ w_down[e] + b_down[e]

    y_slots = lax.map(expert_block, (x_slots, block_expert)).reshape(n_slots, D)
    y = jax.ops.segment_sum(y_slots * slot_gate[:, None].astype(y_slots.dtype), slot_token, num_segments=T)
    return y.reshape(B, S, D)


def setup_inputs(seed: int = 0) -> dict:
    key = jax.random.key(seed)
    ks = jax.random.split(key, 24)
    f32 = jnp.float32
    D, F, E = D_MODEL, D_FF, N_EXPERTS
    nrm = lambda k, shape, s: jax.random.normal(k, shape, f32) * s
    x = nrm(ks[0], (BATCH, SEQ, D), 1.0)
    da_qk = nrm(ks[1], (N_DA_LAYERS, D, 2 * DA_HEADS * 2 * DA_HEAD_DIM), D ** -0.5)
    da_v = nrm(ks[2], (N_DA_LAYERS, D, DA_HEADS * DA_V_DIM), D ** -0.5 * DEEPNORM_BETA)
    da_w_in = jnp.concatenate([da_qk, da_v], axis=-1)
    da_w_out = nrm(ks[3], (N_DA_LAYERS, DA_HEADS * DA_V_DIM, D), (DA_HEADS * DA_V_DIM) ** -0.5 * DEEPNORM_BETA)
    da_lam_q1 = nrm(ks[4], (N_DA_LAYERS, DA_HEAD_DIM), DA_LAMBDA_STD)
    da_lam_k1 = nrm(ks[5], (N_DA_LAYERS, DA_HEAD_DIM), DA_LAMBDA_STD)
    da_lam_q2 = nrm(ks[6], (N_DA_LAYERS, DA_HEAD_DIM), DA_LAMBDA_STD)
    da_lam_k2 = nrm(ks[7], (N_DA_LAYERS, DA_HEAD_DIM), DA_LAMBDA_STD)
    da_subln_g = 1.0 + nrm(ks[8], (N_DA_LAYERS, DA_V_DIM), 0.02)
    ret_qk = nrm(ks[9], (N_RET_LAYERS, D, 2 * RET_HEADS * RET_QK_DIM), D ** -0.5)
    ret_v = nrm(ks[10], (N_RET_LAYERS, D, RET_HEADS * RET_V_DIM), D ** -0.5 * DEEPNORM_BETA)
    ret_g = nrm(ks[11], (N_RET_LAYERS, D, RET_HEADS * RET_V_DIM), D ** -0.5)
    ret_w_in = jnp.concatenate([ret_qk, ret_v, ret_g], axis=-1)
    ret_w_out = nrm(ks[12], (N_RET_LAYERS, RET_HEADS * RET_V_DIM, D), (RET_HEADS * RET_V_DIM) ** -0.5 * DEEPNORM_BETA)
    moe_w_router = nrm(ks[13], (DEPTH, D, E), D ** -0.5)
    moe_b_router = nrm(ks[14], (DEPTH, E), ROUTER_BIAS_STD)
    moe_w_gate_up = nrm(ks[15], (DEPTH, E, D, 2 * F), D ** -0.5)
    moe_b_gate_up = nrm(ks[16], (DEPTH, E, 2 * F), 0.01)
    moe_w_down = nrm(ks[17], (DEPTH, E, F, D), F ** -0.5 * DEEPNORM_BETA)
    moe_b_down = nrm(ks[18], (DEPTH, E, D), 0.01)
    ln_mix_g = 1.0 + nrm(ks[19], (DEPTH, D), 0.02)
    ln_mix_b = nrm(ks[20], (DEPTH, D), 0.02)
    ln_ffn_g = 1.0 + nrm(ks[21], (DEPTH, D), 0.02)
    ln_ffn_b = nrm(ks[22], (DEPTH, D), 0.02)
    return {"x": x, "da_w_in": da_w_in, "da_w_out": da_w_out,
            "da_lam_q1": da_lam_q1, "da_lam_k1": da_lam_k1, "da_lam_q2": da_lam_q2, "da_lam_k2": da_lam_k2,
            "da_subln_g": da_subln_g, "ret_w_in": ret_w_in, "ret_w_out": ret_w_out,
            "moe_w_router": moe_w_router, "moe_b_router": moe_b_router,
            "moe_w_gate_up": moe_w_gate_up, "moe_b_gate_up": moe_b_gate_up,
            "moe_w_down": moe_w_down, "moe_b_down": moe_b_down,
            "ln_mix_g": ln_mix_g, "ln_mix_b": ln_mix_b, "ln_ffn_g": ln_ffn_g, "ln_ffn_b": ln_ffn_b}


def reference(x, da_w_in, da_w_out, da_lam_q1, da_lam_k1, da_lam_q2, da_lam_k2, da_subln_g,
              ret_w_in, ret_w_out, moe_w_router, moe_b_router, moe_w_gate_up, moe_b_gate_up,
              moe_w_down, moe_b_down, ln_mix_g, ln_mix_b, ln_ffn_g, ln_ffn_b):
    for i in range(DEPTH):
        j = i // N_MIXERS
        if i % N_MIXERS == 0:
            lambda_init = 0.8 - 0.6 * math.exp(-0.3 * i)
            h = diff_attention(x, da_w_in[j], da_w_out[j], da_lam_q1[j], da_lam_k1[j],
                               da_lam_q2[j], da_lam_k2[j], da_subln_g[j], lambda_init)
        else:
            h = retention(x, ret_w_in[j], ret_w_out[j])
        x = layer_norm(DEEPNORM_ALPHA * x + h, ln_mix_g[i], ln_mix_b[i])
        f = moe(x, moe_w_router[i], moe_b_router[i], moe_w_gate_up[i], moe_b_gate_up[i],
                moe_w_down[i], moe_b_down[i])
        x = layer_norm(DEEPNORM_ALPHA * x + f, ln_ffn_g[i], ln_ffn_b[i])
    return x
```

```cpp
#include <hip/hip_runtime.h>
#include <cstdio>
#include <cstdint>
constexpr int WAVETBL_OFF = 147456 - 256;
__device__ __forceinline__ int hw_tid(__attribute__((address_space(3))) unsigned char* lds0) {
    const int slot = (int)__builtin_amdgcn_s_getreg((5 << 11) | 4) & 63;
    const int wave = __builtin_amdgcn_readfirstlane(*(const __attribute__((address_space(3))) int*)(lds0 + WAVETBL_OFF + slot * 4));
    unsigned z = 0u; asm volatile("" : "+v"(z));
    int t = wave * 64 + (int)__builtin_amdgcn_mbcnt_hi(~0u, __builtin_amdgcn_mbcnt_lo(~0u, z));
    asm volatile("" : "+v"(t)); return t; }
template <int CTRL> __device__ __forceinline__ float dppf(float v) { return __builtin_bit_cast(float, __builtin_amdgcn_update_dpp(0, __builtin_bit_cast(int, v), CTRL, 0xF, 0xF, true)); }
__device__ __forceinline__ float swap16_other(float v, float& self) { float w; asm volatile("s_nop 1\n\tv_permlane16_swap_b32 %0, %1" : "=v"(w), "+v"(v) : "0"(v)); self = v; return w; }
__device__ __forceinline__ float swap32_other(float v, float& self) { float w; asm volatile("s_nop 1\n\tv_permlane32_swap_b32 %0, %1" : "=v"(w), "+v"(v) : "0"(v)); self = v; return w; }
__device__ __forceinline__ float row_sum16(float v) { v += dppf<0xB1>(v); v += dppf<0x4E>(v); v += dppf<0x141>(v); v += dppf<0x140>(v); return v; }
__device__ __forceinline__ float row_max16(float v) { v = __builtin_fmaxf(v, dppf<0xB1>(v)); v = __builtin_fmaxf(v, dppf<0x4E>(v)); v = __builtin_fmaxf(v, dppf<0x141>(v)); v = __builtin_fmaxf(v, dppf<0x140>(v)); return v; }
__device__ __forceinline__ float half_sum32(float v) { v = row_sum16(v); float a; const float b = swap16_other(v, a); return a + b; }
__device__ __forceinline__ float half_max32(float v) { v = row_max16(v); float a; const float b = swap16_other(v, a); return __builtin_fmaxf(a, b); }
__device__ __forceinline__ float wave_sum(float v) { v = half_sum32(v); float a; const float b = swap32_other(v, a); return a + b; }
__device__ __forceinline__ float wave_max(float v) { v = half_max32(v); float a; const float b = swap32_other(v, a); return __builtin_fmaxf(a, b); }
__device__ __forceinline__ float xor32_sum(float v) { float a; const float b = swap32_other(v, a); return a + b; }
__device__ __forceinline__ float xor32_max(float v) { float a; const float b = swap32_other(v, a); return __builtin_fmaxf(a, b); }
__device__ __forceinline__ float xor16_sum(float v) { float a; const float b = swap16_other(v, a); return a + b; }
namespace pg8 {
#define PG8_LAS __attribute__((address_space(3)))
typedef unsigned short bf16_t;
typedef short bf16x8 __attribute__((ext_vector_type(8)));
typedef float f32x4 __attribute__((ext_vector_type(4)));
typedef unsigned u32x4 __attribute__((ext_vector_type(4)));
constexpr int BM = 256, BK = 64, HALF = 128, HTB = HALF * BK * 2  , STAGE_BYTES = 8 * HTB, NXCD = 8, WGM = 4;

__host__ __device__ __forceinline__ int lds_byte(int r, int c) { const int st = (r >> 4) * 2 + (c >> 5), rr = r & 15, cc = c & 31, ob = rr * 64 + cc * 2; return st * 1024 + (ob ^ (((ob >> 9) & 1) << 5)); }
__host__ __device__ __forceinline__ void stage_rc(int b, int& R, int& C) { const int st = b / 1024, sb = b % 1024, swz = sb ^ (((sb >> 9) & 1) << 5); R = (st >> 1) * 16 + swz / 64; C = (st & 1) * 32 + (swz % 64) / 2; }
__host__ __device__ __forceinline__ int perm32(int rho) { const int n = rho >> 4, i = rho & 15; return 8 * (i >> 2) + 4 * n + (i & 3); }

struct Unit { int pm, pn, pb, aux, rows, lt; };
struct Gemm { const bf16_t* A; const bf16_t* Bt; int M, N, K; };

struct StaticOrder {
    int nM, nN, nwg, G, c;
    __host__ __device__ void init(int M, int N, int G_, int c_) { nM = M / BM; nN = N / BM; nwg = nM * nN; G = G_; c = c_; }
    __host__ __device__ bool next(int i, Unit& u) const {
        const long L = (long)i * G + c; if (L >= nwg) return false;
        int wgid = (int)L; { const int q = nwg / NXCD, r = nwg % NXCD, xcd = wgid % NXCD, off = wgid / NXCD; wgid = (xcd < r ? xcd * (q + 1) : r * (q + 1) + (xcd - r) * q) + off; }
        const int nig = WGM * nN, gid = wgid / nig, fm = gid * WGM, gsz = (nM - fm) < WGM ? (nM - fm) : WGM;
        u.pm = fm + ((wgid % nig) % gsz); u.pn = (wgid % nig) / gsz; u.pb = u.pn; u.aux = 0; u.rows = BM; u.lt = 0; return true;
    }
    __device__ __forceinline__ void a_ready(const Unit&) const {}
    __device__ __forceinline__ void done(const Unit&) const {}
};

__device__ __forceinline__ unsigned cvt_pk_bf16(float lo, float hi) { unsigned r; asm volatile("v_cvt_pk_bf16_f32 %0, %1, %2" : "=v"(r) : "v"(lo), "v"(hi)); return r; }
__device__ __forceinline__ u32x4 pack8(const f32x4 v0, const f32x4 v1) { u32x4 w; w.x = cvt_pk_bf16(v0[0], v0[1]); w.y = cvt_pk_bf16(v0[2], v0[3]); w.z = cvt_pk_bf16(v1[0], v1[1]); w.w = cvt_pk_bf16(v1[2], v1[3]); return w; }

struct EpiScaleBf16 {
    static constexpr bool PERM = true, AFTER_DRAIN = false;
    struct Pre {}; __device__ __forceinline__ void preload(Pre&, const Unit&, int, int, int, int) const {}
    __device__ __forceinline__ void init(f32x4 (&acc)[2][2][4][2], const Pre&) const {
#pragma unroll
        for (int a = 0; a < 2; ++a)
#pragma unroll
            for (int b = 0; b < 2; ++b)
#pragma unroll
                for (int m = 0; m < 4; ++m)
#pragma unroll
                    for (int n = 0; n < 2; ++n) acc[a][b][m][n] = (f32x4){0.f, 0.f, 0.f, 0.f}; }
    bf16_t* O; int ldc; int qcols; float qscale; unsigned* kmax;
    __device__ __forceinline__ void operator()(const f32x4 (&acc)[2][2][4][2], const Unit& u, int wr, int wc, int fr, int fq) const {
        const int row0 = u.pm * BM + wr * 64 + fr, col0 = u.pn * BM + wc * 32 + 8 * fq;
        if (u.pn >= 4 && u.pn < 8) {
#pragma unroll
            for (int bj = 0; bj < 2; ++bj) { float mx = 0.f;
#pragma unroll
                for (int ai = 0; ai < 2; ++ai)
#pragma unroll
                    for (int m = 0; m < 4; ++m) { const f32x4 a = acc[ai][bj][m][0], c = acc[ai][bj][m][1];
                        float ss = (a[0] * a[0] + a[1] * a[1]) + (a[2] * a[2] + a[3] * a[3]) + (c[0] * c[0] + c[1] * c[1]) + (c[2] * c[2] + c[3] * c[3]);
                        ss = xor32_sum(xor16_sum(ss)); mx = __builtin_fmaxf(mx, ss); }
                mx = row_max16(mx);
                if (fr == 0 && fq == 0) { const int b = u.pm >> 5, hm = (u.pn - 4) * 4 + bj * 2 + (wc >> 1);
                    __hip_atomic_fetch_max(kmax + ((b * 16 + hm) * 2 + (wc & 1)), __builtin_bit_cast(unsigned, mx), __ATOMIC_RELAXED, __HIP_MEMORY_SCOPE_AGENT); } }
        }
#pragma unroll
        for (int ai = 0; ai < 2; ++ai)
#pragma unroll
            for (int m = 0; m < 4; ++m) { bf16_t* rowp = O + (size_t)(row0 + ai * HALF + m * 16) * ldc + col0;
#pragma unroll
                for (int bj = 0; bj < 2; ++bj) { const float sc = (col0 + bj * HALF) < qcols ? qscale : 1.f;
                    *(u32x4*)(rowp + bj * HALF) = pack8(acc[ai][bj][m][0] * sc, acc[ai][bj][m][1] * sc); } }
    }
};

struct EpiRetProj {
    static constexpr bool PERM = true, AFTER_DRAIN = false;
    struct Pre {}; __device__ __forceinline__ void preload(Pre&, const Unit&, int, int, int, int) const {}
    __device__ __forceinline__ void init(f32x4 (&acc)[2][2][4][2], const Pre&) const {
#pragma unroll
        for (int a = 0; a < 2; ++a)
#pragma unroll
            for (int b = 0; b < 2; ++b)
#pragma unroll
                for (int m = 0; m < 4; ++m)
#pragma unroll
                    for (int n = 0; n < 2; ++n) acc[a][b][m][n] = (f32x4){0.f, 0.f, 0.f, 0.f}; }
    bf16_t* O; int ldc; float lg2[4];
    __device__ __forceinline__ void operator()(const f32x4 (&acc)[2][2][4][2], const Unit& u, int wr, int wc, int fr, int fq) const {
        const int row0 = u.pm * BM + wr * 64 + fr, cl = wc * 32 + 8 * fq;
#pragma unroll
        for (int bj = 0; bj < 2; ++bj) {
            const int c0 = u.pn * BM + bj * HALF, sect = c0 >> 10;
            int head, width, colh; size_t base;
            if (sect < 2) { head = (c0 >> 8) & 3; width = 256; colh = (c0 & 255) + cl; base = (size_t)sect * 33554432; }
            else if (sect < 4) { head = (c0 - 2048) >> 9; width = 512; colh = ((c0 - 2048) & 511) + cl; base = (size_t)2 * 33554432; }
            else { head = (c0 - 4096) >> 9; width = 512; colh = ((c0 - 4096) & 511) + cl; base = (size_t)4 * 33554432; }
            const float lg = head == 0 ? lg2[0] : head == 1 ? lg2[1] : head == 2 ? lg2[2] : lg2[3];
#pragma unroll
            for (int ai = 0; ai < 2; ++ai)
#pragma unroll
                for (int m = 0; m < 4; ++m) { const int row = row0 + ai * HALF + m * 16; const float jp = (float)((row & 127) + 1);
                    float sc = 1.f; if (sect == 0) sc = __builtin_amdgcn_exp2f(jp * lg); else if (sect == 1) sc = 0.0625f * __builtin_amdgcn_exp2f(-jp * lg);
                    const size_t off = base + ((size_t)(((row >> 13) * 4 + head) * 8192 + (row & 8191))) * width + colh;
                    *(u32x4*)(O + off) = pack8(acc[ai][bj][m][0] * sc, acc[ai][bj][m][1] * sc); } }
    }
};

struct EpiRes {
    static constexpr bool PERM = false, AFTER_DRAIN = false;
    struct Pre {}; __device__ __forceinline__ void preload(Pre&, const Unit&, int, int, int, int) const {}
    __device__ __forceinline__ void init(f32x4 (&acc)[2][2][4][2], const Pre&) const {
#pragma unroll
        for (int a = 0; a < 2; ++a)
#pragma unroll
            for (int b = 0; b < 2; ++b)
#pragma unroll
                for (int m = 0; m < 4; ++m)
#pragma unroll
                    for (int n = 0; n < 2; ++n) acc[a][b][m][n] = (f32x4){0.f, 0.f, 0.f, 0.f}; }
    const bf16_t* XB; bf16_t* Y; int ldc; float alpha; float* STATS;
    __device__ __forceinline__ void operator()(const f32x4 (&acc)[2][2][4][2], const Unit& u, int wr, int wc, int fr, int fq) const {
        typedef unsigned u32x2 __attribute__((ext_vector_type(2)));
        const int row0 = u.pm * BM + wr * 64 + fr, col0 = u.pn * BM + wc * 32 + 4 * fq;
        u32x2 xr[2][4][2][2];
#pragma unroll
        for (int ai = 0; ai < 2; ++ai)
#pragma unroll
            for (int m = 0; m < 4; ++m) { const size_t off = (size_t)(row0 + ai * HALF + m * 16) * ldc + col0;
#pragma unroll
                for (int bj = 0; bj < 2; ++bj)
#pragma unroll
                    for (int n = 0; n < 2; ++n) xr[ai][m][bj][n] = *(const u32x2*)(XB + off + bj * HALF + n * 16); }
        __builtin_amdgcn_sched_barrier(0);
#pragma unroll
        for (int ai = 0; ai < 2; ++ai)
#pragma unroll
            for (int m = 0; m < 4; ++m) { const size_t off = (size_t)(row0 + ai * HALF + m * 16) * ldc + col0; float s1 = 0.f, s2 = 0.f;
#pragma unroll
                for (int bj = 0; bj < 2; ++bj)
#pragma unroll
                    for (int n = 0; n < 2; ++n) { const u32x2 xw = xr[ai][m][bj][n];
                        const f32x4 x = (f32x4){__builtin_bit_cast(float, xw.x << 16), __builtin_bit_cast(float, xw.x & 0xffff0000u), __builtin_bit_cast(float, xw.y << 16), __builtin_bit_cast(float, xw.y & 0xffff0000u)};
                        const f32x4 y = x * alpha + acc[ai][bj][m][n]; { u32x2 yw; yw.x = cvt_pk_bf16(y[0], y[1]); yw.y = cvt_pk_bf16(y[2], y[3]); *(u32x2*)(Y + off + bj * HALF + n * 16) = yw; }
                        s1 += (y[0] + y[1]) + (y[2] + y[3]); s2 += (y[0] * y[0] + y[1] * y[1]) + (y[2] * y[2] + y[3] * y[3]); }
                s1 = xor32_sum(xor16_sum(s1)); s2 = xor32_sum(xor16_sum(s2));
                if (fq == 0) { typedef float f32x2s __attribute__((ext_vector_type(2))); *(f32x2s*)(STATS + ((size_t)(row0 + ai * HALF + m * 16) * 16 + u.pn * 4 + wc) * 2) = (f32x2s){s1, s2}; } }
    }
};

struct EpiSwiGLU {
    static constexpr bool PERM = true, AFTER_DRAIN = false;
    bf16_t* ACT; const float* bgu;
    struct Pre { f32x4 v[4]; };
    __device__ __forceinline__ void preload(Pre& p, const Unit& u, int wr, int wc, int fr, int fq) const {
        const float* be = bgu + (size_t)u.aux * 2048 + u.pn * HALF + wc * 32 + 8 * fq;
        p.v[0] = *(const f32x4*)(be); p.v[1] = *(const f32x4*)(be + 4); p.v[2] = *(const f32x4*)(be + 1024); p.v[3] = *(const f32x4*)(be + 1028); }
    __device__ __forceinline__ void init(f32x4 (&acc)[2][2][4][2], const Pre& p) const {
#pragma unroll
        for (int a = 0; a < 2; ++a)
#pragma unroll
            for (int m = 0; m < 4; ++m) { acc[a][0][m][0] = p.v[0]; acc[a][0][m][1] = p.v[1]; acc[a][1][m][0] = p.v[2]; acc[a][1][m][1] = p.v[3]; } }
    __device__ __forceinline__ void operator()(const f32x4 (&acc)[2][2][4][2], const Unit& u, int wr, int wc, int fr, int fq) const {
        const int row0 = u.pm * BM + wr * 64 + fr, f0 = u.pn * HALF + wc * 32 + 8 * fq;
#pragma unroll
        for (int ai = 0; ai < 2; ++ai)
#pragma unroll
            for (int m = 0; m < 4; ++m) {
                f32x4 o[2];
#pragma unroll
                for (int n = 0; n < 2; ++n) { const f32x4 g4 = acc[ai][0][m][n], u4 = acc[ai][1][m][n];
#pragma unroll
                    for (int i = 0; i < 4; i += 2) {
                        typedef float f32x2p __attribute__((ext_vector_type(2)));
                        const f32x2p g = {__builtin_amdgcn_fmed3f(g4[i], -3.0e38f, 7.0f), __builtin_amdgcn_fmed3f(g4[i + 1], -3.0e38f, 7.0f)}, up = {__builtin_amdgcn_fmed3f(u4[i], -7.0f, 7.0f), __builtin_amdgcn_fmed3f(u4[i + 1], -7.0f, 7.0f)};
                        const f32x2p a = g * (f32x2p){-1.702f * 1.4426950408889634f, -1.702f * 1.4426950408889634f};
                        const f32x2p d = (f32x2p){__builtin_amdgcn_exp2f(a.x), __builtin_amdgcn_exp2f(a.y)} + (f32x2p){1.0f, 1.0f};
                        const f32x2p t = g * (f32x2p){__builtin_amdgcn_rcpf(d.x), __builtin_amdgcn_rcpf(d.y)};
                        const f32x2p r = __builtin_elementwise_fma(t, up, t); o[n][i] = r.x; o[n][i + 1] = r.y; } }
                *(u32x4*)(ACT + (size_t)(row0 + ai * HALF + m * 16) * 1024 + f0) = pack8(o[0], o[1]); }
    }
};

constexpr int GCAP_SLOTS = 32768;
struct EpiDown {
    static constexpr bool PERM = true, AFTER_DRAIN = false;
    struct Pre { f32x4 v[4]; };
    __device__ __forceinline__ void preload(Pre& p, const Unit& u, int wr, int wc, int fr, int fq) const {
        const float* be = bd + (size_t)u.aux * 1024 + u.pn * BM + wc * 32 + 8 * fq;
        p.v[0] = *(const f32x4*)(be); p.v[1] = *(const f32x4*)(be + 4); p.v[2] = *(const f32x4*)(be + HALF); p.v[3] = *(const f32x4*)(be + HALF + 4); }
    __device__ __forceinline__ void init(f32x4 (&acc)[2][2][4][2], const Pre& p) const {
#pragma unroll
        for (int bj = 0; bj < 2; ++bj)
#pragma unroll
            for (int a = 0; a < 2; ++a)
#pragma unroll
                for (int m = 0; m < 4; ++m) { acc[a][bj][m][0] = p.v[2 * bj]; acc[a][bj][m][1] = p.v[2 * bj + 1]; } }
    bf16_t* YE; const float* bd; const int2* SLOT; int dummy_row;
    __device__ __forceinline__ void operator()(const f32x4 (&acc)[2][2][4][2], const Unit& u, int wr, int wc, int fr, int fq) const {
        int rl0 = wr * 64 + fr; asm volatile("" : "+v"(rl0));
        const int col0 = u.pn * BM + wc * 32 + 8 * fq;
        int2 sr[2][4];
#pragma unroll
        for (int ai = 0; ai < 2; ++ai)
#pragma unroll
            for (int m = 0; m < 4; ++m) { const int rl = rl0 + ai * HALF + m * 16;
                sr[ai][m] = SLOT[(size_t)u.aux * GCAP_SLOTS + (size_t)u.lt * BM + (rl < u.rows ? rl : 0)]; }
        __builtin_amdgcn_sched_barrier(0);
#pragma unroll
        for (int ai = 0; ai < 2; ++ai)
#pragma unroll
            for (int m = 0; m < 4; ++m) { const int rl = rl0 + ai * HALF + m * 16; const bool ok = rl < u.rows;
                const int2 s = sr[ai][m]; const float w = __int_as_float(s.y); bf16_t* rowp = YE + (size_t)(ok ? s.x : dummy_row) * 1024 + col0;
#pragma unroll
                for (int bj = 0; bj < 2; ++bj) *(u32x4*)(rowp + bj * HALF) = pack8(acc[ai][bj][m][0] * w, acc[ai][bj][m][1] * w); }
    }
};

constexpr int GCAP = GCAP_SLOTS;
template <class Epi, class Sched, bool ALIGN_EPI = false, bool SP2 = false, bool GATHER = false>
__device__ __forceinline__ void gemm_phase(PG8_LAS unsigned char* lds, const Gemm g, const Sched& S, const Epi& E, const int2* gslot = nullptr, PG8_LAS unsigned char* gtab = nullptr) {
    static_assert(!GATHER || SP2, "the gather path is written for the SP2 loop only");
    const int tid = hw_tid(lds); const int wid = __builtin_amdgcn_readfirstlane(tid >> 6), lane = tid & 63, wr = wid >> 2, wc = wid & 3, fr = lane & 15, fq = lane >> 4;
    const int K = g.K, nt = K / BK;
    unsigned voffA[2], voffB[2];
#pragma unroll
    for (int i = 0; i < 2; ++i) { int R, C; stage_rc(tid * 16 + i * 8192, R, C); const int Rb = Epi::PERM ? ((R & ~31) + perm32(R & 31)) : R;
        voffA[i] = (unsigned)(R * K + C) * 2u; voffB[i] = (unsigned)(Rb * K + C) * 2u; }
    unsigned vC[2][2], vN[2][2]; int grl[2]; unsigned gcb[2];
#pragma unroll
    for (int i = 0; i < 2; ++i) { int R, C; stage_rc(tid * 16 + i * 8192, R, C); grl[i] = R; gcb[i] = (unsigned)C * 2u; }
#pragma unroll
    for (int h = 0; h < 2; ++h)
#pragma unroll
        for (int i = 0; i < 2; ++i) { vC[h][i] = 0u; vN[h][i] = 0u; }
#define PG8_GDMA(u, par) do { int gl_ = lane; asm volatile("" : "+v"(gl_));        \
        if (wid < 2) __builtin_amdgcn_global_load_lds((const unsigned*)((const char*)gslot + ((size_t)(u).aux * GCAP + (size_t)(u).lt * 256) * 8 + (size_t)(wid * 64 + gl_) * 16), \
        (PG8_LAS unsigned*)(gtab + (par) * 2048 + wid * 1024), 16, 0, 0); } while (0)
#define PG8_GREAD(dst, u, par) do { _Pragma("unroll") for (int h_ = 0; h_ < 2; ++h_) _Pragma("unroll") for (int i_ = 0; i_ < 2; ++i_) { const int rl_ = 128 * h_ + grl[i_]; \
        const int tk_ = *(const PG8_LAS int*)(gtab + (par) * 2048 + rl_ * 8); const unsigned tok_ = (rl_ < (u).rows) ? ((unsigned)tk_ >> 2) : 0u; dst[h_][i_] = tok_ * (unsigned)(K * 2) + gcb[i_]; } } while (0)
#define PG8_AH(h) (GATHER ? (size_t)0 : (size_t)(h) * hstep)
#define PG8_VA(arr, h) (GATHER ? arr[h] : voffA)
    const size_t kstep = (size_t)(BK * 2);
    const size_t hstep = (size_t)HALF * K * 2;
    const size_t tstep = 2 * hstep;
    const unsigned ldsw = (unsigned)wid * 1024u;
    const int aoff = lds_byte(wr * 64 + fr, fq * 8), boff = lds_byte(wc * 32 + fr, fq * 8);
#define PG8_SA(b, h) (((b) * 2 + (h)) * HTB)
#define PG8_SB(b, h) ((4 + (b) * 2 + (h)) * HTB)
#define PG8_STAGE(bufoff, gbase, voff) do { _Pragma("unroll") for (int _i = 0; _i < 2; ++_i) \
        __builtin_amdgcn_global_load_lds((const unsigned*)((const char*)(gbase) + (voff)[_i]), (PG8_LAS unsigned*)(lds + (bufoff) + ldsw + _i * 8192), 16, 0, 0); } while (0)
#define PG8_LDA(dst, b, h) do { _Pragma("unroll") for (int m = 0; m < 4; ++m) _Pragma("unroll") for (int k = 0; k < 2; ++k) dst[m][k] = *(const PG8_LAS bf16x8*)(lds + PG8_SA(b, h) + aoff + m * 2048 + k * 1024); } while (0)
#define PG8_LDB(dst, b, h) do { _Pragma("unroll") for (int n = 0; n < 2; ++n) _Pragma("unroll") for (int k = 0; k < 2; ++k) dst[n][k] = *(const PG8_LAS bf16x8*)(lds + PG8_SB(b, h) + boff + n * 2048 + k * 1024); } while (0)
#define PG8_MMA(ai, bj, At, Bt) do { __builtin_amdgcn_s_setprio(1); _Pragma("unroll") for (int m = 0; m < 4; ++m) _Pragma("unroll") for (int n = 0; n < 2; ++n) _Pragma("unroll") for (int k = 0; k < 2; ++k) \
        acc[ai][bj][m][n] = __builtin_amdgcn_mfma_f32_16x16x32_bf16(Bt[n][k], At[m][k], acc[ai][bj][m][n], 0, 0, 0); __builtin_amdgcn_s_setprio(0); } while (0)
#define PG8_WAIT_V(n) asm volatile("s_waitcnt vmcnt(" #n ")" ::: "memory")
#define PG8_WAIT_L(n) asm volatile("s_waitcnt lgkmcnt(" #n ")" ::: "memory")
#define PG8_BAR __builtin_amdgcn_s_barrier()
#define PG8_SCHED __builtin_amdgcn_sched_barrier(0)
    Unit cur, nxt; int ui = 0;
    if (!S.next(0, cur)) return;
    f32x4 acc[2][2][4][2];
    { typename Epi::Pre pre0; E.preload(pre0, cur, wr, wc, fr, fq); E.init(acc, pre0); }
    bf16x8 At[4][2], B0[2][2], B1[2][2];
    const char* cA = GATHER ? (const char*)g.A : (const char*)g.A + (size_t)cur.pm * tstep; const char* cB = (const char*)g.Bt + (size_t)cur.pb * tstep;
    if constexpr (GATHER) { PG8_GDMA(cur, 0); asm volatile("s_waitcnt vmcnt(0)" ::: "memory"); __syncthreads(); PG8_GREAD(vC, cur, 0); }
    S.a_ready(cur);
    if constexpr (SP2) {
        PG8_STAGE(PG8_SB(0, 0), cB, voffB); PG8_STAGE(PG8_SB(0, 1), cB + hstep, voffB); PG8_STAGE(PG8_SA(0, 0), cA, PG8_VA(vC, 0)); PG8_STAGE(PG8_SA(0, 1), cA + PG8_AH(1), PG8_VA(vC, 1));
        if (wr == 1) PG8_BAR;
        PG8_WAIT_V(2); PG8_BAR;
        PG8_STAGE(PG8_SB(1, 0), cB + kstep, voffB); PG8_STAGE(PG8_SA(1, 0), cA + kstep, PG8_VA(vC, 0)); PG8_STAGE(PG8_SB(1, 1), cB + hstep + kstep, voffB);
        PG8_WAIT_V(6); PG8_BAR;
    } else {
        PG8_STAGE(PG8_SB(0, 0), cB, voffB); PG8_STAGE(PG8_SA(0, 0), cA, voffA); PG8_STAGE(PG8_SB(0, 1), cB + hstep, voffB); PG8_STAGE(PG8_SA(0, 1), cA + hstep, voffA);
        if (wr == 1) PG8_BAR;
        PG8_WAIT_V(4); PG8_BAR;
        PG8_STAGE(PG8_SB(1, 0), cB + kstep, voffB); PG8_STAGE(PG8_SA(1, 0), cA + kstep, voffA); PG8_STAGE(PG8_SB(1, 1), cB + hstep + kstep, voffB);
        PG8_WAIT_V(6); PG8_BAR;
    }
    for (;;) {
        const bool has_next = S.next(ui + 1, nxt);
        if constexpr (GATHER) { if (has_next) PG8_GDMA(nxt, (ui + 1) & 1); }
        const char* nA = (has_next && !GATHER) ? (const char*)g.A + (size_t)nxt.pm * tstep : cA; const char* nB = has_next ? (const char*)g.Bt + (size_t)nxt.pb * tstep : cB;
        for (int t = 0; t < nt; t += 2) {
            const bool last = (t == nt - 2);
            const char* a1 = cA + (size_t)(t + 1) * kstep;
            const char* a2 = last ? nA : cA + (size_t)(t + 2) * kstep; const char* b2 = last ? nB : cB + (size_t)(t + 2) * kstep;
            const char* a3 = a2 + kstep; const char* b3 = b2 + kstep;
            if (last && has_next) S.a_ready(nxt);
            if constexpr (GATHER) { if (last) { if (has_next) { PG8_GREAD(vN, nxt, (ui + 1) & 1); } else { _Pragma("unroll") for (int h_ = 0; h_ < 2; ++h_) _Pragma("unroll") for (int i_ = 0; i_ < 2; ++i_) vN[h_][i_] = vC[h_][i_]; } } }
            unsigned vS[2][2];
#pragma unroll
            for (int h_ = 0; h_ < 2; ++h_)
#pragma unroll
                for (int i_ = 0; i_ < 2; ++i_) vS[h_][i_] = (GATHER && last) ? vN[h_][i_] : vC[h_][i_];
            if constexpr (SP2) {
            PG8_LDB(B0, 0, 0); PG8_LDB(B1, 0, 1); PG8_SCHED; PG8_LDA(At, 0, 0); PG8_STAGE(PG8_SA(1, 1), a1 + PG8_AH(1), PG8_VA(vC, 1));
            PG8_WAIT_V(8); PG8_WAIT_L(0); PG8_BAR; PG8_MMA(0, 0, At, B0); PG8_MMA(0, 1, At, B1); PG8_BAR; PG8_SCHED;
            PG8_LDA(At, 0, 1); PG8_STAGE(PG8_SB(0, 0), b2, voffB); PG8_STAGE(PG8_SB(0, 1), b2 + hstep, voffB); PG8_STAGE(PG8_SA(0, 0), a2, PG8_VA(vS, 0));
            PG8_WAIT_V(8); PG8_WAIT_L(0); PG8_BAR; PG8_MMA(1, 0, At, B0); PG8_MMA(1, 1, At, B1); PG8_BAR; PG8_SCHED;
            PG8_LDB(B0, 1, 0); PG8_LDB(B1, 1, 1); PG8_SCHED; PG8_LDA(At, 1, 0); PG8_STAGE(PG8_SA(0, 1), a2 + PG8_AH(1), PG8_VA(vS, 1));
            PG8_WAIT_V(8); PG8_WAIT_L(0); PG8_BAR; PG8_MMA(0, 0, At, B0); PG8_MMA(0, 1, At, B1); PG8_BAR; PG8_SCHED;
            PG8_LDA(At, 1, 1); PG8_STAGE(PG8_SB(1, 0), b3, voffB); PG8_STAGE(PG8_SB(1, 1), b3 + hstep, voffB); PG8_STAGE(PG8_SA(1, 0), a3, PG8_VA(vS, 0));
            PG8_WAIT_V(8); PG8_WAIT_L(0); PG8_BAR; PG8_MMA(1, 0, At, B0); PG8_MMA(1, 1, At, B1); PG8_BAR; PG8_SCHED;
            } else {
            PG8_LDB(B0, 0, 0); PG8_SCHED; PG8_LDA(At, 0, 0); PG8_STAGE(PG8_SA(1, 1), a1 + hstep, voffA);
            PG8_WAIT_L(8); PG8_BAR; PG8_WAIT_L(0); PG8_MMA(0, 0, At, B0); PG8_BAR; PG8_SCHED;
            PG8_LDB(B1, 0, 1); PG8_STAGE(PG8_SB(0, 0), b2, voffB);
            PG8_BAR; PG8_WAIT_L(0); PG8_MMA(0, 1, At, B1); PG8_BAR;
            PG8_LDA(At, 0, 1); PG8_STAGE(PG8_SA(0, 0), a2, voffA);
            PG8_BAR; PG8_WAIT_L(0); PG8_MMA(1, 0, At, B0); PG8_BAR; PG8_SCHED;
            PG8_STAGE(PG8_SB(0, 1), b2 + hstep, voffB);
            PG8_WAIT_V(6); PG8_BAR; PG8_MMA(1, 1, At, B1); PG8_BAR;
            PG8_LDB(B0, 1, 0); PG8_SCHED; PG8_LDA(At, 1, 0); PG8_STAGE(PG8_SA(0, 1), a2 + hstep, voffA);
            PG8_WAIT_L(8); PG8_BAR; PG8_WAIT_L(0); PG8_MMA(0, 0, At, B0); PG8_BAR; PG8_SCHED;
            PG8_LDB(B1, 1, 1); PG8_STAGE(PG8_SB(1, 0), b3, voffB);
            PG8_BAR; PG8_WAIT_L(0); PG8_MMA(0, 1, At, B1); PG8_BAR;
            PG8_LDA(At, 1, 1); PG8_STAGE(PG8_SA(1, 0), a3, voffA);
            PG8_BAR; PG8_WAIT_L(0); PG8_MMA(1, 0, At, B0); PG8_BAR; PG8_SCHED;
            PG8_STAGE(PG8_SB(1, 1), b3 + hstep, voffB);
            PG8_WAIT_V(6); PG8_BAR; PG8_MMA(1, 1, At, B1); PG8_BAR;
            }
        }
        if constexpr (ALIGN_EPI) { if (wr == 0) PG8_BAR; }
        typename Epi::Pre pre; E.preload(pre, has_next ? nxt : cur, wr, wc, fr, fq); __builtin_amdgcn_sched_barrier(0);
        if constexpr (!Epi::AFTER_DRAIN) { E(acc, cur, wr, wc, fr, fq); S.done(cur); }
        if (!has_next) break;
        E.init(acc, pre);
        cur = nxt; cA = nA; cB = nB; ++ui;
        if constexpr (GATHER) { _Pragma("unroll") for (int h_ = 0; h_ < 2; ++h_) _Pragma("unroll") for (int i_ = 0; i_ < 2; ++i_) vC[h_][i_] = vN[h_][i_]; }
        if constexpr (ALIGN_EPI) { if (wr == 1) PG8_BAR; }
    }
    PG8_WAIT_V(0);
    if constexpr (!ALIGN_EPI) { if (wr == 0) PG8_BAR; }
    PG8_BAR;
    if constexpr (Epi::AFTER_DRAIN) { E.fused(acc, cur, wr, wc, fr, fq, lds, wid, lane); S.done(cur); }
#undef PG8_SA
#undef PG8_GDMA
#undef PG8_GREAD
#undef PG8_AH
#undef PG8_VA
#undef PG8_SB
#undef PG8_STAGE
#undef PG8_LDA
#undef PG8_LDB
#undef PG8_MMA
#undef PG8_WAIT_V
#undef PG8_WAIT_L
#undef PG8_BAR
#undef PG8_SCHED
}
}
#ifndef PG8_SP2
#define PG8_SP2 true
#endif
#ifndef PG8_ALIGN
#define PG8_ALIGN true
#endif
#ifndef PROBE_DOUBLE
#define PROBE_DOUBLE 0
#endif
#ifndef MK_N_LAUNCHES
#define MK_N_LAUNCHES 1
#endif

constexpr int NWAVES = 8;
constexpr int BATCH = 4, SEQ = 8192, D = 1024, T = BATCH * SEQ, DEPTH = 4;
constexpr int NEXP = 32, TOPK = 4, FF = 1024;
constexpr int DA_H = 8, RET_H = 4;
constexpr float LN_EPS = 1e-5f;
constexpr float DN_ALPHA = 1.6817928305074290f;
constexpr float LOG2E = 1.4426950408889634f;
constexpr int MT_MAX = T * TOPK / 256 + NEXP;

constexpr size_t MiB = 1u << 20;
constexpr size_t WS_CTL = 0, CTL_ZERO_BYTES = 1 * MiB;
constexpr size_t WS_WIMG = 2 * MiB;
constexpr size_t WS_STATS = 4 * MiB;
constexpr size_t WS_WDAIN = 16 * MiB;
constexpr size_t WS_WDAOUT = 28 * MiB;
constexpr size_t WS_WRETIN = 32 * MiB;
constexpr size_t WS_WRETOUT = 56 * MiB;
constexpr size_t WS_WGU = 64 * MiB;
constexpr size_t WS_WDN = 576 * MiB;
constexpr size_t WS_XB = 832 * MiB;
constexpr size_t WS_Y = 896 * MiB;
constexpr size_t WS_PROJ = 1024 * MiB;
constexpr size_t WS_AO = 1408 * MiB;
constexpr size_t WS_STATE = 1536 * MiB;
constexpr size_t WS_XS = 1792 * MiB;
constexpr size_t WS_ACT = 2064 * MiB;
constexpr size_t WS_YE = 2336 * MiB;
constexpr size_t WS_ROUTE = 2592 * MiB;
constexpr size_t WS_SLOT = 2596 * MiB;
constexpr size_t WS_END = 2608 * MiB;
constexpr int CW_BAR = 4096;
constexpr int CW_CNT = 16384;
constexpr int CW_KMAX = 32768;
constexpr int CW_QCTR = 33280;
constexpr int RING_BYTES = 131072;
constexpr int MISC_OFF = RING_BYTES + 320;
constexpr int TBL_OFF = RING_BYTES + 1024;
constexpr int LDS_BYTES = 147456;

#define GAS __attribute__((address_space(1)))
#define LAS __attribute__((address_space(3)))
typedef unsigned short bf16;
typedef unsigned v4u __attribute__((ext_vector_type(4)));
typedef unsigned v2u __attribute__((ext_vector_type(2)));
typedef float f32x4 __attribute__((ext_vector_type(4)));
typedef float f32x16 __attribute__((ext_vector_type(16)));
typedef short bf16x8 __attribute__((ext_vector_type(8)));
typedef short s16x4 __attribute__((ext_vector_type(4)));
typedef GAS unsigned gu32;
#define RLX_AGENT __ATOMIC_RELAXED, __HIP_MEMORY_SCOPE_AGENT
#define LDS_WAIT() asm volatile("s_waitcnt lgkmcnt(0)" ::: "memory")
#define VM_WAIT() asm volatile("s_waitcnt vmcnt(0)" ::: "memory")
__device__ __forceinline__ unsigned f2bf(float f) { unsigned u = __builtin_bit_cast(unsigned, f); return (u + 0x7fffu + ((u >> 16) & 1u)) >> 16; }
typedef float f32x2_t __attribute__((ext_vector_type(2))); typedef __bf16 bf16x2_t __attribute__((ext_vector_type(2)));
__device__ __forceinline__ unsigned pk2(float lo, float hi) { f32x2_t v = {lo, hi}; bf16x2_t b = __builtin_convertvector(v, bf16x2_t); return __builtin_bit_cast(unsigned, b); }
__device__ __forceinline__ float bf2f(unsigned short h) { return __builtin_bit_cast(float, (unsigned)h << 16); }
__device__ __forceinline__ float bflo(unsigned w) { return __builtin_bit_cast(float, w << 16); }
__device__ __forceinline__ float bfhi(unsigned w) { return __builtin_bit_cast(float, w & 0xffff0000u); }
__device__ __forceinline__ int crow(int r, int hi) { return (r & 3) + 8 * (r >> 2) + 4 * hi; }
typedef short v4i16_t __attribute__((ext_vector_type(4)));
__device__ __forceinline__ s16x4 vtr(LAS const unsigned char* p) { return __builtin_bit_cast(s16x4, __builtin_amdgcn_ds_read_tr16_b64_v4i16((LAS v4i16_t*)p)); }
__device__ __forceinline__ bf16x8 cat8(s16x4 lo, s16x4 hi) { return (bf16x8){lo[0], lo[1], lo[2], lo[3], hi[0], hi[1], hi[2], hi[3]}; }
__device__ __forceinline__ bf16x8 pack8f(float a0, float a1, float a2, float a3, float a4, float a5, float a6, float a7) {
    v4u w; w.x = pk2(a0, a1); w.y = pk2(a2, a3); w.z = pk2(a4, a5); w.w = pk2(a6, a7); return __builtin_bit_cast(bf16x8, w); }
#define XB_TMO      128
#define XB_XCNT(j)  (256  + 64 * (j))
#define XB_XSUB(j)  (1280 + 64 * (j))
#define XB_XGEN(j)  (2304 + 64 * (j))
#define XB_TOP      3328
#define XB_TOPGEN   3392
#define XCD_BAR_WORDS 3456
#define XB_SPIN_CAP (1u << 24)

__device__ __forceinline__ unsigned xb_ld(unsigned* p)              { return __hip_atomic_load(p, __ATOMIC_RELAXED, __HIP_MEMORY_SCOPE_AGENT); }
__device__ __forceinline__ unsigned xb_add(unsigned* p, unsigned v) { return __hip_atomic_fetch_add(p, v, __ATOMIC_RELAXED, __HIP_MEMORY_SCOPE_AGENT); }
__device__ __forceinline__ unsigned xb_xcc_id() { return (unsigned)__builtin_amdgcn_s_getreg((3 << 11) | 20) & 0xFu; }
#define XB_SPIN(cond, bar) do { unsigned _sp = 0; while (cond) { __builtin_amdgcn_s_sleep(1); \
    if ((++_sp & 255u) == 0u) { if (xb_ld(&(bar)[XB_TMO])) break; if (_sp > XB_SPIN_CAP) { atomicAdd(&(bar)[XB_TMO], 1u); break; } } } } while (0)

struct XcdBarrier {
    unsigned* bar; unsigned x;
    volatile LAS unsigned* st;
};

__device__ __forceinline__ XcdBarrier xcd_barrier_post(unsigned* bar, volatile LAS unsigned* st) {
    XcdBarrier b; b.bar = bar; b.x = xb_xcc_id(); b.st = st;
    if (threadIdx.x == 0) (void)xb_add(&bar[XB_XCNT(b.x)], 1u);
    return b;
}
__device__ __forceinline__ void xcd_barrier_complete(unsigned* bar, unsigned x, unsigned& nloc, unsigned& nx) {
    const unsigned G = gridDim.x * gridDim.y * gridDim.z;
    unsigned sum, cnt, mine, sp = 0u;
    for (;;) {
        sum = 0u; cnt = 0u; mine = 0u;
#pragma unroll
        for (unsigned j = 0; j < 16; ++j) { const unsigned c = xb_ld(&bar[XB_XCNT(j)]); sum += c; cnt += (c > 0u) ? 1u : 0u; mine = (j == x) ? c : mine; }
        if (sum == G) break;
        __builtin_amdgcn_s_sleep(1);
        if ((++sp & 255u) == 0u) { if (xb_ld(&bar[XB_TMO])) break; if (sp > XB_SPIN_CAP) { atomicAdd(&bar[XB_TMO], 1u); break; } }
    }
    nloc = mine > 0u ? mine : 1u; nx = cnt > 0u ? cnt : 1u;
}

__device__ __forceinline__ void xcd_barrier(const XcdBarrier& b) {
    asm volatile("s_waitcnt vmcnt(0)" ::: "memory");
    __syncthreads();
    if (threadIdx.x == 0) {
        unsigned* bar = b.bar;
        __builtin_amdgcn_s_waitcnt(0);
        unsigned nloc = b.st[0], nx = b.st[1];
        if (nloc == 0u) { xcd_barrier_complete(bar, b.x, nloc, nx); b.st[0] = nloc; b.st[1] = nx; }
        const unsigned old = xb_add(&bar[XB_XSUB(b.x)], 1u);
        const unsigned gen = old / nloc;
        if (old + 1u == (gen + 1u) * nloc) {
            __builtin_amdgcn_fence(__ATOMIC_RELEASE, "agent");
            asm volatile("s_waitcnt vmcnt(0)" ::: "memory");
            const unsigned og = xb_add(&bar[XB_TOP], 1u);
            const unsigned tg = og / nx;
            if (og + 1u == (tg + 1u) * nx) xb_add(&bar[XB_TOPGEN], 1u);
            else XB_SPIN(xb_ld(&bar[XB_TOPGEN]) == tg, bar);
            __builtin_amdgcn_fence(__ATOMIC_ACQUIRE, "agent");
            xb_add(&bar[XB_XGEN(b.x)], 1u);
            asm volatile("s_waitcnt vmcnt(0)" ::: "memory");
        } else {
            XB_SPIN(xb_ld(&bar[XB_XGEN(b.x)]) == gen, bar);
            __builtin_amdgcn_fence(__ATOMIC_ACQUIRE, "agent");
            asm volatile("s_waitcnt vmcnt(0)" ::: "memory");
        }
    }
    __syncthreads();
}
struct Frame {
    LAS unsigned char* lds;
    volatile LAS unsigned* MISC;
    gu32* ctl;
    int vcu, G;
};

#define LTID() const int tid_ = hw_tid(F.lds), lane_ = tid_ & 63, wave_ = __builtin_amdgcn_readfirstlane(tid_ >> 6); (void)lane_; (void)wave_
template <int MODE>
__device__ __forceinline__ int p0_dest_row(int n0) { return (MODE == 1) ? ((n0 < 1024) ? (256 * (n0 >> 7) + (n0 & 127)) : (256 * ((n0 - 1024) >> 7) + 128 + ((n0 - 1024) & 127))) : n0; }
template <int MODE>
__device__ __forceinline__ void p0_family(Frame& F, const float* W, bf16* WT, int nmat, int K, int N, int wg_rank = -1, int wg_count = 0) { LTID();
    LAS float* scr = (LAS float*)(F.lds + wave_ * 16384);
    const int gw = (wg_rank < 0 ? F.vcu : wg_rank) * NWAVES + wave_, NGW = (wg_rank < 0 ? F.G : wg_count) * NWAVES, lane = lane_;
    const int nblk = N / 32, ipm = (K / 64) * nblk, total = nmat * ipm;
    f32x4 cur[8], nxt[8], nx2[8], nx3[8];
#define P0_LOAD(dst, it_) do { const int mat_ = (it_) / ipm, r_ = (it_) - mat_ * ipm, kb_ = r_ / nblk, nb_ = r_ - kb_ * nblk; \
        const float* src_ = W + (size_t)mat_ * K * N + (size_t)(64 * kb_ + (lane >> 3)) * N + 32 * nb_ + 4 * (lane & 7); \
        _Pragma("unroll") for (int i = 0; i < 8; ++i) dst[i] = __builtin_nontemporal_load((const GAS f32x4*)(src_ + (size_t)(8 * i) * N)); } while (0)
    int it = gw;
    if (it < total) P0_LOAD(cur, it);
    if (it + NGW < total) P0_LOAD(nxt, it + NGW);
    if (it + 2 * NGW < total) P0_LOAD(nx2, it + 2 * NGW);
    for (; it < total; it += NGW) {
        const int itn = it + 3 * NGW;
        if (itn < total) P0_LOAD(nx3, itn);
        const int mat = it / ipm, r = it - mat * ipm, kb = r / nblk, nb = r - kb * nblk, k0 = 64 * kb, r0 = p0_dest_row<MODE>(32 * nb);
#pragma unroll
        for (int i = 0; i < 8; ++i) { LAS float* sw = scr + (8 * i + (lane >> 3)) * 33 + 4 * (lane & 7); sw[0] = cur[i].x; sw[1] = cur[i].y; sw[2] = cur[i].z; sw[3] = cur[i].w; }
        LDS_WAIT(); asm volatile("" ::: "memory");
        const int c = lane & 7; bf16* wt = WT + (size_t)mat * K * N;
#pragma unroll
        for (int j = 0; j < 4; ++j) { const int n = (lane >> 3) + 8 * j; const LAS float* sp = scr + (8 * c) * 33 + n;
            v4u o; o.x = pk2(sp[0 * 33], sp[1 * 33]); o.y = pk2(sp[2 * 33], sp[3 * 33]); o.z = pk2(sp[4 * 33], sp[5 * 33]); o.w = pk2(sp[6 * 33], sp[7 * 33]);
            __builtin_nontemporal_store(o, (GAS v4u*)(wt + (size_t)(r0 + n) * K + k0 + 8 * c)); }
        LDS_WAIT(); asm volatile("" ::: "memory");
#pragma unroll
        for (int i = 0; i < 8; ++i) { cur[i] = nxt[i]; nxt[i] = nx2[i]; nx2[i] = nx3[i]; }
    }
#undef P0_LOAD
}
__device__ __forceinline__ void p0_x_to_bf16(Frame& F, const float* x, bf16* XB) { LTID();
    const int gw = F.vcu * NWAVES + wave_, NGW = F.G * NWAVES;
    for (int m = gw; m < T; m += NGW) {
        const GAS f32x4* xr = (const GAS f32x4*)(x + (size_t)m * D) + lane_; GAS v2u* o = (GAS v2u*)(XB + (size_t)m * D) + lane_;
#pragma unroll
        for (int j = 0; j < 4; ++j) { const f32x4 v = __builtin_nontemporal_load(xr + 64 * j); v2u w; w.x = pk2(v.x, v.y); w.y = pk2(v.z, v.w); o[64 * j] = w; } }
}

__device__ __forceinline__ void ln_apply(f32x4 (&v)[4], const float* g, const float* b, int lane) {
    float s = 0.f;
#pragma unroll
    for (int j = 0; j < 4; ++j) s += (v[j].x + v[j].y) + (v[j].z + v[j].w);
    const float mean = wave_sum(s) * (1.f / D); float s2 = 0.f;
#pragma unroll
    for (int j = 0; j < 4; ++j) { v[j] = v[j] - mean; s2 += (v[j].x * v[j].x + v[j].y * v[j].y) + (v[j].z * v[j].z + v[j].w * v[j].w); }
    const float rstd = 1.f / sqrtf(wave_sum(s2) * (1.f / D) + LN_EPS);
#pragma unroll
    for (int j = 0; j < 4; ++j) { const f32x4 gg = *((const GAS f32x4*)g + lane + 64 * j), bb = *((const GAS f32x4*)b + lane + 64 * j); v[j] = v[j] * rstd * gg + bb; }
}
__device__ __forceinline__ void store_x(const f32x4 (&v)[4], float* X, bf16* XB, size_t row, int lane) {
    GAS v2u* bo = (GAS v2u*)(XB + row * D) + lane;
#pragma unroll
    for (int j = 0; j < 4; ++j) { v2u w; w.x = pk2(v[j].x, v[j].y); w.y = pk2(v[j].z, v[j].w); bo[64 * j] = w; }
    if (X) { GAS f32x4* xo = (GAS f32x4*)(X + row * D) + lane;
#pragma unroll
        for (int j = 0; j < 4; ++j) xo[64 * j] = v[j]; }
}
__device__ __forceinline__ void p0_router_image(Frame& F, const float* Wr_all, unsigned char* IMG) { LTID();
    const int gt = (F.vcu * NWAVES + wave_) * 64 + lane_;
    if (gt < DEPTH * NEXP * 128) { const int L = gt >> 12, e = (gt >> 7) & 31, c = gt & 127; const float* w = Wr_all + (size_t)L * D * NEXP + (size_t)(8 * c) * NEXP + e;
        float x[8]; v4u hi, lo;
#pragma unroll
        for (int j = 0; j < 8; ++j) x[j] = w[j * NEXP];
#pragma unroll
        for (int j = 0; j < 4; ++j) { hi[j] = pk2(x[2 * j], x[2 * j + 1]); lo[j] = pk2(x[2 * j] - bflo(hi[j]), x[2 * j + 1] - bfhi(hi[j])); }
        unsigned char* dst = IMG + (size_t)L * 131072 + e * 2048 + ((c ^ (e & 15)) * 16);
        *(GAS v4u*)dst = hi; *(GAS v4u*)(dst + 65536) = lo; }
}
__device__ __forceinline__ void ln_router_phase(Frame& F, const bf16* Y, const float* STATS, const float* g, const float* b, const unsigned char* WIMG, const float* br, bf16* XB, int2* SLOT, gu32* cnt) { LTID();
    LAS unsigned char* lds = F.lds;
#pragma unroll 4
    for (int i = 0; i < 16; ++i) { const int idx = tid_ + 512 * i; *(LAS v4u*)(lds + idx * 16) = *(const GAS v4u*)(WIMG + idx * 16); }
    LAS int* lcnt = (LAS int*)(lds + TBL_OFF + 4096);
    typedef int v4i_t __attribute__((ext_vector_type(4)));
    LAS v4i_t* rec = (LAS v4i_t*)(lds + TBL_OFF + 4096 + 256);
    for (int rt = F.vcu; rt < T / 128; rt += F.G) {
        if (tid_ < 32) lcnt[tid_] = 0;
        LDS_WAIT(); __syncthreads();
        int tid = tid_; asm volatile("" : "+v"(tid));
        const int lane = tid & 63, wid = __builtin_amdgcn_readfirstlane(tid >> 6), r = lane & 15, kg = lane >> 4;
        const size_t row = (size_t)rt * 128 + wid * 16 + r;
        const bf16* yr = Y + row * D + kg * 8;
        float s1, s2;
        { const GAS f32x4* sp = (const GAS f32x4*)(STATS + (row * 16 + kg * 4) * 2); const f32x4 a = sp[0], c = sp[1]; s1 = (a.x + a.z) + (c.x + c.z); s2 = (a.y + a.w) + (c.y + c.w); }
        { float t0; float o0 = swap16_other(s1, t0); s1 = t0 + o0; o0 = swap32_other(s1, t0); s1 = t0 + o0; o0 = swap16_other(s2, t0); s2 = t0 + o0; o0 = swap32_other(s2, t0); s2 = t0 + o0; }
        const float mean = s1 * (1.f / D), rstd = 1.f / sqrtf(__builtin_fmaxf(s2 * (1.f / D) - mean * mean, 0.f) + LN_EPS);
        pg8::f32x4 c0 = (pg8::f32x4){0.f, 0.f, 0.f, 0.f}, c1 = c0;
        bf16* xbr = XB + row * D + kg * 8;
        LAS const unsigned char* wb = lds + r * 2048;
        v4u ywn[4];
#pragma unroll
        for (int t = 0; t < 4; ++t) ywn[t] = __builtin_nontemporal_load((const GAS v4u*)(yr + 32 * t));
#pragma unroll
        for (int q = 0; q < 8; ++q) {
            f32x4 ga[4], gb[4], ba[4], bb[4]; v4u ywc[4];
#pragma unroll
            for (int t = 0; t < 4; ++t) { const int s = 4 * q + t; ga[t] = *(const GAS f32x4*)(g + 32 * s + kg * 8); gb[t] = *(const GAS f32x4*)(g + 32 * s + kg * 8 + 4); ba[t] = *(const GAS f32x4*)(b + 32 * s + kg * 8); bb[t] = *(const GAS f32x4*)(b + 32 * s + kg * 8 + 4); ywc[t] = ywn[t]; }
            if (q < 7) {
#pragma unroll
                for (int t = 0; t < 4; ++t) ywn[t] = __builtin_nontemporal_load((const GAS v4u*)(yr + 32 * (4 * q + 4 + t))); }
            __builtin_amdgcn_sched_barrier(0);
#pragma unroll
            for (int t = 0; t < 4; ++t) { const int s = 4 * q + t; const v4u yw = ywc[t];
            const f32x4 ya = (f32x4){bflo(yw[0]), bfhi(yw[0]), bflo(yw[1]), bfhi(yw[1])}, yb = (f32x4){bflo(yw[2]), bfhi(yw[2]), bflo(yw[3]), bfhi(yw[3])};
            const f32x4 xa = (ya - mean) * rstd * ga[t] + ba[t], xb = (yb - mean) * rstd * gb[t] + bb[t];
            v4u hi, lo; hi[0] = pk2(xa.x, xa.y); hi[1] = pk2(xa.z, xa.w); hi[2] = pk2(xb.x, xb.y); hi[3] = pk2(xb.z, xb.w);
            lo[0] = pk2(xa.x - bflo(hi[0]), xa.y - bfhi(hi[0])); lo[1] = pk2(xa.z - bflo(hi[1]), xa.w - bfhi(hi[1])); lo[2] = pk2(xb.x - bflo(hi[2]), xb.y - bfhi(hi[2])); lo[3] = pk2(xb.z - bflo(hi[3]), xb.w - bfhi(hi[3]));
            *(GAS v4u*)(xbr + 32 * s) = hi;
            const int co = ((4 * s + kg) ^ r) * 16;
            const bf16x8 bh0 = *(const LAS bf16x8*)(wb + co), bh1 = *(const LAS bf16x8*)(wb + 32768 + co), bl0 = *(const LAS bf16x8*)(wb + 65536 + co), bl1 = *(const LAS bf16x8*)(wb + 98304 + co);
            const bf16x8 ah = __builtin_bit_cast(bf16x8, hi), al = __builtin_bit_cast(bf16x8, lo);
            c0 = __builtin_amdgcn_mfma_f32_16x16x32_bf16(ah, bh0, c0, 0, 0, 0); c1 = __builtin_amdgcn_mfma_f32_16x16x32_bf16(ah, bh1, c1, 0, 0, 0);
            c0 = __builtin_amdgcn_mfma_f32_16x16x32_bf16(al, bh0, c0, 0, 0, 0); c1 = __builtin_amdgcn_mfma_f32_16x16x32_bf16(al, bh1, c1, 0, 0, 0);
            c0 = __builtin_amdgcn_mfma_f32_16x16x32_bf16(ah, bl0, c0, 0, 0, 0); c1 = __builtin_amdgcn_mfma_f32_16x16x32_bf16(ah, bl1, c1, 0, 0, 0); }
            __builtin_amdgcn_sched_barrier(0);
        }
        const float bi0 = br[r], bi1 = br[16 + r];
#pragma unroll
        for (int rr = 0; rr < 4; ++rr) {
            float v0 = c0[rr] + bi0, v1 = c1[rr] + bi1; int ei[4]; float ev[4];
#pragma unroll
            for (int k = 0; k < 4; ++k) { const float m = row_max16(__builtin_fmaxf(v0, v1));
                const unsigned long long m0 = __ballot(v0 == m), m1 = __ballot(v1 == m);
                const unsigned q0b = (unsigned)(m0 >> (16 * kg)) & 0xffffu, q1b = (unsigned)(m1 >> (16 * kg)) & 0xffffu;
                const int idx = q0b ? (__ffs((int)q0b) - 1) : (16 + __ffs((int)q1b) - 1);
                ev[k] = m; ei[k] = idx;
                if (idx < 16) { if (r == idx) v0 = -INFINITY; } else { if (r == idx - 16) v1 = -INFINITY; } }
            const float p1 = __expf(ev[1] - ev[0]), p2 = __expf(ev[2] - ev[0]), p3 = __expf(ev[3] - ev[0]); const float inv = 1.f / (((1.f + p1) + p2) + p3);
            if (r < 4) { const int me = r == 0 ? ei[0] : r == 1 ? ei[1] : r == 2 ? ei[2] : ei[3]; const float mw = (r == 0 ? 1.f : r == 1 ? p1 : r == 2 ? p2 : p3) * inv;
                const int lr = __hip_atomic_fetch_add(lcnt + me, 1, __ATOMIC_RELAXED, __HIP_MEMORY_SCOPE_WORKGROUP);
                rec[(wid * 16 + 4 * kg + rr) * 4 + r] = (v4i_t){me, lr, __float_as_int(mw), 0}; }
        }
        LDS_WAIT(); __syncthreads();
        if (tid < NEXP) { const int c = lcnt[tid]; lcnt[32 + tid] = c ? (int)__hip_atomic_fetch_add(cnt + tid * 64, (unsigned)c, RLX_AGENT) : 0; }
        LDS_WAIT(); __syncthreads();
        { const v4i_t rc = rec[tid]; typedef int v2i_t __attribute__((ext_vector_type(2)));
          *(GAS v2i_t*)(SLOT + (size_t)rc.x * pg8::GCAP_SLOTS + (lcnt[32 + rc.x] + rc.y)) = (v2i_t){(rt * 128 + (tid >> 2)) * 4 + (tid & 3), rc.z}; }
        LDS_WAIT(); __syncthreads();
    }
}
__device__ __forceinline__ void build_tables(Frame& F, gu32* cnt) { LTID();
    LAS int* tb = (LAS int*)(F.lds + TBL_OFF);
    __syncthreads();
    if (tid_ < NEXP) tb[40 + tid_] = (int)__hip_atomic_load(cnt + tid_ * 64, RLX_AGENT);
    LDS_WAIT(); __syncthreads();
    if (tid_ == 0) { int acc = 0; for (int e = 0; e < NEXP; ++e) { tb[e] = acc; acc += (tb[40 + e] + 255) >> 8; } tb[NEXP] = acc; }
    LDS_WAIT(); __syncthreads();
    for (int pm = tid_; pm < MT_MAX; pm += 512) { int e = 0;
#pragma unroll
        for (int j = 1; j < NEXP; ++j) e += (tb[j] <= pm) ? 1 : 0;
        tb[128 + pm] = e; }
    LDS_WAIT(); __syncthreads();
}
__device__ __forceinline__ void gather_phase(Frame& F, const bf16* XB, const int4* ROUTE, bf16* XS, int2* SLOT) { LTID();
    const LAS int* tb = (const LAS int*)(F.lds + TBL_OFF);
    const int gw = F.vcu * NWAVES + wave_, NGW = F.G * NWAVES, lane = lane_;
    for (int t = gw; t < T; t += NGW) {
        const int4 r = ROUTE[(size_t)t * 4 + (lane & 3)];
        const GAS v4u* src = (const GAS v4u*)(XB + (size_t)t * D); const v4u a = src[lane], c = src[64 + lane];
#pragma unroll
        for (int k = 0; k < 4; ++k) { const int e = __shfl(r.x, k), rk = __shfl(r.y, k), wb = __shfl(r.z, k); const int dest = 256 * tb[e] + rk;
            GAS v4u* dst = (GAS v4u*)(XS + (size_t)dest * D); dst[lane] = a; dst[64 + lane] = c;
            if (lane == 0) SLOT[dest] = make_int2(t * 4 + k, wb); }
    }
}
__device__ __forceinline__ void combine_ln_phase(Frame& F, const bf16* YE, const float* g, const float* b, float* X, bf16* XB) { LTID();
    const int gw = F.vcu * NWAVES + wave_, NGW = F.G * NWAVES, lane = lane_;
    v2u xw[4], yw[4][4];
#define CL_LOAD(r_) do { _Pragma("unroll") for (int j = 0; j < 4; ++j) xw[j] = *((const GAS v2u*)(XB + (size_t)(r_) * D) + lane + 64 * j); \
        _Pragma("unroll") for (int k = 0; k < 4; ++k) { const GAS v2u* yr = (const GAS v2u*)(YE + ((size_t)(r_) * 4 + k) * D) + lane; _Pragma("unroll") for (int j = 0; j < 4; ++j) yw[k][j] = __builtin_nontemporal_load(yr + 64 * j); } } while (0)
    if (gw < T) CL_LOAD(gw);
    for (int row = gw; row < T; row += NGW) {
        f32x4 v[4];
#pragma unroll
        for (int j = 0; j < 4; ++j) { const v2u w = xw[j]; v[j] = (f32x4){bflo(w.x), bfhi(w.x), bflo(w.y), bfhi(w.y)} * DN_ALPHA; }
#pragma unroll
        for (int k = 0; k < 4; ++k) {
#pragma unroll
            for (int j = 0; j < 4; ++j) { const v2u w = yw[k][j]; v[j].x += bflo(w.x); v[j].y += bfhi(w.x); v[j].z += bflo(w.y); v[j].w += bfhi(w.y); } }
        if (row + NGW < T) CL_LOAD(row + NGW);
        __builtin_amdgcn_sched_barrier(0);
        ln_apply(v, g, b, lane);
        store_x(v, X, XB, (size_t)row, lane);
    }
#undef CL_LOAD
}

struct GroupedOrder {
    const LAS int* tb; int NT, GM, G, bx;
    __device__ __forceinline__ bool next(int i, pg8::Unit& u) const {
        const int MT = tb[NEXP]; int pm, pn;
        if (G == 256) { const int x = bx & 7, j = bx >> 3, s = i * 8 + x; pm = s * GM + j % GM; pn = j / GM; }
        else { const int L = i * G + bx; pm = L / NT; pn = L % NT; }
        if (pm >= MT) return false;
        const int e = tb[128 + pm];
        int rows = tb[40 + e] - 256 * (pm - tb[e]); rows = rows > 256 ? 256 : rows;
        u.pm = __builtin_amdgcn_readfirstlane(pm); u.pn = __builtin_amdgcn_readfirstlane(pn); u.pb = __builtin_amdgcn_readfirstlane(e * NT + pn); u.aux = __builtin_amdgcn_readfirstlane(e); u.rows = __builtin_amdgcn_readfirstlane(rows); u.lt = __builtin_amdgcn_readfirstlane(pm - tb[e]);
        return true;
    }
    __device__ __forceinline__ void a_ready(const pg8::Unit&) const {}
    __device__ __forceinline__ void done(const pg8::Unit&) const {}
};

__device__ __forceinline__ void glds16(const void* gsrc, unsigned lds_dst) { unsigned keep;
    asm volatile("s_mov_b32 %0, m0\n\ts_mov_b32 m0, %2\n\ts_nop 0\n\tglobal_load_lds_dwordx4 %1, off\n\ts_mov_b32 m0, %0" : "=&s"(keep) : "v"(gsrc), "s"(lds_dst) : "memory"); }
struct ConvJob { const float* wgu; bf16* wgu_t; const float* wdn; bf16* wdn_t; int nmat; int every; };
__device__ __forceinline__ void da_attn_phase(Frame& F, const bf16* QKV, bf16* AO, float lam, float one_m_li, const float* subg, const unsigned* kmax, gu32* qctr, const ConvJob& cj) { LTID();
    LAS unsigned char* lds = F.lds;
    if (cj.nmat > 0 && (F.vcu % cj.every) == 0) {
        p0_family<1>(F, cj.wgu, cj.wgu_t, cj.nmat, D, 2 * FF, F.vcu / cj.every, (F.G + cj.every - 1) / cj.every);
        p0_family<0>(F, cj.wdn, cj.wdn_t, cj.nmat, FF, D, F.vcu / cj.every, (F.G + cj.every - 1) / cj.every);
        LDS_WAIT(); __syncthreads();
    }
    LAS volatile int* qslot = (LAS volatile int*)(lds + TBL_OFF + 3072);
    LAS float* wred = (LAS float*)(lds + TBL_OFF + 3136);
    if (tid_ == 0) *qslot = (int)__hip_atomic_fetch_add(qctr, 1u, RLX_AGENT);
    LDS_WAIT(); __syncthreads();
    int U = __builtin_amdgcn_readfirstlane(*qslot);
    __syncthreads();
    while (U < 2048) {
        int tid = tid_; asm volatile("" : "+v"(tid));
        const int lane = tid & 63, r32 = lane & 31, hh = lane >> 5, wid = __builtin_amdgcn_readfirstlane(tid >> 6), mp = wid & 1, rg = wid >> 1;
        LAS float* wsf = (LAS float*)(lds + 98304 + wid * 256);
        const int voff = (4 * hh + ((lane & 15) >> 2)) * 64 + ((lane >> 4) & 1) * 32 + (lane & 3) * 8;
        unsigned nxtU = 0u; if (tid == 0) nxtU = __hip_atomic_fetch_add(qctr, 1u, RLX_AGENT);
        const int h = 7 - (U >> 8), qb = 63 - ((U & 255) >> 2), b = U & 3;
        const int q0 = qb * 128, NT = 2 * qb + 2;
        const float sl2 = __builtin_amdgcn_exp2f(-(float)(h + 1)) * LOG2E;
        const size_t rowbase = (size_t)b * SEQ;
        const unsigned* kmp = kmax + ((b * 16 + h * 2 + mp) * 2);
        const float km2 = __builtin_bit_cast(float, __hip_atomic_load(kmp, RLX_AGENT)) + __builtin_bit_cast(float, __hip_atomic_load(kmp + 1, RLX_AGENT));
        bf16x8 qr[4];
        { const bf16* qp = QKV + (rowbase + q0 + rg * 32 + r32) * 3072 + h * 128 + mp * 64 + hh * 8;
#pragma unroll
          for (int d0 = 0; d0 < 4; ++d0) qr[d0] = *(const GAS bf16x8*)(qp + d0 * 16); }
        int t_min = 0; float qkw = 0.f;
        { float qs = 0.f;
#pragma unroll
          for (int d0 = 0; d0 < 4; ++d0)
#pragma unroll
              for (int j = 0; j < 8; ++j) { const float qv = bf2f((unsigned short)qr[d0][j]); qs += qv * qv; }
          qs = xor32_sum(qs); qs = half_max32(qs);
          const float bw = 2.0f * sqrtf(qs * km2) * 1.02f;
          qkw = 0.5f * bw;
          if (lane == 0) wred[wid] = bw;
          LDS_WAIT(); __syncthreads();
          float bm = wred[0];
#pragma unroll
          for (int w8 = 1; w8 < 8; ++w8) bm = __builtin_fmaxf(bm, wred[w8]);
          const float Wk = (bm + 38.0f) / sl2, xx = ((float)q0 - Wk - 63.0f) * (1.0f / 64.0f);
          t_min = (xx > 0.f) ? (int)ceilf(xx) : 0; t_min = __builtin_amdgcn_readfirstlane(t_min); }
        int NIT = NT - t_min;
        const bf16* kg0 = QKV + (rowbase + lane) * 3072 + 1024 + h * 128 + wid * 8;
        const bf16* vg0 = QKV + (rowbase + 16 * (wid & 3) + (lane >> 2)) * 3072 + 2048 + h * 128 + (wid >> 2) * 32 + (lane & 3) * 8;
        const unsigned ldsb = (unsigned)(uintptr_t)lds, kd0 = ldsb + wid * 1024, vd0 = ldsb + 49152 + (wid >> 2) * 4096 + (wid & 3) * 1024;
#define DMA_K(it_, ks) do { const size_t to_ = (size_t)(NT - 1 - (it_)) * 64 * 3072; const unsigned sb_ = (unsigned)(ks) * 16384u; \
        glds16(kg0 + to_, (unsigned)__builtin_amdgcn_readfirstlane(kd0 + sb_)); glds16(kg0 + to_ + 64, (unsigned)__builtin_amdgcn_readfirstlane(kd0 + sb_ + 8192)); } while (0)
#define DMA_V(it_, vs) do { const size_t to_ = (size_t)(NT - 1 - (it_)) * 64 * 3072; const unsigned sb_ = (unsigned)(vs) * 16384u; \
        glds16(vg0 + to_, (unsigned)__builtin_amdgcn_readfirstlane(vd0 + sb_)); glds16(vg0 + to_ + 64, (unsigned)__builtin_amdgcn_readfirstlane(vd0 + sb_ + 8192)); } while (0)
#define DA_QK(P0, P1, it_, ks) do { const int t_ = NT - 1 - (it_), krel0_ = 64 * t_ - q0; const float cb0_ = sl2 * (float)krel0_ + hb - m_ref; LAS const unsigned char* Kb_ = lds + (ks) * 16384; \
        _Pragma("unroll") for (int i = 0; i < 16; ++i) { P0[i] = cb0_ + sl2 * (float)((i & 3) + 8 * (i >> 2)); P1[i] = cb0_ + sl2 * (float)(32 + (i & 3) + 8 * (i >> 2)); } \
        _Pragma("unroll") for (int d0 = 0; d0 < 4; ++d0) { \
            const bf16x8 a0 = *(const LAS bf16x8*)(Kb_ + (mp * 8 + 2 * d0 + hh) * 1024 + r32 * 16), a1 = *(const LAS bf16x8*)(Kb_ + (mp * 8 + 2 * d0 + hh) * 1024 + 512 + r32 * 16); \
            P0 = __builtin_amdgcn_mfma_f32_32x32x16_bf16(a0, qr[d0], P0, 0, 0, 0); P1 = __builtin_amdgcn_mfma_f32_32x32x16_bf16(a1, qr[d0], P1, 0, 0, 0); } \
        if ((it_) < 2) { const int qrel = rg * 32 + r32; \
            _Pragma("unroll") for (int i = 0; i < 16; ++i) { const int kr = krel0_ + crow(i, hh); if (kr > qrel) P0[i] = -INFINITY; if (kr + 32 > qrel) P1[i] = -INFINITY; } } } while (0)
        float tmax = -INFINITY;
        float m_ref = -qkw, l_run = 0.f; f32x16 o[4];
#pragma unroll
        for (int eb = 0; eb < 4; ++eb) o[eb] = (f32x16){0.f, 0.f, 0.f, 0.f, 0.f, 0.f, 0.f, 0.f, 0.f, 0.f, 0.f, 0.f, 0.f, 0.f, 0.f, 0.f};
        const float hb = sl2 * (float)(4 * hh);
        DMA_K(0, 0); DMA_K(1, 1); DMA_V(0, 0);
        if (NIT > 2) { DMA_K(2, 2); DMA_V(1, 1); asm volatile("s_waitcnt vmcnt(8)\n\ts_barrier" ::: "memory"); }
        else { DMA_V(1, 1); asm volatile("s_waitcnt vmcnt(6)\n\ts_barrier" ::: "memory"); }
        f32x16 p0, p1, n0, n1;
        DA_QK(p0, p1, 0, 0);
        n0 = p0; n1 = p1;
        int s3 = 0;
#define DA_MAX3(a, b, c) ({ float r_; asm("v_max3_f32 %0, %1, %2, %3" : "=v"(r_) : "v"(a), "v"(b), "v"(c)); r_; })
#define DA_ITER(P0, P1, N0, N1, it_) do { \
              \
            if ((it_) + 2 < NIT) asm volatile("s_waitcnt vmcnt(4) lgkmcnt(0)\n\ts_barrier" ::: "memory"); \
            else if ((it_) + 1 < NIT) asm volatile("s_waitcnt vmcnt(2) lgkmcnt(0)\n\ts_barrier" ::: "memory"); \
            else asm volatile("s_waitcnt vmcnt(0) lgkmcnt(0)\n\ts_barrier" ::: "memory"); \
            if ((it_) == 2 && NIT > 3) {                           \
                float xm = wred[8]; _Pragma("unroll") for (int w8 = 1; w8 < 8; ++w8) xm = __builtin_fminf(xm, wred[8 + w8]); \
                const int tdrop = (int)floorf(xm * (1.0f / 64.0f)); int nit2 = NT - (tdrop + 1); nit2 = nit2 < 4 ? 4 : nit2; nit2 = __builtin_amdgcn_readfirstlane(nit2); \
                if (nit2 < NIT) NIT = nit2; } \
            const int s3n = (s3 == 2) ? 0 : s3 + 1, s3p = (s3 == 0) ? 2 : s3 - 1; \
            if ((it_) + 3 < NIT) DMA_K((it_) + 3, s3); \
            if ((it_) + 2 < NIT) DMA_V((it_) + 2, s3p); \
            if ((it_) + 1 < NIT) DA_QK(N0, N1, (it_) + 1, s3n); \
            __builtin_amdgcn_sched_barrier(0); \
            float mx = DA_MAX3(P0[0], P1[0], P0[1]); mx = DA_MAX3(mx, P1[1], P0[2]); mx = DA_MAX3(mx, P1[2], P0[3]); mx = DA_MAX3(mx, P1[3], P0[4]); \
            float my = DA_MAX3(P1[4], P0[5], P1[5]); my = DA_MAX3(my, P0[6], P1[6]); my = DA_MAX3(my, P0[7], P1[7]); my = DA_MAX3(my, P0[8], P1[8]); \
            mx = DA_MAX3(mx, P0[9], P1[9]); mx = DA_MAX3(mx, P0[10], P1[10]); mx = DA_MAX3(mx, P0[11], P1[11]); mx = DA_MAX3(mx, P0[12], P1[12]); \
            my = DA_MAX3(my, P0[13], P1[13]); my = DA_MAX3(my, P0[14], P1[14]); my = DA_MAX3(my, P0[15], P1[15]); mx = DA_MAX3(mx, my, my); \
            { float sf_; const float ot_ = swap32_other(mx, sf_); mx = DA_MAX3(sf_, ot_, ot_); } \
            tmax = __builtin_fmaxf(tmax, mx + m_ref);              \
            if (__any(mx > 8.0f)) {                                \
                const float dlt = (mx > 0.f) ? mx : 0.f; m_ref += dlt; \
                _Pragma("unroll") for (int i = 0; i < 16; ++i) { P0[i] -= dlt; P1[i] -= dlt; N0[i] -= dlt; N1[i] -= dlt; } \
                const float f = __builtin_amdgcn_exp2f(-dlt); l_run *= f; \
                if (hh == 0) wsf[r32] = f; \
                LDS_WAIT(); \
                _Pragma("unroll") for (int i = 0; i < 16; ++i) { const float af = wsf[crow(i, hh)]; \
                    _Pragma("unroll") for (int eb = 0; eb < 4; ++eb) o[eb][i] *= af; } \
            } \
            float rs0 = 0.f, rs1 = 0.f; \
            _Pragma("unroll") for (int i = 0; i < 16; ++i) { P0[i] = __builtin_amdgcn_exp2f(P0[i]); P1[i] = __builtin_amdgcn_exp2f(P1[i]); rs0 += P0[i]; rs1 += P1[i]; } \
            l_run += rs0 + rs1; \
            bf16x8 pa[4]; \
            pa[0] = pack8f(P0[0], P0[1], P0[2], P0[3], P0[4], P0[5], P0[6], P0[7]); pa[1] = pack8f(P0[8], P0[9], P0[10], P0[11], P0[12], P0[13], P0[14], P0[15]); \
            pa[2] = pack8f(P1[0], P1[1], P1[2], P1[3], P1[4], P1[5], P1[6], P1[7]); pa[3] = pack8f(P1[8], P1[9], P1[10], P1[11], P1[12], P1[13], P1[14], P1[15]); \
            LAS const unsigned char* Vb = lds + 49152 + s3 * 16384; \
              \
            _Pragma("unroll") for (int ks = 0; ks < 4; ++ks) { bf16x8 vf[4]; \
                _Pragma("unroll") for (int eb = 0; eb < 4; ++eb) vf[eb] = cat8(vtr(Vb + eb * 4096 + ks * 1024 + voff), vtr(Vb + eb * 4096 + ks * 1024 + 512 + voff)); \
                __builtin_amdgcn_sched_barrier(0); \
                _Pragma("unroll") for (int eb = 0; eb < 4; ++eb) o[eb] = __builtin_amdgcn_mfma_f32_32x32x16_bf16(pa[ks], vf[eb], o[eb], 0, 0, 0); \
                __builtin_amdgcn_sched_barrier(0); } \
            if ((it_) == 1) { float tm = tmax; tm = -half_max32(-tm); tm = -xor32_max(-tm);                   \
                if (lane == 0) wred[8 + wid] = (tm - qkw - 38.0f) / sl2 + (float)q0 - 63.0f; }                  \
            s3 = s3n; } while (0)
        int it = 0;
        for (; it + 1 < NIT; it += 2) { DA_ITER(p0, p1, n0, n1, it); DA_ITER(n0, n1, p0, p1, it + 1); }
        if (it < NIT) DA_ITER(p0, p1, n0, n1, it);
#undef DA_ITER
#undef DA_MAX3
#undef DMA_K
#undef DMA_V
#undef DA_QK
        asm volatile("s_waitcnt vmcnt(0)" ::: "memory");
        LDS_WAIT(); __syncthreads();
        const float l_tot = xor32_sum(l_run);
        if (hh == 0) wsf[r32] = 1.f / l_tot;
        LDS_WAIT();
        float rinv[16];
#pragma unroll
        for (int i = 0; i < 16; ++i) rinv[i] = wsf[crow(i, hh)];
        LAS float* comb = (LAS float*)lds + rg * 4096;
        if (mp == 1) {
#pragma unroll
            for (int eb = 0; eb < 4; ++eb)
#pragma unroll
                for (int i = 0; i < 16; ++i) comb[crow(i, hh) * 128 + eb * 32 + r32] = o[eb][i] * rinv[i];
        }
        LDS_WAIT(); __syncthreads();
        if (mp == 0) {
            float ss[16];
#pragma unroll
            for (int i = 0; i < 16; ++i) { float s = 0.f;
#pragma unroll
                for (int eb = 0; eb < 4; ++eb) { const float dlt = o[eb][i] * rinv[i] - lam * comb[crow(i, hh) * 128 + eb * 32 + r32]; o[eb][i] = dlt; s += dlt * dlt; }
                ss[i] = half_sum32(s); }
            float gsc[4];
#pragma unroll
            for (int eb = 0; eb < 4; ++eb) gsc[eb] = subg[eb * 32 + r32] * one_m_li;
#pragma unroll
            for (int i = 0; i < 16; ++i) { const float rr = 1.f / sqrtf(ss[i] * (1.f / 128.f) + LN_EPS);
                LAS bf16* tp = (LAS bf16*)(lds + 65536) + (rg * 32 + crow(i, hh)) * 128 + r32;
#pragma unroll
                for (int eb = 0; eb < 4; ++eb) tp[eb * 32] = (bf16)f2bf(o[eb][i] * rr * gsc[eb]); }
        }
        if (tid == 0) *qslot = (int)nxtU;
        LDS_WAIT(); __syncthreads();
        U = __builtin_amdgcn_readfirstlane(*qslot);
#pragma unroll
        for (int k = 0; k < 4; ++k) { const int idx = tid + 512 * k, row = idx >> 4, c16 = idx & 15;
            *(GAS v4u*)(AO + (rowbase + q0 + row) * 1024 + h * 128 + c16 * 8) = *(const LAS v4u*)(lds + 65536 + idx * 16); }
        LDS_WAIT(); __syncthreads();
    }
}

__device__ __forceinline__ void ret_scan_phase(Frame& F, const bf16* PROJ, bf16* ST, const float (&lg2)[4]) { LTID();
    LAS unsigned char* lds = F.lds;
    for (int L = F.vcu; L < 256; L += F.G) {
        int tid = tid_; asm volatile("" : "+v"(tid));
        const int lane = tid & 63, r32 = lane & 31, hh = lane >> 5, wid = __builtin_amdgcn_readfirstlane(tid >> 6);
        const int voff = (4 * hh + ((lane & 15) >> 2)) * 64 + ((lane >> 4) & 1) * 32 + (lane & 3) * 8;
        const int bh = L >> 4, dkh = (L >> 3) & 1, e8 = L & 7, h = bh & 3;
        const float lgh = h == 0 ? lg2[0] : h == 1 ? lg2[1] : h == 2 ? lg2[2] : lg2[3];
        const float gC = __builtin_amdgcn_exp2f(128.f * lgh);
        const int trow = lane >> 2, chl = lane & 3;
        const bf16* ksrc0 = PROJ + (size_t)T * 1024 + ((size_t)bh * SEQ + 16 * ((2 * wid) & 3) + trow) * 256 + dkh * 128 + ((2 * wid) >> 2) * 32 + chl * 8;
        const bf16* ksrc1 = PROJ + (size_t)T * 1024 + ((size_t)bh * SEQ + 16 * ((2 * wid + 1) & 3) + trow) * 256 + dkh * 128 + ((2 * wid + 1) >> 2) * 32 + chl * 8;
        const bf16* vsrc = PROJ + (size_t)2 * T * 1024 + ((size_t)bh * SEQ + 16 * (wid & 3) + trow) * 512 + e8 * 64 + (wid >> 2) * 32 + chl * 8;
        const unsigned ldsb = (unsigned)(uintptr_t)lds;
#define RS_DMA(m, slot) do { const size_t mk_ = (size_t)(m) * 64 * 256, mv_ = (size_t)(m) * 64 * 512; const unsigned sb_ = ldsb + (unsigned)(slot) * 24576u; \
        glds16(ksrc0 + mk_, (unsigned)__builtin_amdgcn_readfirstlane(sb_ + (2 * wid) * 1024)); glds16(ksrc1 + mk_, (unsigned)__builtin_amdgcn_readfirstlane(sb_ + (2 * wid + 1) * 1024)); \
        glds16(vsrc + mv_, (unsigned)__builtin_amdgcn_readfirstlane(sb_ + 16384 + wid * 1024)); } while (0)
        f32x16 st = (f32x16){0.f, 0.f, 0.f, 0.f, 0.f, 0.f, 0.f, 0.f, 0.f, 0.f, 0.f, 0.f, 0.f, 0.f, 0.f, 0.f};
        const int el = (wid >> 2) * 32 + r32;
        bf16* stg = ST + ((size_t)bh * 64 * 512 + e8 * 64) * 256 + dkh * 128;
        RS_DMA(0, 0); RS_DMA(1, 1); RS_DMA(2, 2);
#pragma unroll 1
        for (int m = 0; m < 128; ++m) {
            const int slot = m & 3, n = m >> 1;
            if (m >= 3 && m + 2 < 128) asm volatile("s_waitcnt vmcnt(8) lgkmcnt(0)\n\ts_barrier" ::: "memory");
            else if (m + 2 < 128) asm volatile("s_waitcnt vmcnt(6) lgkmcnt(0)\n\ts_barrier" ::: "memory");
            else if (m + 1 < 128) asm volatile("s_waitcnt vmcnt(3) lgkmcnt(0)\n\ts_barrier" ::: "memory");
            else asm volatile("s_waitcnt vmcnt(0) lgkmcnt(0)\n\ts_barrier" ::: "memory");
            if (m + 3 < 128) RS_DMA(m + 3, (m + 3) & 3);
            if ((m & 1) == 0) {
                const int bf = n & 1;
                if (n > 0) {
#pragma unroll
                    for (int k2 = 0; k2 < 2; ++k2) { const int p = tid + 512 * k2, e = p >> 4, c = (p & 15) ^ (e & 15);
                        *(GAS v4u*)(stg + ((size_t)(n - 1) * 512 + e) * 256 + c * 8) = *(const LAS v4u*)(lds + 98304 + (bf ^ 1) * 16384 + p * 16); } }
#pragma unroll
                for (int g4 = 0; g4 < 4; ++g4) { v2u w; w.x = pk2(st[4 * g4], st[4 * g4 + 1]); w.y = pk2(st[4 * g4 + 2], st[4 * g4 + 3]);
                    *(LAS v2u*)(lds + 98304 + bf * 16384 + el * 256 + ((((wid & 3) * 4 + g4) ^ (el & 15)) * 16) + hh * 8) = w; }
            }
            LAS const unsigned char* kb = lds + slot * 24576 + (wid & 3) * 4096; LAS const unsigned char* vb = lds + slot * 24576 + 16384 + (wid >> 2) * 4096;
#pragma unroll
            for (int s = 0; s < 4; ++s) { const bf16x8 a = cat8(vtr(kb + s * 1024 + voff), vtr(kb + s * 1024 + 512 + voff)), bb = cat8(vtr(vb + s * 1024 + voff), vtr(vb + s * 1024 + 512 + voff));
                st = __builtin_amdgcn_mfma_f32_32x32x16_bf16(a, bb, st, 0, 0, 0); }
            if (m & 1) {
#pragma unroll
                for (int i = 0; i < 16; ++i) st[i] *= gC; }
        }
#undef RS_DMA
        asm volatile("s_waitcnt vmcnt(0) lgkmcnt(0)\n\ts_barrier" ::: "memory");
#pragma unroll
        for (int k2 = 0; k2 < 2; ++k2) { const int p = tid + 512 * k2, e = p >> 4, c = (p & 15) ^ (e & 15);
            *(GAS v4u*)(stg + ((size_t)63 * 512 + e) * 256 + c * 8) = *(const LAS v4u*)(lds + 98304 + 16384 + p * 16); }
        LDS_WAIT(); __syncthreads();
    }
}
__device__ __forceinline__ void ret_main_phase(Frame& F, const bf16* PROJ, const bf16* ST, bf16* AO) { LTID();
    LAS unsigned char* lds = F.lds;
    LAS float* part = (LAS float*)(lds + TBL_OFF + 512);
    for (int L = F.vcu * 4; L < 1024; L += F.G * 4) for (int uu = 0; uu < 4; ++uu) {
        int tid = tid_; asm volatile("" : "+v"(tid));
        const int lane = tid & 63, r32 = lane & 31, hh = lane >> 5, wid = __builtin_amdgcn_readfirstlane(tid >> 6), rg = wid & 3, e2 = wid >> 2;
        const int voff = (4 * hh + ((lane & 15) >> 2)) * 64 + ((lane >> 4) & 1) * 32 + (lane & 3) * 8;
        const int U = L + uu, bh = U >> 6, n = U & 63, b = bh >> 2, h = bh & 3;
        const size_t tokbase = (size_t)b * SEQ + (size_t)n * 128, hb0 = (size_t)bh * SEQ + (size_t)n * 128;
        const bf16* qrow = PROJ + (hb0 + rg * 32 + r32) * 256 + 8 * hh;
        const bf16* stb = ST + ((size_t)bh * 64 + n) * 512 * 256;
        const unsigned ldsb = (unsigned)(uintptr_t)lds + wid * 1024;
#define RM_WAITBAR() asm volatile("s_waitcnt vmcnt(0) lgkmcnt(0)\n\ts_barrier" ::: "memory")
#define RM_DMA_KS(buf) do { _Pragma("unroll") for (int i = 0; i < 8; ++i) { const int idx = tid + 512 * i, tok = idx >> 5, c = (idx & 31) ^ (tok & 31); \
        glds16(PROJ + (size_t)T * 1024 + (hb0 + tok) * 256 + c * 8, (unsigned)__builtin_amdgcn_readfirstlane(ldsb + (buf) * 65536 + i * 8192)); } } while (0)
#define RM_DMA_V(p, buf) do { _Pragma("unroll") for (int i = 0; i < 8; ++i) { const int idx = tid + 512 * i, tok = (idx >> 2) & 127; \
        glds16(PROJ + (size_t)2 * T * 1024 + (hb0 + tok) * 512 + (p) * 256 + (idx >> 9) * 32 + (idx & 3) * 8, (unsigned)__builtin_amdgcn_readfirstlane(ldsb + (buf) * 65536 + i * 8192)); } } while (0)
#define RM_DMA_ST(p, dkh, buf) do { _Pragma("unroll") for (int i = 0; i < 8; ++i) { const int idx = tid + 512 * i, e = idx >> 4, c = (idx & 15) ^ (e & 15); \
        glds16(stb + (size_t)((p) * 256 + e) * 256 + (dkh) * 128 + c * 8, (unsigned)__builtin_amdgcn_readfirstlane(ldsb + (buf) * 65536 + i * 8192)); } } while (0)
        RM_DMA_KS(0);
        bf16x8 pa[4][2];
        {
            bf16x8 qf[16];
#pragma unroll
            for (int s = 0; s < 16; ++s) qf[s] = *(const GAS bf16x8*)(qrow + 16 * s);
            RM_WAITBAR();
            asm volatile("" :: "v"(qf[0]), "v"(qf[1]), "v"(qf[2]), "v"(qf[3]), "v"(qf[4]), "v"(qf[5]), "v"(qf[6]), "v"(qf[7]), "v"(qf[8]), "v"(qf[9]), "v"(qf[10]), "v"(qf[11]), "v"(qf[12]), "v"(qf[13]), "v"(qf[14]), "v"(qf[15]));
            RM_DMA_V(0, 1);
#pragma unroll
            for (int jb = 0; jb < 4; ++jb) {
                f32x16 S = (f32x16){0.f, 0.f, 0.f, 0.f, 0.f, 0.f, 0.f, 0.f, 0.f, 0.f, 0.f, 0.f, 0.f, 0.f, 0.f, 0.f};
                if (jb <= rg) {
#pragma unroll
                    for (int s = 0; s < 16; ++s) { const bf16x8 a = *(const LAS bf16x8*)(lds + (32 * jb + r32) * 512 + (((2 * s + hh) ^ r32) * 16)); S = __builtin_amdgcn_mfma_f32_32x32x16_bf16(a, qf[s], S, 0, 0, 0); }
                    if (jb == rg) {
#pragma unroll
                        for (int i = 0; i < 16; ++i) if (crow(i, hh) > r32) S[i] = 0.f; }
                }
                pa[jb][0] = pack8f(S[0], S[1], S[2], S[3], S[4], S[5], S[6], S[7]); pa[jb][1] = pack8f(S[8], S[9], S[10], S[11], S[12], S[13], S[14], S[15]);
            }
        }
        f32x16 o[8];
#pragma unroll
        for (int eb = 0; eb < 8; ++eb) o[eb] = (f32x16){0.f, 0.f, 0.f, 0.f, 0.f, 0.f, 0.f, 0.f, 0.f, 0.f, 0.f, 0.f, 0.f, 0.f, 0.f, 0.f};
#define RM_PV(BUF, OB) do { _Pragma("unroll") for (int jb = 0; jb < 4; ++jb) if (jb <= rg) { _Pragma("unroll") for (int s2 = 0; s2 < 2; ++s2) { \
            _Pragma("unroll") for (int j = 0; j < 4; ++j) { LAS const unsigned char* vb = lds + (BUF) * 65536 + (e2 * 4 + j) * 8192 + (32 * jb + 16 * s2) * 64 + voff; \
                o[(OB) + j] = __builtin_amdgcn_mfma_f32_32x32x16_bf16(pa[jb][s2], cat8(vtr(vb), vtr(vb + 512)), o[(OB) + j], 0, 0, 0); } \
            __builtin_amdgcn_sched_barrier(0); } } } while (0)
#define RM_QA(DKH) do { _Pragma("unroll") for (int sl = 0; sl < 8; ++sl) qa[sl] = *(const GAS bf16x8*)(qrow + 16 * ((DKH) * 8 + sl)); } while (0)
#define RM_QA_USE() asm volatile("" :: "v"(qa[0]), "v"(qa[1]), "v"(qa[2]), "v"(qa[3]), "v"(qa[4]), "v"(qa[5]), "v"(qa[6]), "v"(qa[7]))
#define RM_CROSS(BUF, OB) do { \
            _Pragma("unroll") for (int sl = 0; sl < 8; ++sl) { \
                _Pragma("unroll") for (int j = 0; j < 4; ++j) { const bf16x8 bb = *(const LAS bf16x8*)(lds + (BUF) * 65536 + ((e2 * 4 + j) * 32 + r32) * 256 + (((2 * sl + hh) ^ (r32 & 15)) * 16)); \
                    o[(OB) + j] = __builtin_amdgcn_mfma_f32_32x32x16_bf16(qa[sl], bb, o[(OB) + j], 0, 0, 0); } \
                __builtin_amdgcn_sched_barrier(0); } } while (0)
        bf16x8 qa[8];
        RM_WAITBAR(); RM_DMA_V(1, 0);      RM_PV(1, 0);
        RM_WAITBAR(); RM_DMA_ST(0, 0, 1);  RM_PV(0, 4);
        RM_QA(0); RM_WAITBAR(); RM_QA_USE(); RM_DMA_ST(0, 1, 0);  RM_CROSS(1, 0);
        RM_QA(1); RM_WAITBAR(); RM_QA_USE(); RM_DMA_ST(1, 0, 1);  RM_CROSS(0, 0);
        RM_QA(0); RM_WAITBAR(); RM_QA_USE(); RM_DMA_ST(1, 1, 0);  RM_CROSS(1, 4);
        RM_QA(1); RM_WAITBAR(); RM_QA_USE();                      RM_CROSS(0, 4);
#undef RM_QA
#undef RM_QA_USE
#undef RM_DMA_KS
#undef RM_DMA_V
#undef RM_DMA_ST
#undef RM_PV
#undef RM_CROSS
#pragma unroll
        for (int i = 0; i < 16; ++i) { float s1 = 0.f, s2 = 0.f;
#pragma unroll
            for (int eb = 0; eb < 8; ++eb) { s1 += o[eb][i]; s2 += o[eb][i] * o[eb][i]; }
            s1 = half_sum32(s1); s2 = half_sum32(s2);
            if (r32 == 0) { part[(e2 * 128 + rg * 32 + crow(i, hh)) * 2] = s1; part[(e2 * 128 + rg * 32 + crow(i, hh)) * 2 + 1] = s2; } }
        asm volatile("s_waitcnt lgkmcnt(0)\n\ts_barrier" ::: "memory");
#undef RM_WAITBAR
#pragma unroll
        for (int i = 0; i < 16; ++i) { const int rl = rg * 32 + crow(i, hh);
            const float s1 = part[rl * 2] + part[(128 + rl) * 2], s2 = part[rl * 2 + 1] + part[(128 + rl) * 2 + 1];
            const float mean = s1 * (1.f / 512.f), var = __builtin_fmaxf(s2 * (1.f / 512.f) - mean * mean, 0.f), rstd = 1.f / sqrtf(var + LN_EPS);
            LAS bf16* tp = (LAS bf16*)(lds + rl * 1024) + e2 * 128 + r32;
#pragma unroll
            for (int eb = 0; eb < 8; ++eb) tp[(eb >> 2) * 256 + (eb & 3) * 32] = (bf16)f2bf((o[eb][i] - mean) * rstd); }
        v4u gv[16];
#pragma unroll
        for (int k = 0; k < 16; ++k) { const int p = tid + 512 * k, row = p >> 6, c16 = p & 63; gv[k] = __builtin_nontemporal_load((const GAS v4u*)(PROJ + (size_t)4 * T * 1024 + (hb0 + row) * 512 + c16 * 8)); }
        __builtin_amdgcn_sched_barrier(0);
        LDS_WAIT(); __syncthreads();
#pragma unroll
        for (int k = 0; k < 16; ++k) { const int p = tid + 512 * k, row = p >> 6, c16 = p & 63;
            const v4u ov = *(const LAS v4u*)(lds + p * 16); v4u r;
#pragma unroll
            for (int q = 0; q < 4; ++q) { const float g0 = bflo(gv[k][q]), g1 = bfhi(gv[k][q]);
                const float s0 = g0 * __builtin_amdgcn_rcpf(1.0f + __builtin_amdgcn_exp2f(-g0 * LOG2E)), s1 = g1 * __builtin_amdgcn_rcpf(1.0f + __builtin_amdgcn_exp2f(-g1 * LOG2E));
                r[q] = pk2(bflo(ov[q]) * s0, bfhi(ov[q]) * s1); }
            *(GAS v4u*)(AO + (tokbase + row) * 2048 + h * 512 + c16 * 8) = r; }
        LDS_WAIT(); __syncthreads();
    }
}
struct Args { const float* in[20]; float* out; unsigned char* ws; int ph_lo, ph_hi; };
constexpr int N_PHASES = 1 + 2 * (3 + 4) + 2 * (4 + 4);

__global__ void __launch_bounds__(NWAVES * 64, 2) mega_fwd(Args args) {
    extern __shared__ __attribute__((aligned(16))) unsigned char lds[];
    Frame F;
    F.lds = (LAS unsigned char*)lds;
    F.MISC = (volatile LAS unsigned*)(F.lds + MISC_OFF);
    F.G = gridDim.x; { const int bx = blockIdx.x; F.vcu = (F.G % 8 == 0) ? (bx % 8) * (F.G / 8) + bx / 8 : bx; }
    F.ctl = (gu32*)(args.ws + WS_CTL);
    for (int u = threadIdx.x; u < (LDS_BYTES - RING_BYTES) / 4; u += NWAVES * 64) ((LAS unsigned*)(F.lds + RING_BYTES))[u] = 0u;
    __syncthreads();
    if ((threadIdx.x & 63) == 0) *(LAS int*)(F.lds + WAVETBL_OFF + ((int)__builtin_amdgcn_s_getreg((5 << 11) | 4) & 63) * 4) = (int)(threadIdx.x >> 6);
    __syncthreads();
    XcdBarrier bar = xcd_barrier_post((unsigned*)(F.ctl + CW_BAR), F.MISC + 8);

    typedef __attribute__((address_space(4))) const unsigned char* kptr_t;
#define KP() kptr_t kp_ = (kptr_t)__builtin_amdgcn_kernarg_segment_ptr(); asm volatile("" : "+s"(kp_))
#define IN_(i) ((const float*)(*(const GAS float* __attribute__((address_space(4))) const*)(kp_ + 8 * (i))))
#define OUT_() ((float*)(*(GAS float* __attribute__((address_space(4))) const*)(kp_ + 160)))
#define WS_(off) ((unsigned char*)(*(GAS unsigned char* __attribute__((address_space(4))) const*)(kp_ + 168)) + (off))
    const int lo = args.ph_lo, hi = args.ph_hi;
    int ph = 0;
#define RUN() (lo <= ph && ph < hi)
#define REP(k) for (int rep_ = 0; rep_ < ((PROBE_DOUBLE == (k)) ? 2 : 1); ++rep_)
#define SEAM() do { for (int sr_ = 0; sr_ < ((PROBE_DOUBLE == 10) ? 2 : 1); ++sr_) if (ph + 1 < hi) { XcdBarrier b_ = bar; asm volatile("" : "+s"(b_.bar), "+s"(b_.x)); b_.bar = (unsigned*)(GAS unsigned*)b_.bar; xcd_barrier(b_); } } while (0)

    if (RUN()) {
        REP(1) { KP();
        p0_family<0>(F, IN_(1), (bf16*)WS_(WS_WDAIN), 2, D, 3072);
        p0_family<0>(F, IN_(2), (bf16*)WS_(WS_WDAOUT), 2, D, D);
        p0_family<0>(F, IN_(8), (bf16*)WS_(WS_WRETIN), 2, D, 6144);
        p0_family<0>(F, IN_(9), (bf16*)WS_(WS_WRETOUT), 2, 2048, D);
        p0_router_image(F, IN_(10), WS_(WS_WIMG));
        p0_x_to_bf16(F, IN_(0), (bf16*)WS_(WS_XB)); }
        SEAM();
    }
    ++ph;

#pragma unroll 1
    for (int layer = 0; layer < DEPTH; ++layer) {
        const int jm = layer >> 1;
        if ((layer & 1) == 0) {
            if (RUN()) {
                KP(); pg8::Gemm g{(bf16*)WS_(WS_XB), (bf16*)WS_(WS_WDAIN) + (size_t)jm * 3072 * D, T, 3072, D}; pg8::StaticOrder S; S.init(T, 3072, F.G, (int)blockIdx.x);
                pg8::EpiScaleBf16 E{(bf16*)WS_(WS_PROJ), 3072, 1024, 0.125f * LOG2E, (unsigned*)(GAS unsigned*)(F.ctl + CW_KMAX + jm * 256)};

REP(2) {
pg8::gemm_phase<pg8::EpiScaleBf16, pg8::StaticOrder, PG8_ALIGN, PG8_SP2>(F.lds, g, S, E);
}

                SEAM();
            }
            ++ph;
            if (RUN()) {
                KP(); float d1 = 0.f, d2 = 0.f;
                { const float* lq1 = IN_(3) + jm * 64; const float* lk1 = IN_(4) + jm * 64; const float* lq2 = IN_(5) + jm * 64; const float* lk2 = IN_(6) + jm * 64;
                  for (int i = 0; i < 64; ++i) { d1 += lq1[i] * lk1[i]; d2 += lq2[i] * lk2[i]; } }
                const float li = (layer == 0) ? 0.2f : 0.47071301834148437f;
                const float lam = __expf(d1) - __expf(d2) + li;

REP(3)
                {
                  const int l0 = (layer == 0) ? 0 : 2, nl = 2;
                  const ConvJob cj{IN_(12) + (size_t)l0 * NEXP * D * 2 * FF, (bf16*)WS_(WS_WGU) + (size_t)l0 * NEXP * D * 2 * FF, IN_(14) + (size_t)l0 * NEXP * FF * D, (bf16*)WS_(WS_WDN) + (size_t)l0 * NEXP * FF * D, (rep_ == 0) ? nl * NEXP : 0, 2};
                  da_attn_phase(F, (const bf16*)WS_(WS_PROJ), (bf16*)WS_(WS_AO), lam, 1.0f - li, IN_(7) + jm * 128, (const unsigned*)(GAS unsigned*)(F.ctl + CW_KMAX + jm * 256), F.ctl + CW_QCTR + jm * 64 + rep_ * 8, cj); }

                SEAM();
            }
            ++ph;
            if (RUN()) {
                KP(); pg8::Gemm g{(bf16*)WS_(WS_AO), (bf16*)WS_(WS_WDAOUT) + (size_t)jm * D * D, T, D, D}; pg8::StaticOrder S; S.init(T, D, F.G, (int)blockIdx.x);
                pg8::EpiRes E{(bf16*)WS_(WS_XB), (bf16*)WS_(WS_Y), D, DN_ALPHA, (float*)WS_(WS_STATS)};

REP(2) {
pg8::gemm_phase<pg8::EpiRes, pg8::StaticOrder, PG8_ALIGN, PG8_SP2>(F.lds, g, S, E);
}

                SEAM();
            }
            ++ph;
        } else {
            const float lg2[4] = {-0.045803689613124784f, -0.022720076500083584f, -0.011315313227834068f, -0.0056465631411835116f};
            if (RUN()) {
                KP(); pg8::Gemm g{(bf16*)WS_(WS_XB), (bf16*)WS_(WS_WRETIN) + (size_t)jm * 6144 * D, T, 6144, D}; pg8::StaticOrder S; S.init(T, 6144, F.G, (int)blockIdx.x);
                pg8::EpiRetProj E{(bf16*)WS_(WS_PROJ), 6144, {lg2[0], lg2[1], lg2[2], lg2[3]}};

REP(2) {
pg8::gemm_phase<pg8::EpiRetProj, pg8::StaticOrder, PG8_ALIGN, PG8_SP2>(F.lds, g, S, E);
}

                SEAM();
            }
            ++ph;
            if (RUN()) {
 KP(); REP(4) ret_scan_phase(F, (const bf16*)WS_(WS_PROJ), (bf16*)WS_(WS_STATE), lg2);
 SEAM(); }
            ++ph;
            if (RUN()) {
 KP(); REP(5) ret_main_phase(F, (const bf16*)WS_(WS_PROJ), (const bf16*)WS_(WS_STATE), (bf16*)WS_(WS_AO));
 SEAM(); }
            ++ph;
            if (RUN()) {
                KP(); pg8::Gemm g{(bf16*)WS_(WS_AO), (bf16*)WS_(WS_WRETOUT) + (size_t)jm * D * 2048, T, D, 2048}; pg8::StaticOrder S; S.init(T, D, F.G, (int)blockIdx.x);
                pg8::EpiRes E{(bf16*)WS_(WS_XB), (bf16*)WS_(WS_Y), D, DN_ALPHA, (float*)WS_(WS_STATS)};

REP(2) {
pg8::gemm_phase<pg8::EpiRes, pg8::StaticOrder, PG8_ALIGN, PG8_SP2>(F.lds, g, S, E);
}

                SEAM();
            }
            ++ph;
        }
        gu32* cnt = F.ctl + CW_CNT + layer * NEXP * 64;
        if (RUN()) {

            KP();
            ln_router_phase(F, (const bf16*)WS_(WS_Y), (const float*)WS_(WS_STATS), IN_(16) + layer * D, IN_(17) + layer * D, (const unsigned char*)WS_(WS_WIMG) + (size_t)layer * 131072, IN_(11) + layer * NEXP, (bf16*)WS_(WS_XB), (int2*)WS_(WS_SLOT), cnt);
            SEAM();
        }
        ++ph;
        if (RUN()) {
            KP(); build_tables(F, cnt);
            pg8::Gemm g{(bf16*)WS_(WS_XB), (bf16*)WS_(WS_WGU) + (size_t)layer * NEXP * 2048 * D, MT_MAX * 256, 2048, D};
            GroupedOrder S{(const LAS int*)(F.lds + TBL_OFF), 8, 4, F.G, (int)blockIdx.x};
            pg8::EpiSwiGLU E{(bf16*)WS_(WS_ACT), IN_(13) + (size_t)layer * NEXP * 2048};

REP(6) {
pg8::gemm_phase<pg8::EpiSwiGLU, GroupedOrder, PG8_ALIGN, PG8_SP2, true>(F.lds, g, S, E, (const int2*)WS_(WS_SLOT), F.lds + TBL_OFF + 4096);
}

            SEAM();
        }
        ++ph;
        if (RUN()) {
            KP(); build_tables(F, cnt);
            pg8::Gemm g{(bf16*)WS_(WS_ACT), (bf16*)WS_(WS_WDN) + (size_t)layer * NEXP * D * FF, MT_MAX * 256, D, FF};
            GroupedOrder S{(const LAS int*)(F.lds + TBL_OFF), 4, 8, F.G, (int)blockIdx.x};
            pg8::EpiDown E{(bf16*)WS_(WS_YE), IN_(15) + (size_t)layer * NEXP * D, (const int2*)WS_(WS_SLOT), T * TOPK};

REP(6) {
pg8::gemm_phase<pg8::EpiDown, GroupedOrder, PG8_ALIGN, PG8_SP2>(F.lds, g, S, E);
}

            SEAM();
        }
        ++ph;
        if (RUN()) { KP(); combine_ln_phase(F, (const bf16*)WS_(WS_YE), IN_(18) + layer * D, IN_(19) + layer * D, (layer == DEPTH - 1) ? OUT_() : (float*)nullptr, (bf16*)WS_(WS_XB)); SEAM(); }
        ++ph;
    }
#undef RUN
#undef SEAM
}

extern "C" void kernel_launch(void* const* d_in, const int* in_sizes, int n_in, void* d_out, int out_size, void* d_ws, size_t ws_size, hipStream_t stream) {
    static int grid = 0;
    if (grid == 0) {
        if (n_in != 20 || in_sizes[0] != T * D || out_size != T * D || ws_size < WS_END) { fprintf(stderr, "kernel_launch: unexpected shapes (n_in %d, in0 %d, out %d, ws %zu); nothing launched\n", n_in, n_in > 0 ? in_sizes[0] : -1, out_size, ws_size); grid = -1; return; }
        int dev = 0, cus = 0, per_cu = 0;
        if (hipGetDevice(&dev) != hipSuccess || hipDeviceGetAttribute(&cus, hipDeviceAttributeMultiprocessorCount, dev) != hipSuccess) { grid = -1; return; }
        if (hipFuncSetAttribute((const void*)mega_fwd, hipFuncAttributeMaxDynamicSharedMemorySize, LDS_BYTES) != hipSuccess) { fprintf(stderr, "kernel_launch: hipFuncSetAttribute failed\n"); grid = -1; return; }
        if (hipOccupancyMaxActiveBlocksPerMultiprocessor(&per_cu, (const void*)mega_fwd, NWAVES * 64, LDS_BYTES) != hipSuccess || per_cu < 1)
            fprintf(stderr, "kernel_launch: note: occupancy query reports %d workgroups per CU\n", per_cu);
        (void)hipGetLastError();
        grid = cus;
    }
    if (grid < 0) return;
    if (hipMemsetAsync((char*)d_ws + WS_CTL, 0, CTL_ZERO_BYTES, stream) != hipSuccess) return;
    Args a{};
    for (int i = 0; i < 20; ++i) a.in[i] = (const float*)d_in[i];
    a.out = (float*)d_out; a.ws = (unsigned char*)d_ws;
#if MK_N_LAUNCHES == 1
    a.ph_lo = 0; a.ph_hi = N_PHASES;
    hipLaunchKernelGGL(mega_fwd, dim3(grid), dim3(NWAVES * 64), LDS_BYTES, stream, a);
#else
    for (int p = 0; p < N_PHASES; ++p) { a.ph_lo = p; a.ph_hi = p + 1; hipLaunchKernelGGL(mega_fwd, dim3(grid), dim3(NWAVES * 64), LDS_BYTES, stream, a); }
#endif
    const hipError_t le = hipPeekAtLastError();
    if (le != hipSuccess) fprintf(stderr, "kernel_launch: launch failed: %s\n", hipGetErrorName(le));
}
```

```cpp
#include <hip/hip_runtime.h>
#include <cstdio>
#include <cstdint>
constexpr int WAVETBL_OFF = 147456 - 256;
__device__ __forceinline__ int hw_tid(__attribute__((address_space(3))) unsigned char* lds0) {
    const int slot = (int)__builtin_amdgcn_s_getreg((5 << 11) | 4) & 63;
    const int wave = __builtin_amdgcn_readfirstlane(*(const __attribute__((address_space(3))) int*)(lds0 + WAVETBL_OFF + slot * 4));
    unsigned z = 0u; asm volatile("" : "+v"(z));
    int t = wave * 64 + (int)__builtin_amdgcn_mbcnt_hi(~0u, __builtin_amdgcn_mbcnt_lo(~0u, z));
    asm volatile("" : "+v"(t)); return t; }
template <int CTRL> __device__ __forceinline__ float dppf(float v) { return __builtin_bit_cast(float, __builtin_amdgcn_update_dpp(0, __builtin_bit_cast(int, v), CTRL, 0xF, 0xF, true)); }
__device__ __forceinline__ float swap16_other(float v, float& self) { float w; asm volatile("s_nop 1\n\tv_permlane16_swap_b32 %0, %1" : "=v"(w), "+v"(v) : "0"(v)); self = v; return w; }
__device__ __forceinline__ float swap32_other(float v, float& self) { float w; asm volatile("s_nop 1\n\tv_permlane32_swap_b32 %0, %1" : "=v"(w), "+v"(v) : "0"(v)); self = v; return w; }
__device__ __forceinline__ float row_sum16(float v) { v += dppf<0xB1>(v); v += dppf<0x4E>(v); v += dppf<0x141>(v); v += dppf<0x140>(v); return v; }
__device__ __forceinline__ float row_max16(float v) { v = __builtin_fmaxf(v, dppf<0xB1>(v)); v = __builtin_fmaxf(v, dppf<0x4E>(v)); v = __builtin_fmaxf(v, dppf<0x141>(v)); v = __builtin_fmaxf(v, dppf<0x140>(v)); return v; }
__device__ __forceinline__ float half_sum32(float v) { v = row_sum16(v); float a; const float b = swap16_other(v, a); return a + b; }
__device__ __forceinline__ float half_max32(float v) { v = row_max16(v); float a; const float b = swap16_other(v, a); return __builtin_fmaxf(a, b); }
__device__ __forceinline__ float wave_sum(float v) { v = half_sum32(v); float a; const float b = swap32_other(v, a); return a + b; }
__device__ __forceinline__ float wave_max(float v) { v = half_max32(v); float a; const float b = swap32_other(v, a); return __builtin_fmaxf(a, b); }
__device__ __forceinline__ float xor32_sum(float v) { float a; const float b = swap32_other(v, a); return a + b; }
__device__ __forceinline__ float xor32_max(float v) { float a; const float b = swap32_other(v, a); return __builtin_fmaxf(a, b); }
__device__ __forceinline__ float xor16_sum(float v) { float a; const float b = swap16_other(v, a); return a + b; }
namespace pg8 {
#define PG8_LAS __attribute__((address_space(3)))
typedef unsigned short bf16_t;
typedef short bf16x8 __attribute__((ext_vector_type(8)));
typedef float f32x4 __attribute__((ext_vector_type(4)));
typedef unsigned u32x4 __attribute__((ext_vector_type(4)));
constexpr int BM = 256, BK = 64, HALF = 128, HTB = HALF * BK * 2  , STAGE_BYTES = 8 * HTB, NXCD = 8, WGM = 4;

__host__ __device__ __forceinline__ int lds_byte(int r, int c) { const int st = (r >> 4) * 2 + (c >> 5), rr = r & 15, cc = c & 31, ob = rr * 64 + cc * 2; return st * 1024 + (ob ^ (((ob >> 9) & 1) << 5)); }
__host__ __device__ __forceinline__ void stage_rc(int b, int& R, int& C) { const int st = b / 1024, sb = b % 1024, swz = sb ^ (((sb >> 9) & 1) << 5); R = (st >> 1) * 16 + swz / 64; C = (st & 1) * 32 + (swz % 64) / 2; }
__host__ __device__ __forceinline__ int perm32(int rho) { const int n = rho >> 4, i = rho & 15; return 8 * (i >> 2) + 4 * n + (i & 3); }

struct Unit { int pm, pn, pb, aux, rows, lt; };
struct Gemm { const bf16_t* A; const bf16_t* Bt; int M, N, K; };

struct StaticOrder {
    int nM, nN, nwg, G, c;
    __host__ __device__ void init(int M, int N, int G_, int c_) { nM = M / BM; nN = N / BM; nwg = nM * nN; G = G_; c = c_; }
    __host__ __device__ bool next(int i, Unit& u) const {
        const long L = (long)i * G + c; if (L >= nwg) return false;
        int wgid = (int)L; { const int q = nwg / NXCD, r = nwg % NXCD, xcd = wgid % NXCD, off = wgid / NXCD; wgid = (xcd < r ? xcd * (q + 1) : r * (q + 1) + (xcd - r) * q) + off; }
        const int nig = WGM * nN, gid = wgid / nig, fm = gid * WGM, gsz = (nM - fm) < WGM ? (nM - fm) : WGM;
        u.pm = fm + ((wgid % nig) % gsz); u.pn = (wgid % nig) / gsz; u.pb = u.pn; u.aux = 0; u.rows = BM; u.lt = 0; return true;
    }
    __device__ __forceinline__ void a_ready(const Unit&) const {}
    __device__ __forceinline__ void done(const Unit&) const {}
};

__device__ __forceinline__ unsigned cvt_pk_bf16(float lo, float hi) { unsigned r; asm volatile("v_cvt_pk_bf16_f32 %0, %1, %2" : "=v"(r) : "v"(lo), "v"(hi)); return r; }
__device__ __forceinline__ u32x4 pack8(const f32x4 v0, const f32x4 v1) { u32x4 w; w.x = cvt_pk_bf16(v0[0], v0[1]); w.y = cvt_pk_bf16(v0[2], v0[3]); w.z = cvt_pk_bf16(v1[0], v1[1]); w.w = cvt_pk_bf16(v1[2], v1[3]); return w; }

struct EpiScaleBf16 {
    static constexpr bool PERM = true, AFTER_DRAIN = false;
    struct Pre {}; __device__ __forceinline__ void preload(Pre&, const Unit&, int, int, int, int) const {}
    __device__ __forceinline__ void init(f32x4 (&acc)[2][2][4][2], const Pre&) const {
#pragma unroll
        for (int a = 0; a < 2; ++a)
#pragma unroll
            for (int b = 0; b < 2; ++b)
#pragma unroll
                for (int m = 0; m < 4; ++m)
#pragma unroll
                    for (int n = 0; n < 2; ++n) acc[a][b][m][n] = (f32x4){0.f, 0.f, 0.f, 0.f}; }
    bf16_t* O; int ldc; int qcols; float qscale; unsigned* kmax;
    __device__ __forceinline__ void operator()(const f32x4 (&acc)[2][2][4][2], const Unit& u, int wr, int wc, int fr, int fq) const {
        const int row0 = u.pm * BM + wr * 64 + fr, col0 = u.pn * BM + wc * 32 + 8 * fq;
        if (u.pn >= 4 && u.pn < 8) {
#pragma unroll
            for (int bj = 0; bj < 2; ++bj) { float mx = 0.f;
#pragma unroll
                for (int ai = 0; ai < 2; ++ai)
#pragma unroll
                    for (int m = 0; m < 4; ++m) { const f32x4 a = acc[ai][bj][m][0], c = acc[ai][bj][m][1];
                        float ss = (a[0] * a[0] + a[1] * a[1]) + (a[2] * a[2] + a[3] * a[3]) + (c[0] * c[0] + c[1] * c[1]) + (c[2] * c[2] + c[3] * c[3]);
                        ss = xor32_sum(xor16_sum(ss)); mx = __builtin_fmaxf(mx, ss); }
                mx = row_max16(mx);
                if (fr == 0 && fq == 0) { const int b = u.pm >> 5, hm = (u.pn - 4) * 4 + bj * 2 + (wc >> 1);
                    __hip_atomic_fetch_max(kmax + ((b * 16 + hm) * 2 + (wc & 1)), __builtin_bit_cast(unsigned, mx), __ATOMIC_RELAXED, __HIP_MEMORY_SCOPE_AGENT); } }
        }
#pragma unroll
        for (int ai = 0; ai < 2; ++ai)
#pragma unroll
            for (int m = 0; m < 4; ++m) { bf16_t* rowp = O + (size_t)(row0 + ai * HALF + m * 16) * ldc + col0;
#pragma unroll
                for (int bj = 0; bj < 2; ++bj) { const float sc = (col0 + bj * HALF) < qcols ? qscale : 1.f;
                    *(u32x4*)(rowp + bj * HALF) = pack8(acc[ai][bj][m][0] * sc, acc[ai][bj][m][1] * sc); } }
    }
};

struct EpiRetProj {
    static constexpr bool PERM = true, AFTER_DRAIN = false;
    struct Pre {}; __device__ __forceinline__ void preload(Pre&, const Unit&, int, int, int, int) const {}
    __device__ __forceinline__ void init(f32x4 (&acc)[2][2][4][2], const Pre&) const {
#pragma unroll
        for (int a = 0; a < 2; ++a)
#pragma unroll
            for (int b = 0; b < 2; ++b)
#pragma unroll
                for (int m = 0; m < 4; ++m)
#pragma unroll
                    for (int n = 0; n < 2; ++n) acc[a][b][m][n] = (f32x4){0.f, 0.f, 0.f, 0.f}; }
    bf16_t* O; int ldc; float lg2[4];
    __device__ __forceinline__ void operator()(const f32x4 (&acc)[2][2][4][2], const Unit& u, int wr, int wc, int fr, int fq) const {
        const int row0 = u.pm * BM + wr * 64 + fr, cl = wc * 32 + 8 * fq;
#pragma unroll
        for (int bj = 0; bj < 2; ++bj) {
            const int c0 = u.pn * BM + bj * HALF, sect = c0 >> 10;
            int head, width, colh; size_t base;
            if (sect < 2) { head = (c0 >> 8) & 3; width = 256; colh = (c0 & 255) + cl; base = (size_t)sect * 33554432; }
            else if (sect < 4) { head = (c0 - 2048) >> 9; width = 512; colh = ((c0 - 2048) & 511) + cl; base = (size_t)2 * 33554432; }
            else { head = (c0 - 4096) >> 9; width = 512; colh = ((c0 - 4096) & 511) + cl; base = (size_t)4 * 33554432; }
            const float lg = head == 0 ? lg2[0] : head == 1 ? lg2[1] : head == 2 ? lg2[2] : lg2[3];
#pragma unroll
            for (int ai = 0; ai < 2; ++ai)
#pragma unroll
                for (int m = 0; m < 4; ++m) { const int row = row0 + ai * HALF + m * 16; const float jp = (float)((row & 127) + 1);
                    float sc = 1.f; if (sect == 0) sc = __builtin_amdgcn_exp2f(jp * lg); else if (sect == 1) sc = 0.0625f * __builtin_amdgcn_exp2f(-jp * lg);
                    const size_t off = base + ((size_t)(((row >> 13) * 4 + head) * 8192 + (row & 8191))) * width + colh;
                    *(u32x4*)(O + off) = pack8(acc[ai][bj][m][0] * sc, acc[ai][bj][m][1] * sc); } }
    }
};

struct EpiRes {
    static constexpr bool PERM = false, AFTER_DRAIN = false;
    struct Pre {}; __device__ __forceinline__ void preload(Pre&, const Unit&, int, int, int, int) const {}
    __device__ __forceinline__ void init(f32x4 (&acc)[2][2][4][2], const Pre&) const {
#pragma unroll
        for (int a = 0; a < 2; ++a)
#pragma unroll
            for (int b = 0; b < 2; ++b)
#pragma unroll
                for (int m = 0; m < 4; ++m)
#pragma unroll
                    for (int n = 0; n < 2; ++n) acc[a][b][m][n] = (f32x4){0.f, 0.f, 0.f, 0.f}; }
    const bf16_t* XB; bf16_t* Y; int ldc; float alpha; float* STATS;
    __device__ __forceinline__ void operator()(const f32x4 (&acc)[2][2][4][2], const Unit& u, int wr, int wc, int fr, int fq) const {
        typedef unsigned u32x2 __attribute__((ext_vector_type(2)));
        const int row0 = u.pm * BM + wr * 64 + fr, col0 = u.pn * BM + wc * 32 + 4 * fq;
        u32x2 xr[2][4][2][2];
#pragma unroll
        for (int ai = 0; ai < 2; ++ai)
#pragma unroll
            for (int m = 0; m < 4; ++m) { const size_t off = (size_t)(row0 + ai * HALF + m * 16) * ldc + col0;
#pragma unroll
                for (int bj = 0; bj < 2; ++bj)
#pragma unroll
                    for (int n = 0; n < 2; ++n) xr[ai][m][bj][n] = *(const u32x2*)(XB + off + bj * HALF + n * 16); }
        __builtin_amdgcn_sched_barrier(0);
#pragma unroll
        for (int ai = 0; ai < 2; ++ai)
#pragma unroll
            for (int m = 0; m < 4; ++m) { const size_t off = (size_t)(row0 + ai * HALF + m * 16) * ldc + col0; float s1 = 0.f, s2 = 0.f;
#pragma unroll
                for (int bj = 0; bj < 2; ++bj)
#pragma unroll
                    for (int n = 0; n < 2; ++n) { const u32x2 xw = xr[ai][m][bj][n];
                        const f32x4 x = (f32x4){__builtin_bit_cast(float, xw.x << 16), __builtin_bit_cast(float, xw.x & 0xffff0000u), __builtin_bit_cast(float, xw.y << 16), __builtin_bit_cast(float, xw.y & 0xffff0000u)};
                        const f32x4 y = x * alpha + acc[ai][bj][m][n]; { u32x2 yw; yw.x = cvt_pk_bf16(y[0], y[1]); yw.y = cvt_pk_bf16(y[2], y[3]); *(u32x2*)(Y + off + bj * HALF + n * 16) = yw; }
                        s1 += (y[0] + y[1]) + (y[2] + y[3]); s2 += (y[0] * y[0] + y[1] * y[1]) + (y[2] * y[2] + y[3] * y[3]); }
                s1 = xor32_sum(xor16_sum(s1)); s2 = xor32_sum(xor16_sum(s2));
                if (fq == 0) { typedef float f32x2s __attribute__((ext_vector_type(2))); *(f32x2s*)(STATS + ((size_t)(row0 + ai * HALF + m * 16) * 16 + u.pn * 4 + wc) * 2) = (f32x2s){s1, s2}; } }
    }
};

struct EpiSwiGLU {
    static constexpr bool PERM = true, AFTER_DRAIN = false;
    bf16_t* ACT; const float* bgu;
    struct Pre { f32x4 v[4]; };
    __device__ __forceinline__ void preload(Pre& p, const Unit& u, int wr, int wc, int fr, int fq) const {
        const float* be = bgu + (size_t)u.aux * 2048 + u.pn * HALF + wc * 32 + 8 * fq;
        p.v[0] = *(const f32x4*)(be); p.v[1] = *(const f32x4*)(be + 4); p.v[2] = *(const f32x4*)(be + 1024); p.v[3] = *(const f32x4*)(be + 1028); }
    __device__ __forceinline__ void init(f32x4 (&acc)[2][2][4][2], const Pre& p) const {
#pragma unroll
        for (int a = 0; a < 2; ++a)
#pragma unroll
            for (int m = 0; m < 4; ++m) { acc[a][0][m][0] = p.v[0]; acc[a][0][m][1] = p.v[1]; acc[a][1][m][0] = p.v[2]; acc[a][1][m][1] = p.v[3]; } }
    __device__ __forceinline__ void operator()(const f32x4 (&acc)[2][2][4][2], const Unit& u, int wr, int wc, int fr, int fq) const {
        const int row0 = u.pm * BM + wr * 64 + fr, f0 = u.pn * HALF + wc * 32 + 8 * fq;
#pragma unroll
        for (int ai = 0; ai < 2; ++ai)
#pragma unroll
            for (int m = 0; m < 4; ++m) {
                f32x4 o[2];
#pragma unroll
                for (int n = 0; n < 2; ++n) { const f32x4 g4 = acc[ai][0][m][n], u4 = acc[ai][1][m][n];
#pragma unroll
                    for (int i = 0; i < 4; i += 2) {
                        typedef float f32x2p __attribute__((ext_vector_type(2)));
                        const f32x2p g = {__builtin_amdgcn_fmed3f(g4[i], -3.0e38f, 7.0f), __builtin_amdgcn_fmed3f(g4[i + 1], -3.0e38f, 7.0f)}, up = {__builtin_amdgcn_fmed3f(u4[i], -7.0f, 7.0f), __builtin_amdgcn_fmed3f(u4[i + 1], -7.0f, 7.0f)};
                        const f32x2p a = g * (f32x2p){-1.702f * 1.4426950408889634f, -1.702f * 1.4426950408889634f};
                        const f32x2p d = (f32x2p){__builtin_amdgcn_exp2f(a.x), __builtin_amdgcn_exp2f(a.y)} + (f32x2p){1.0f, 1.0f};
                        const f32x2p t = g * (f32x2p){__builtin_amdgcn_rcpf(d.x), __builtin_amdgcn_rcpf(d.y)};
                        const f32x2p r = __builtin_elementwise_fma(t, up, t); o[n][i] = r.x; o[n][i + 1] = r.y; } }
                *(u32x4*)(ACT + (size_t)(row0 + ai * HALF + m * 16) * 1024 + f0) = pack8(o[0], o[1]); }
    }
};

constexpr int GCAP_SLOTS = 32768;
struct EpiDown {
    static constexpr bool PERM = true, AFTER_DRAIN = false;
    struct Pre { f32x4 v[4]; };
    __device__ __forceinline__ void preload(Pre& p, const Unit& u, int wr, int wc, int fr, int fq) const {
        const float* be = bd + (size_t)u.aux * 1024 + u.pn * BM + wc * 32 + 8 * fq;
        p.v[0] = *(const f32x4*)(be); p.v[1] = *(const f32x4*)(be + 4); p.v[2] = *(const f32x4*)(be + HALF); p.v[3] = *(const f32x4*)(be + HALF + 4); }
    __device__ __forceinline__ void init(f32x4 (&acc)[2][2][4][2], const Pre& p) const {
#pragma unroll
        for (int bj = 0; bj < 2; ++bj)
#pragma unroll
            for (int a = 0; a < 2; ++a)
#pragma unroll
                for (int m = 0; m < 4; ++m) { acc[a][bj][m][0] = p.v[2 * bj]; acc[a][bj][m][1] = p.v[2 * bj + 1]; } }
    bf16_t* YE; const float* bd; const int2* SLOT; int dummy_row;
    __device__ __forceinline__ void operator()(const f32x4 (&acc)[2][2][4][2], const Unit& u, int wr, int wc, int fr, int fq) const {
        int rl0 = wr * 64 + fr; asm volatile("" : "+v"(rl0));
        const int col0 = u.pn * BM + wc * 32 + 8 * fq;
        int2 sr[2][4];
#pragma unroll
        for (int ai = 0; ai < 2; ++ai)
#pragma unroll
            for (int m = 0; m < 4; ++m) { const int rl = rl0 + ai * HALF + m * 16;
                sr[ai][m] = SLOT[(size_t)u.aux * GCAP_SLOTS + (size_t)u.lt * BM + (rl < u.rows ? rl : 0)]; }
        __builtin_amdgcn_sched_barrier(0);
#pragma unroll
        for (int ai = 0; ai < 2; ++ai)
#pragma unroll
            for (int m = 0; m < 4; ++m) { const int rl = rl0 + ai * HALF + m * 16; const bool ok = rl < u.rows;
                const int2 s = sr[ai][m]; const float w = __int_as_float(s.y); bf16_t* rowp = YE + (size_t)(ok ? s.x : dummy_row) * 1024 + col0;
#pragma unroll
                for (int bj = 0; bj < 2; ++bj) *(u32x4*)(rowp + bj * HALF) = pack8(acc[ai][bj][m][0] * w, acc[ai][bj][m][1] * w); }
    }
};

constexpr int GCAP = GCAP_SLOTS;
template <class Epi, class Sched, bool ALIGN_EPI = false, bool SP2 = false, bool GATHER = false>
__device__ __forceinline__ void gemm_phase(PG8_LAS unsigned char* lds, const Gemm g, const Sched& S, const Epi& E, const int2* gslot = nullptr, PG8_LAS unsigned char* gtab = nullptr) {
    static_assert(!GATHER || SP2, "the gather path is written for the SP2 loop only");
    const int tid = hw_tid(lds); const int wid = __builtin_amdgcn_readfirstlane(tid >> 6), lane = tid & 63, wr = wid >> 2, wc = wid & 3, fr = lane & 15, fq = lane >> 4;
    const int K = g.K, nt = K / BK;
    unsigned voffA[2], voffB[2];
#pragma unroll
    for (int i = 0; i < 2; ++i) { int R, C; stage_rc(tid * 16 + i * 8192, R, C); const int Rb = Epi::PERM ? ((R & ~31) + perm32(R & 31)) : R;
        voffA[i] = (unsigned)(R * K + C) * 2u; voffB[i] = (unsigned)(Rb * K + C) * 2u; }
    unsigned vC[2][2], vN[2][2]; int grl[2]; unsigned gcb[2];
#pragma unroll
    for (int i = 0; i < 2; ++i) { int R, C; stage_rc(tid * 16 + i * 8192, R, C); grl[i] = R; gcb[i] = (unsigned)C * 2u; }
#pragma unroll
    for (int h = 0; h < 2; ++h)
#pragma unroll
        for (int i = 0; i < 2; ++i) { vC[h][i] = 0u; vN[h][i] = 0u; }
#define PG8_GDMA(u, par) do { int gl_ = lane; asm volatile("" : "+v"(gl_));        \
        if (wid < 2) __builtin_amdgcn_global_load_lds((const unsigned*)((const char*)gslot + ((size_t)(u).aux * GCAP + (size_t)(u).lt * 256) * 8 + (size_t)(wid * 64 + gl_) * 16), \
        (PG8_LAS unsigned*)(gtab + (par) * 2048 + wid * 1024), 16, 0, 0); } while (0)
#define PG8_GREAD(dst, u, par) do { _Pragma("unroll") for (int h_ = 0; h_ < 2; ++h_) _Pragma("unroll") for (int i_ = 0; i_ < 2; ++i_) { const int rl_ = 128 * h_ + grl[i_]; \
        const int tk_ = *(const PG8_LAS int*)(gtab + (par) * 2048 + rl_ * 8); const unsigned tok_ = (rl_ < (u).rows) ? ((unsigned)tk_ >> 2) : 0u; dst[h_][i_] = tok_ * (unsigned)(K * 2) + gcb[i_]; } } while (0)
#define PG8_AH(h) (GATHER ? (size_t)0 : (size_t)(h) * hstep)
#define PG8_VA(arr, h) (GATHER ? arr[h] : voffA)
    const size_t kstep = (size_t)(BK * 2);
    const size_t hstep = (size_t)HALF * K * 2;
    const size_t tstep = 2 * hstep;
    const unsigned ldsw = (unsigned)wid * 1024u;
    const int aoff = lds_byte(wr * 64 + fr, fq * 8), boff = lds_byte(wc * 32 + fr, fq * 8);
#define PG8_SA(b, h) (((b) * 2 + (h)) * HTB)
#define PG8_SB(b, h) ((4 + (b) * 2 + (h)) * HTB)
#define PG8_STAGE(bufoff, gbase, voff) do { _Pragma("unroll") for (int _i = 0; _i < 2; ++_i) \
        __builtin_amdgcn_global_load_lds((const unsigned*)((const char*)(gbase) + (voff)[_i]), (PG8_LAS unsigned*)(lds + (bufoff) + ldsw + _i * 8192), 16, 0, 0); } while (0)
#define PG8_LDA(dst, b, h) do { _Pragma("unroll") for (int m = 0; m < 4; ++m) _Pragma("unroll") for (int k = 0; k < 2; ++k) dst[m][k] = *(const PG8_LAS bf16x8*)(lds + PG8_SA(b, h) + aoff + m * 2048 + k * 1024); } while (0)
#define PG8_LDB(dst, b, h) do { _Pragma("unroll") for (int n = 0; n < 2; ++n) _Pragma("unroll") for (int k = 0; k < 2; ++k) dst[n][k] = *(const PG8_LAS bf16x8*)(lds + PG8_SB(b, h) + boff + n * 2048 + k * 1024); } while (0)
#define PG8_MMA(ai, bj, At, Bt) do { __builtin_amdgcn_s_setprio(1); _Pragma("unroll") for (int m = 0; m < 4; ++m) _Pragma("unroll") for (int n = 0; n < 2; ++n) _Pragma("unroll") for (int k = 0; k < 2; ++k) \
        acc[ai][bj][m][n] = __builtin_amdgcn_mfma_f32_16x16x32_bf16(Bt[n][k], At[m][k], acc[ai][bj][m][n], 0, 0, 0); __builtin_amdgcn_s_setprio(0); } while (0)
#define PG8_WAIT_V(n) asm volatile("s_waitcnt vmcnt(" #n ")" ::: "memory")
#define PG8_WAIT_L(n) asm volatile("s_waitcnt lgkmcnt(" #n ")" ::: "memory")
#define PG8_BAR __builtin_amdgcn_s_barrier()
#define PG8_SCHED __builtin_amdgcn_sched_barrier(0)
    Unit cur, nxt; int ui = 0;
    if (!S.next(0, cur)) return;
    f32x4 acc[2][2][4][2];
    { typename Epi::Pre pre0; E.preload(pre0, cur, wr, wc, fr, fq); E.init(acc, pre0); }
    bf16x8 At[4][2], B0[2][2], B1[2][2];
    const char* cA = GATHER ? (const char*)g.A : (const char*)g.A + (size_t)cur.pm * tstep; const char* cB = (const char*)g.Bt + (size_t)cur.pb * tstep;
    if constexpr (GATHER) { PG8_GDMA(cur, 0); asm volatile("s_waitcnt vmcnt(0)" ::: "memory"); __syncthreads(); PG8_GREAD(vC, cur, 0); }
    S.a_ready(cur);
    if constexpr (SP2) {
        PG8_STAGE(PG8_SB(0, 0), cB, voffB); PG8_STAGE(PG8_SB(0, 1), cB + hstep, voffB); PG8_STAGE(PG8_SA(0, 0), cA, PG8_VA(vC, 0)); PG8_STAGE(PG8_SA(0, 1), cA + PG8_AH(1), PG8_VA(vC, 1));
        if (wr == 1) PG8_BAR;
        PG8_WAIT_V(2); PG8_BAR;
        PG8_STAGE(PG8_SB(1, 0), cB + kstep, voffB); PG8_STAGE(PG8_SA(1, 0), cA + kstep, PG8_VA(vC, 0)); PG8_STAGE(PG8_SB(1, 1), cB + hstep + kstep, voffB);
        PG8_WAIT_V(6); PG8_BAR;
    } else {
        PG8_STAGE(PG8_SB(0, 0), cB, voffB); PG8_STAGE(PG8_SA(0, 0), cA, voffA); PG8_STAGE(PG8_SB(0, 1), cB + hstep, voffB); PG8_STAGE(PG8_SA(0, 1), cA + hstep, voffA);
        if (wr == 1) PG8_BAR;
        PG8_WAIT_V(4); PG8_BAR;
        PG8_STAGE(PG8_SB(1, 0), cB + kstep, voffB); PG8_STAGE(PG8_SA(1, 0), cA + kstep, voffA); PG8_STAGE(PG8_SB(1, 1), cB + hstep + kstep, voffB);
        PG8_WAIT_V(6); PG8_BAR;
    }
    for (;;) {
        const bool has_next = S.next(ui + 1, nxt);
        if constexpr (GATHER) { if (has_next) PG8_GDMA(nxt, (ui + 1) & 1); }
        const char* nA = (has_next && !GATHER) ? (const char*)g.A + (size_t)nxt.pm * tstep : cA; const char* nB = has_next ? (const char*)g.Bt + (size_t)nxt.pb * tstep : cB;
        for (int t = 0; t < nt; t += 2) {
            const bool last = (t == nt - 2);
            const char* a1 = cA + (size_t)(t + 1) * kstep;
            const char* a2 = last ? nA : cA + (size_t)(t + 2) * kstep; const char* b2 = last ? nB : cB + (size_t)(t + 2) * kstep;
            const char* a3 = a2 + kstep; const char* b3 = b2 + kstep;
            if (last && has_next) S.a_ready(nxt);
            if constexpr (GATHER) { if (last) { if (has_next) { PG8_GREAD(vN, nxt, (ui + 1) & 1); } else { _Pragma("unroll") for (int h_ = 0; h_ < 2; ++h_) _Pragma("unroll") for (int i_ = 0; i_ < 2; ++i_) vN[h_][i_] = vC[h_][i_]; } } }
            unsigned vS[2][2];
#pragma unroll
            for (int h_ = 0; h_ < 2; ++h_)
#pragma unroll
                for (int i_ = 0; i_ < 2; ++i_) vS[h_][i_] = (GATHER && last) ? vN[h_][i_] : vC[h_][i_];
            if constexpr (SP2) {
            PG8_LDB(B0, 0, 0); PG8_LDB(B1, 0, 1); PG8_SCHED; PG8_LDA(At, 0, 0); PG8_STAGE(PG8_SA(1, 1), a1 + PG8_AH(1), PG8_VA(vC, 1));
            PG8_WAIT_V(8); PG8_WAIT_L(0); PG8_BAR; PG8_MMA(0, 0, At, B0); PG8_MMA(0, 1, At, B1); PG8_BAR; PG8_SCHED;
            PG8_LDA(At, 0, 1); PG8_STAGE(PG8_SB(0, 0), b2, voffB); PG8_STAGE(PG8_SB(0, 1), b2 + hstep, voffB); PG8_STAGE(PG8_SA(0, 0), a2, PG8_VA(vS, 0));
            PG8_WAIT_V(8); PG8_WAIT_L(0); PG8_BAR; PG8_MMA(1, 0, At, B0); PG8_MMA(1, 1, At, B1); PG8_BAR; PG8_SCHED;
            PG8_LDB(B0, 1, 0); PG8_LDB(B1, 1, 1); PG8_SCHED; PG8_LDA(At, 1, 0); PG8_STAGE(PG8_SA(0, 1), a2 + PG8_AH(1), PG8_VA(vS, 1));
            PG8_WAIT_V(8); PG8_WAIT_L(0); PG8_BAR; PG8_MMA(0, 0, At, B0); PG8_MMA(0, 1, At, B1); PG8_BAR; PG8_SCHED;
            PG8_LDA(At, 1, 1); PG8_STAGE(PG8_SB(1, 0), b3, voffB); PG8_STAGE(PG8_SB(1, 1), b3 + hstep, voffB); PG8_STAGE(PG8_SA(1, 0), a3, PG8_VA(vS, 0));
            PG8_WAIT_V(8); PG8_WAIT_L(0); PG8_BAR; PG8_MMA(1, 0, At, B0); PG8_MMA(1, 1, At, B1); PG8_BAR; PG8_SCHED;
            } else {
            PG8_LDB(B0, 0, 0); PG8_SCHED; PG8_LDA(At, 0, 0); PG8_STAGE(PG8_SA(1, 1), a1 + hstep, voffA);
            PG8_WAIT_L(8); PG8_BAR; PG8_WAIT_L(0); PG8_MMA(0, 0, At, B0); PG8_BAR; PG8_SCHED;
            PG8_LDB(B1, 0, 1); PG8_STAGE(PG8_SB(0, 0), b2, voffB);
            PG8_BAR; PG8_WAIT_L(0); PG8_MMA(0, 1, At, B1); PG8_BAR;
            PG8_LDA(At, 0, 1); PG8_STAGE(PG8_SA(0, 0), a2, voffA);
            PG8_BAR; PG8_WAIT_L(0); PG8_MMA(1, 0, At, B0); PG8_BAR; PG8_SCHED;
            PG8_STAGE(PG8_SB(0, 1), b2 + hstep, voffB);
            PG8_WAIT_V(6); PG8_BAR; PG8_MMA(1, 1, At, B1); PG8_BAR;
            PG8_LDB(B0, 1, 0); PG8_SCHED; PG8_LDA(At, 1, 0); PG8_STAGE(PG8_SA(0, 1), a2 + hstep, voffA);
            PG8_WAIT_L(8); PG8_BAR; PG8_WAIT_L(0); PG8_MMA(0, 0, At, B0); PG8_BAR; PG8_SCHED;
            PG8_LDB(B1, 1, 1); PG8_STAGE(PG8_SB(1, 0), b3, voffB);
            PG8_BAR; PG8_WAIT_L(0); PG8_MMA(0, 1, At, B1); PG8_BAR;
            PG8_LDA(At, 1, 1); PG8_STAGE(PG8_SA(1, 0), a3, voffA);
            PG8_BAR; PG8_WAIT_L(0); PG8_MMA(1, 0, At, B0); PG8_BAR; PG8_SCHED;
            PG8_STAGE(PG8_SB(1, 1), b3 + hstep, voffB);
            PG8_WAIT_V(6); PG8_BAR; PG8_MMA(1, 1, At, B1); PG8_BAR;
            }
        }
        if constexpr (ALIGN_EPI) { if (wr == 0) PG8_BAR; }
        typename Epi::Pre pre; E.preload(pre, has_next ? nxt : cur, wr, wc, fr, fq); __builtin_amdgcn_sched_barrier(0);
        if constexpr (!Epi::AFTER_DRAIN) { E(acc, cur, wr, wc, fr, fq); S.done(cur); }
        if (!has_next) break;
        E.init(acc, pre);
        cur = nxt; cA = nA; cB = nB; ++ui;
        if constexpr (GATHER) { _Pragma("unroll") for (int h_ = 0; h_ < 2; ++h_) _Pragma("unroll") for (int i_ = 0; i_ < 2; ++i_) vC[h_][i_] = vN[h_][i_]; }
        if constexpr (ALIGN_EPI) { if (wr == 1) PG8_BAR; }
    }
    PG8_WAIT_V(0);
    if constexpr (!ALIGN_EPI) { if (wr == 0) PG8_BAR; }
    PG8_BAR;
    if constexpr (Epi::AFTER_DRAIN) { E.fused(acc, cur, wr, wc, fr, fq, lds, wid, lane); S.done(cur); }
#undef PG8_SA
#undef PG8_GDMA
#undef PG8_GREAD
#undef PG8_AH
#undef PG8_VA
#undef PG8_SB
#undef PG8_STAGE
#undef PG8_LDA
#undef PG8_LDB
#undef PG8_MMA
#undef PG8_WAIT_V
#undef PG8_WAIT_L
#undef PG8_BAR
#undef PG8_SCHED
}
}
#ifndef PG8_SP2
#define PG8_SP2 true
#endif
#ifndef PG8_ALIGN
#define PG8_ALIGN true
#endif
#ifndef PROBE_DOUBLE
#define PROBE_DOUBLE 0
#endif
#ifndef MK_N_LAUNCHES
#define MK_N_LAUNCHES 1
#endif

constexpr int NWAVES = 8;
constexpr int BATCH = 4, SEQ = 8192, D = 1024, T = BATCH * SEQ, DEPTH = 4;
constexpr int NEXP = 32, TOPK = 4, FF = 1024;
constexpr int DA_H = 8, RET_H = 4;
constexpr float LN_EPS = 1e-5f;
constexpr float DN_ALPHA = 1.6817928305074290f;
constexpr float LOG2E = 1.4426950408889634f;
constexpr int MT_MAX = T * TOPK / 256 + NEXP;

constexpr size_t MiB = 1u << 20;
constexpr size_t WS_CTL = 0, CTL_ZERO_BYTES = 192 * 1024;
constexpr size_t WS_WIMG = 2 * MiB;
constexpr size_t WS_STATS = 4 * MiB;
constexpr size_t WS_WDAIN = 16 * MiB;
constexpr size_t WS_WDAOUT = 28 * MiB;
constexpr size_t WS_WRETIN = 32 * MiB;
constexpr size_t WS_WRETOUT = 56 * MiB;
constexpr size_t WS_WGU = 64 * MiB;
constexpr size_t WS_WDN = 576 * MiB;
constexpr size_t WS_XB = 832 * MiB;
constexpr size_t WS_Y = 896 * MiB;
constexpr size_t WS_PROJ = 1024 * MiB;
constexpr size_t WS_AO = 1408 * MiB;
constexpr size_t WS_STATE = 1536 * MiB;
constexpr size_t WS_XS = 1792 * MiB;
constexpr size_t WS_ACT = 2064 * MiB;
constexpr size_t WS_YE = 2336 * MiB;
constexpr size_t WS_ROUTE = 2592 * MiB;
constexpr size_t WS_SLOT = 2596 * MiB;
constexpr size_t WS_END = 2608 * MiB;
constexpr int CW_BAR = 4096;
constexpr int CW_CNT = 16384;
constexpr int CW_KMAX = 32768;
constexpr int CW_QCTR = 33280;
constexpr int RING_BYTES = 131072;
constexpr int MISC_OFF = RING_BYTES + 320;
constexpr int TBL_OFF = RING_BYTES + 1024;
constexpr int LDS_BYTES = 147456;

#define GAS __attribute__((address_space(1)))
#define LAS __attribute__((address_space(3)))
typedef unsigned short bf16;
typedef unsigned v4u __attribute__((ext_vector_type(4)));
typedef unsigned v2u __attribute__((ext_vector_type(2)));
typedef float f32x4 __attribute__((ext_vector_type(4)));
typedef float f32x16 __attribute__((ext_vector_type(16)));
typedef short bf16x8 __attribute__((ext_vector_type(8)));
typedef short s16x4 __attribute__((ext_vector_type(4)));
typedef GAS unsigned gu32;
#define RLX_AGENT __ATOMIC_RELAXED, __HIP_MEMORY_SCOPE_AGENT
#define LDS_WAIT() asm volatile("s_waitcnt lgkmcnt(0)" ::: "memory")
#define VM_WAIT() asm volatile("s_waitcnt vmcnt(0)" ::: "memory")
__device__ __forceinline__ unsigned f2bf(float f) { unsigned u = __builtin_bit_cast(unsigned, f); return (u + 0x7fffu + ((u >> 16) & 1u)) >> 16; }
typedef float f32x2_t __attribute__((ext_vector_type(2))); typedef __bf16 bf16x2_t __attribute__((ext_vector_type(2)));
__device__ __forceinline__ unsigned pk2(float lo, float hi) { f32x2_t v = {lo, hi}; bf16x2_t b = __builtin_convertvector(v, bf16x2_t); return __builtin_bit_cast(unsigned, b); }
__device__ __forceinline__ float bf2f(unsigned short h) { return __builtin_bit_cast(float, (unsigned)h << 16); }
__device__ __forceinline__ float bflo(unsigned w) { return __builtin_bit_cast(float, w << 16); }
__device__ __forceinline__ float bfhi(unsigned w) { return __builtin_bit_cast(float, w & 0xffff0000u); }
__device__ __forceinline__ int crow(int r, int hi) { return (r & 3) + 8 * (r >> 2) + 4 * hi; }
typedef short v4i16_t __attribute__((ext_vector_type(4)));
__device__ __forceinline__ s16x4 vtr(LAS const unsigned char* p) { return __builtin_bit_cast(s16x4, __builtin_amdgcn_ds_read_tr16_b64_v4i16((LAS v4i16_t*)p)); }
__device__ __forceinline__ bf16x8 cat8(s16x4 lo, s16x4 hi) { return (bf16x8){lo[0], lo[1], lo[2], lo[3], hi[0], hi[1], hi[2], hi[3]}; }
__device__ __forceinline__ bf16x8 pack8f(float a0, float a1, float a2, float a3, float a4, float a5, float a6, float a7) {
    v4u w; w.x = pk2(a0, a1); w.y = pk2(a2, a3); w.z = pk2(a4, a5); w.w = pk2(a6, a7); return __builtin_bit_cast(bf16x8, w); }
#define XB_TMO      128
#define XB_XCNT(j)  (256  + 64 * (j))
#define XB_XSUB(j)  (1280 + 64 * (j))
#define XB_XGEN(j)  (2304 + 64 * (j))
#define XB_TOP      3328
#define XB_TOPGEN   3392
#define XCD_BAR_WORDS 3456
#define XB_SPIN_CAP (1u << 24)

__device__ __forceinline__ unsigned xb_ld(unsigned* p)              { return __hip_atomic_load(p, __ATOMIC_RELAXED, __HIP_MEMORY_SCOPE_AGENT); }
__device__ __forceinline__ unsigned xb_add(unsigned* p, unsigned v) { return __hip_atomic_fetch_add(p, v, __ATOMIC_RELAXED, __HIP_MEMORY_SCOPE_AGENT); }
__device__ __forceinline__ unsigned xb_xcc_id() { return (unsigned)__builtin_amdgcn_s_getreg((3 << 11) | 20) & 0xFu; }
#define XB_SPIN(cond, bar) do { unsigned _sp = 0; while (cond) { __builtin_amdgcn_s_sleep(1); \
    if ((++_sp & 255u) == 0u) { if (xb_ld(&(bar)[XB_TMO])) break; if (_sp > XB_SPIN_CAP) { atomicAdd(&(bar)[XB_TMO], 1u); break; } } } } while (0)

struct XcdBarrier {
    unsigned* bar; unsigned x;
    volatile LAS unsigned* st;
};

__device__ __forceinline__ XcdBarrier xcd_barrier_post(unsigned* bar, volatile LAS unsigned* st) {
    XcdBarrier b; b.bar = bar; b.x = xb_xcc_id(); b.st = st;
    if (threadIdx.x == 0) (void)xb_add(&bar[XB_XCNT(b.x)], 1u);
    return b;
}
__device__ __forceinline__ void xcd_barrier_complete(unsigned* bar, unsigned x, unsigned& nloc, unsigned& nx) {
    const unsigned G = gridDim.x * gridDim.y * gridDim.z;
    unsigned sum, cnt, mine, sp = 0u;
    for (;;) {
        sum = 0u; cnt = 0u; mine = 0u;
#pragma unroll
        for (unsigned j = 0; j < 16; ++j) { const unsigned c = xb_ld(&bar[XB_XCNT(j)]); sum += c; cnt += (c > 0u) ? 1u : 0u; mine = (j == x) ? c : mine; }
        if (sum == G) break;
        __builtin_amdgcn_s_sleep(1);
        if ((++sp & 255u) == 0u) { if (xb_ld(&bar[XB_TMO])) break; if (sp > XB_SPIN_CAP) { atomicAdd(&bar[XB_TMO], 1u); break; } }
    }
    nloc = mine > 0u ? mine : 1u; nx = cnt > 0u ? cnt : 1u;
}

__device__ __forceinline__ void xcd_barrier(const XcdBarrier& b) {
    asm volatile("s_waitcnt vmcnt(0)" ::: "memory");
    __syncthreads();
    if (threadIdx.x == 0) {
        unsigned* bar = b.bar;
        __builtin_amdgcn_s_waitcnt(0);
        unsigned nloc = b.st[0], nx = b.st[1];
        if (nloc == 0u) { xcd_barrier_complete(bar, b.x, nloc, nx); b.st[0] = nloc; b.st[1] = nx; }
        const unsigned old = xb_add(&bar[XB_XSUB(b.x)], 1u);
        const unsigned gen = old / nloc;
        if (old + 1u == (gen + 1u) * nloc) {
            __builtin_amdgcn_fence(__ATOMIC_RELEASE, "agent");
            asm volatile("s_waitcnt vmcnt(0)" ::: "memory");
            const unsigned og = xb_add(&bar[XB_TOP], 1u);
            const unsigned tg = og / nx;
            if (og + 1u == (tg + 1u) * nx) xb_add(&bar[XB_TOPGEN], 1u);
            else XB_SPIN(xb_ld(&bar[XB_TOPGEN]) == tg, bar);
            __builtin_amdgcn_fence(__ATOMIC_ACQUIRE, "agent");
            xb_add(&bar[XB_XGEN(b.x)], 1u);
            asm volatile("s_waitcnt vmcnt(0)" ::: "memory");
        } else {
            XB_SPIN(xb_ld(&bar[XB_XGEN(b.x)]) == gen, bar);
            __builtin_amdgcn_fence(__ATOMIC_ACQUIRE, "agent");
            asm volatile("s_waitcnt vmcnt(0)" ::: "memory");
        }
    }
    __syncthreads();
}
struct Frame {
    LAS unsigned char* lds;
    volatile LAS unsigned* MISC;
    gu32* ctl;
    int vcu, G;
};

#define LTID() const int tid_ = hw_tid(F.lds), lane_ = tid_ & 63, wave_ = __builtin_amdgcn_readfirstlane(tid_ >> 6); (void)lane_; (void)wave_
template <int MODE>
__device__ __forceinline__ int p0_dest_row(int n0) { return (MODE == 1) ? ((n0 < 1024) ? (256 * (n0 >> 7) + (n0 & 127)) : (256 * ((n0 - 1024) >> 7) + 128 + ((n0 - 1024) & 127))) : n0; }
template <int MODE>
__device__ __forceinline__ void p0_family(Frame& F, const float* W, bf16* WT, int nmat, int K, int N, int wg_rank = -1, int wg_count = 0) { LTID();
    LAS float* scr = (LAS float*)(F.lds + wave_ * 16384);
    const int gw = (wg_rank < 0 ? F.vcu : wg_rank) * NWAVES + wave_, NGW = (wg_rank < 0 ? F.G : wg_count) * NWAVES, lane = lane_;
    const int nblk = N / 32, ipm = (K / 64) * nblk, total = nmat * ipm;
    f32x4 cur[8], nxt[8], nx2[8], nx3[8];
#define P0_LOAD(dst, it_) do { const int mat_ = (it_) / ipm, r_ = (it_) - mat_ * ipm, kb_ = r_ / nblk, nb_ = r_ - kb_ * nblk; \
        const float* src_ = W + (size_t)mat_ * K * N + (size_t)(64 * kb_ + (lane >> 3)) * N + 32 * nb_ + 4 * (lane & 7); \
        _Pragma("unroll") for (int i = 0; i < 8; ++i) dst[i] = __builtin_nontemporal_load((const GAS f32x4*)(src_ + (size_t)(8 * i) * N)); } while (0)
    int it = gw;
    if (it < total) P0_LOAD(cur, it);
    if (it + NGW < total) P0_LOAD(nxt, it + NGW);
    if (it + 2 * NGW < total) P0_LOAD(nx2, it + 2 * NGW);
    for (; it < total; it += NGW) {
        const int itn = it + 3 * NGW;
        if (itn < total) P0_LOAD(nx3, itn);
        const int mat = it / ipm, r = it - mat * ipm, kb = r / nblk, nb = r - kb * nblk, k0 = 64 * kb, r0 = p0_dest_row<MODE>(32 * nb);
#pragma unroll
        for (int i = 0; i < 8; ++i) { LAS float* sw = scr + (8 * i + (lane >> 3)) * 33 + 4 * (lane & 7); sw[0] = cur[i].x; sw[1] = cur[i].y; sw[2] = cur[i].z; sw[3] = cur[i].w; }
        LDS_WAIT(); asm volatile("" ::: "memory");
        const int c = lane & 7; bf16* wt = WT + (size_t)mat * K * N;
#pragma unroll
        for (int j = 0; j < 4; ++j) { const int n = (lane >> 3) + 8 * j; const LAS float* sp = scr + (8 * c) * 33 + n;
            v4u o; o.x = pk2(sp[0 * 33], sp[1 * 33]); o.y = pk2(sp[2 * 33], sp[3 * 33]); o.z = pk2(sp[4 * 33], sp[5 * 33]); o.w = pk2(sp[6 * 33], sp[7 * 33]);
            __builtin_nontemporal_store(o, (GAS v4u*)(wt + (size_t)(r0 + n) * K + k0 + 8 * c)); }
        LDS_WAIT(); asm volatile("" ::: "memory");
#pragma unroll
        for (int i = 0; i < 8; ++i) { cur[i] = nxt[i]; nxt[i] = nx2[i]; nx2[i] = nx3[i]; }
    }
#undef P0_LOAD
}
__device__ __forceinline__ void p0_x_to_bf16(Frame& F, const float* x, bf16* XB) { LTID();
    const int gw = F.vcu * NWAVES + wave_, NGW = F.G * NWAVES;
    for (int m = gw; m < T; m += NGW) {
        const GAS f32x4* xr = (const GAS f32x4*)(x + (size_t)m * D) + lane_; GAS v2u* o = (GAS v2u*)(XB + (size_t)m * D) + lane_;
#pragma unroll
        for (int j = 0; j < 4; ++j) { const f32x4 v = __builtin_nontemporal_load(xr + 64 * j); v2u w; w.x = pk2(v.x, v.y); w.y = pk2(v.z, v.w); o[64 * j] = w; } }
}

__device__ __forceinline__ void ln_apply(f32x4 (&v)[4], const float* g, const float* b, int lane) {
    float s = 0.f;
#pragma unroll
    for (int j = 0; j < 4; ++j) s += (v[j].x + v[j].y) + (v[j].z + v[j].w);
    const float mean = wave_sum(s) * (1.f / D); float s2 = 0.f;
#pragma unroll
    for (int j = 0; j < 4; ++j) { v[j] = v[j] - mean; s2 += (v[j].x * v[j].x + v[j].y * v[j].y) + (v[j].z * v[j].z + v[j].w * v[j].w); }
    const float rstd = 1.f / sqrtf(wave_sum(s2) * (1.f / D) + LN_EPS);
#pragma unroll
    for (int j = 0; j < 4; ++j) { const f32x4 gg = *((const GAS f32x4*)g + lane + 64 * j), bb = *((const GAS f32x4*)b + lane + 64 * j); v[j] = v[j] * rstd * gg + bb; }
}
__device__ __forceinline__ void store_x(const f32x4 (&v)[4], float* X, bf16* XB, size_t row, int lane) {
    GAS v2u* bo = (GAS v2u*)(XB + row * D) + lane;
#pragma unroll
    for (int j = 0; j < 4; ++j) { v2u w; w.x = pk2(v[j].x, v[j].y); w.y = pk2(v[j].z, v[j].w); bo[64 * j] = w; }
    if (X) { GAS f32x4* xo = (GAS f32x4*)(X + row * D) + lane;
#pragma unroll
        for (int j = 0; j < 4; ++j) __builtin_nontemporal_store(v[j], xo + 64 * j); }
}
__device__ __forceinline__ void p0_router_image(Frame& F, const float* Wr_all, unsigned char* IMG) { LTID();
    const int gt = (F.vcu * NWAVES + wave_) * 64 + lane_;
    if (gt < DEPTH * NEXP * 128) { const int L = gt >> 12, e = (gt >> 7) & 31, c = gt & 127; const float* w = Wr_all + (size_t)L * D * NEXP + (size_t)(8 * c) * NEXP + e;
        float x[8]; v4u hi, lo;
#pragma unroll
        for (int j = 0; j < 8; ++j) x[j] = w[j * NEXP];
#pragma unroll
        for (int j = 0; j < 4; ++j) { hi[j] = pk2(x[2 * j], x[2 * j + 1]); lo[j] = pk2(x[2 * j] - bflo(hi[j]), x[2 * j + 1] - bfhi(hi[j])); }
        unsigned char* dst = IMG + (size_t)L * 131072 + e * 2048 + ((c ^ (e & 15)) * 16);
        *(GAS v4u*)dst = hi; *(GAS v4u*)(dst + 65536) = lo; }
}
__device__ __forceinline__ void ln_router_phase(Frame& F, const bf16* Y, const float* STATS, const float* g, const float* b, const unsigned char* WIMG, const float* br, bf16* XB, int2* SLOT, gu32* cnt) { LTID();
    LAS unsigned char* lds = F.lds;
#pragma unroll 4
    for (int i = 0; i < 16; ++i) { const int idx = tid_ + 512 * i; *(LAS v4u*)(lds + idx * 16) = *(const GAS v4u*)(WIMG + idx * 16); }
    LAS int* lcnt = (LAS int*)(lds + TBL_OFF + 4096);
    typedef int v4i_t __attribute__((ext_vector_type(4)));
    LAS v4i_t* rec = (LAS v4i_t*)(lds + TBL_OFF + 4096 + 256);
    for (int rt = F.vcu; rt < T / 128; rt += F.G) {
        if (tid_ < 32) lcnt[tid_] = 0;
        LDS_WAIT(); __syncthreads();
        int tid = tid_; asm volatile("" : "+v"(tid));
        const int lane = tid & 63, wid = __builtin_amdgcn_readfirstlane(tid >> 6), r = lane & 15, kg = lane >> 4;
        const size_t row = (size_t)rt * 128 + wid * 16 + r;
        const bf16* yr = Y + row * D + kg * 8;
        float s1, s2;
        { const GAS f32x4* sp = (const GAS f32x4*)(STATS + (row * 16 + kg * 4) * 2); const f32x4 a = sp[0], c = sp[1]; s1 = (a.x + a.z) + (c.x + c.z); s2 = (a.y + a.w) + (c.y + c.w); }
        { float t0; float o0 = swap16_other(s1, t0); s1 = t0 + o0; o0 = swap32_other(s1, t0); s1 = t0 + o0; o0 = swap16_other(s2, t0); s2 = t0 + o0; o0 = swap32_other(s2, t0); s2 = t0 + o0; }
        const float mean = s1 * (1.f / D), rstd = 1.f / sqrtf(__builtin_fmaxf(s2 * (1.f / D) - mean * mean, 0.f) + LN_EPS);
        pg8::f32x4 c0 = (pg8::f32x4){0.f, 0.f, 0.f, 0.f}, c1 = c0;
        bf16* xbr = XB + row * D + kg * 8;
        LAS const unsigned char* wb = lds + r * 2048;
        v4u ywn[4];
#pragma unroll
        for (int t = 0; t < 4; ++t) ywn[t] = __builtin_nontemporal_load((const GAS v4u*)(yr + 32 * t));
#pragma unroll
        for (int q = 0; q < 8; ++q) {
            f32x4 ga[4], gb[4], ba[4], bb[4]; v4u ywc[4];
#pragma unroll
            for (int t = 0; t < 4; ++t) { const int s = 4 * q + t; ga[t] = *(const GAS f32x4*)(g + 32 * s + kg * 8); gb[t] = *(const GAS f32x4*)(g + 32 * s + kg * 8 + 4); ba[t] = *(const GAS f32x4*)(b + 32 * s + kg * 8); bb[t] = *(const GAS f32x4*)(b + 32 * s + kg * 8 + 4); ywc[t] = ywn[t]; }
            if (q < 7) {
#pragma unroll
                for (int t = 0; t < 4; ++t) ywn[t] = __builtin_nontemporal_load((const GAS v4u*)(yr + 32 * (4 * q + 4 + t))); }
            __builtin_amdgcn_sched_barrier(0);
#pragma unroll
            for (int t = 0; t < 4; ++t) { const int s = 4 * q + t; const v4u yw = ywc[t];
            const f32x4 ya = (f32x4){bflo(yw[0]), bfhi(yw[0]), bflo(yw[1]), bfhi(yw[1])}, yb = (f32x4){bflo(yw[2]), bfhi(yw[2]), bflo(yw[3]), bfhi(yw[3])};
            const f32x4 xa = (ya - mean) * rstd * ga[t] + ba[t], xb = (yb - mean) * rstd * gb[t] + bb[t];
            v4u hi, lo; hi[0] = pk2(xa.x, xa.y); hi[1] = pk2(xa.z, xa.w); hi[2] = pk2(xb.x, xb.y); hi[3] = pk2(xb.z, xb.w);
            lo[0] = pk2(xa.x - bflo(hi[0]), xa.y - bfhi(hi[0])); lo[1] = pk2(xa.z - bflo(hi[1]), xa.w - bfhi(hi[1])); lo[2] = pk2(xb.x - bflo(hi[2]), xb.y - bfhi(hi[2])); lo[3] = pk2(xb.z - bflo(hi[3]), xb.w - bfhi(hi[3]));
            *(GAS v4u*)(xbr + 32 * s) = hi;
            const int co = ((4 * s + kg) ^ r) * 16;
            const bf16x8 bh0 = *(const LAS bf16x8*)(wb + co), bh1 = *(const LAS bf16x8*)(wb + 32768 + co), bl0 = *(const LAS bf16x8*)(wb + 65536 + co), bl1 = *(const LAS bf16x8*)(wb + 98304 + co);
            const bf16x8 ah = __builtin_bit_cast(bf16x8, hi), al = __builtin_bit_cast(bf16x8, lo);
            c0 = __builtin_amdgcn_mfma_f32_16x16x32_bf16(ah, bh0, c0, 0, 0, 0); c1 = __builtin_amdgcn_mfma_f32_16x16x32_bf16(ah, bh1, c1, 0, 0, 0);
            c0 = __builtin_amdgcn_mfma_f32_16x16x32_bf16(al, bh0, c0, 0, 0, 0); c1 = __builtin_amdgcn_mfma_f32_16x16x32_bf16(al, bh1, c1, 0, 0, 0);
            c0 = __builtin_amdgcn_mfma_f32_16x16x32_bf16(ah, bl0, c0, 0, 0, 0); c1 = __builtin_amdgcn_mfma_f32_16x16x32_bf16(ah, bl1, c1, 0, 0, 0); }
            __builtin_amdgcn_sched_barrier(0);
        }
        const float bi0 = br[r], bi1 = br[16 + r];
#pragma unroll
        for (int rr = 0; rr < 4; ++rr) {
            float v0 = c0[rr] + bi0, v1 = c1[rr] + bi1; int ei[4]; float ev[4];
#pragma unroll
            for (int k = 0; k < 4; ++k) { const float m = row_max16(__builtin_fmaxf(v0, v1));
                const unsigned long long m0 = __ballot(v0 == m), m1 = __ballot(v1 == m);
                const unsigned q0b = (unsigned)(m0 >> (16 * kg)) & 0xffffu, q1b = (unsigned)(m1 >> (16 * kg)) & 0xffffu;
                const int idx = q0b ? (__ffs((int)q0b) - 1) : (16 + __ffs((int)q1b) - 1);
                ev[k] = m; ei[k] = idx;
                if (idx < 16) { if (r == idx) v0 = -INFINITY; } else { if (r == idx - 16) v1 = -INFINITY; } }
            const float p1 = __expf(ev[1] - ev[0]), p2 = __expf(ev[2] - ev[0]), p3 = __expf(ev[3] - ev[0]); const float inv = 1.f / (((1.f + p1) + p2) + p3);
            if (r < 4) { const int me = r == 0 ? ei[0] : r == 1 ? ei[1] : r == 2 ? ei[2] : ei[3]; const float mw = (r == 0 ? 1.f : r == 1 ? p1 : r == 2 ? p2 : p3) * inv;
                const int lr = __hip_atomic_fetch_add(lcnt + me, 1, __ATOMIC_RELAXED, __HIP_MEMORY_SCOPE_WORKGROUP);
                rec[(wid * 16 + 4 * kg + rr) * 4 + r] = (v4i_t){me, lr, __float_as_int(mw), 0}; }
        }
        LDS_WAIT(); __syncthreads();
        if (tid < NEXP) { const int c = lcnt[tid]; lcnt[32 + tid] = c ? (int)__hip_atomic_fetch_add(cnt + tid * 64, (unsigned)c, RLX_AGENT) : 0; }
        LDS_WAIT(); __syncthreads();
        { const v4i_t rc = rec[tid]; typedef int v2i_t __attribute__((ext_vector_type(2)));
          *(GAS v2i_t*)(SLOT + (size_t)rc.x * pg8::GCAP_SLOTS + (lcnt[32 + rc.x] + rc.y)) = (v2i_t){(rt * 128 + (tid >> 2)) * 4 + (tid & 3), rc.z}; }
        LDS_WAIT(); __syncthreads();
    }
}
__device__ __forceinline__ void build_tables(Frame& F, gu32* cnt) { LTID();
    LAS int* tb = (LAS int*)(F.lds + TBL_OFF);
    __syncthreads();
    if (tid_ < NEXP) tb[40 + tid_] = (int)__hip_atomic_load(cnt + tid_ * 64, RLX_AGENT);
    LDS_WAIT(); __syncthreads();
    if (tid_ == 0) { int acc = 0; for (int e = 0; e < NEXP; ++e) { tb[e] = acc; acc += (tb[40 + e] + 255) >> 8; } tb[NEXP] = acc; }
    LDS_WAIT(); __syncthreads();
    for (int pm = tid_; pm < MT_MAX; pm += 512) { int e = 0;
#pragma unroll
        for (int j = 1; j < NEXP; ++j) e += (tb[j] <= pm) ? 1 : 0;
        tb[128 + pm] = e; }
    LDS_WAIT(); __syncthreads();
}
__device__ __forceinline__ void gather_phase(Frame& F, const bf16* XB, const int4* ROUTE, bf16* XS, int2* SLOT) { LTID();
    const LAS int* tb = (const LAS int*)(F.lds + TBL_OFF);
    const int gw = F.vcu * NWAVES + wave_, NGW = F.G * NWAVES, lane = lane_;
    for (int t = gw; t < T; t += NGW) {
        const int4 r = ROUTE[(size_t)t * 4 + (lane & 3)];
        const GAS v4u* src = (const GAS v4u*)(XB + (size_t)t * D); const v4u a = src[lane], c = src[64 + lane];
#pragma unroll
        for (int k = 0; k < 4; ++k) { const int e = __shfl(r.x, k), rk = __shfl(r.y, k), wb = __shfl(r.z, k); const int dest = 256 * tb[e] + rk;
            GAS v4u* dst = (GAS v4u*)(XS + (size_t)dest * D); dst[lane] = a; dst[64 + lane] = c;
            if (lane == 0) SLOT[dest] = make_int2(t * 4 + k, wb); }
    }
}
__device__ __forceinline__ void combine_ln_phase(Frame& F, const bf16* YE, const float* g, const float* b, float* X, bf16* XB) { LTID();
    const int gw = F.vcu * NWAVES + wave_, NGW = F.G * NWAVES, lane = lane_;
    v2u xw[4], yw[4][4];
#define CL_LOAD(r_) do { _Pragma("unroll") for (int j = 0; j < 4; ++j) xw[j] = *((const GAS v2u*)(XB + (size_t)(r_) * D) + lane + 64 * j); \
        _Pragma("unroll") for (int k = 0; k < 4; ++k) { const GAS v2u* yr = (const GAS v2u*)(YE + ((size_t)(r_) * 4 + k) * D) + lane; _Pragma("unroll") for (int j = 0; j < 4; ++j) yw[k][j] = __builtin_nontemporal_load(yr + 64 * j); } } while (0)
    if (gw < T) CL_LOAD(gw);
    for (int row = gw; row < T; row += NGW) {
        f32x4 v[4];
#pragma unroll
        for (int j = 0; j < 4; ++j) { const v2u w = xw[j]; v[j] = (f32x4){bflo(w.x), bfhi(w.x), bflo(w.y), bfhi(w.y)} * DN_ALPHA; }
#pragma unroll
        for (int k = 0; k < 4; ++k) {
#pragma unroll
            for (int j = 0; j < 4; ++j) { const v2u w = yw[k][j]; v[j].x += bflo(w.x); v[j].y += bfhi(w.x); v[j].z += bflo(w.y); v[j].w += bfhi(w.y); } }
        if (row + NGW < T) CL_LOAD(row + NGW);
        __builtin_amdgcn_sched_barrier(0);
        ln_apply(v, g, b, lane);
        store_x(v, X, XB, (size_t)row, lane);
    }
#undef CL_LOAD
}

struct GroupedOrder {
    const LAS int* tb; int NT, GM, G, bx;
    __device__ __forceinline__ bool next(int i, pg8::Unit& u) const {
        const int MT = tb[NEXP]; int pm, pn;
        if (G == 256) { const int x = bx & 7, j = bx >> 3, s = i * 8 + x; pm = s * GM + j / NT; pn = j % NT; }
        else { const int L = i * G + bx; pm = L / NT; pn = L % NT; }
        if (pm >= MT) return false;
        const int e = tb[128 + pm];
        int rows = tb[40 + e] - 256 * (pm - tb[e]); rows = rows > 256 ? 256 : rows;
        u.pm = __builtin_amdgcn_readfirstlane(pm); u.pn = __builtin_amdgcn_readfirstlane(pn); u.pb = __builtin_amdgcn_readfirstlane(e * NT + pn); u.aux = __builtin_amdgcn_readfirstlane(e); u.rows = __builtin_amdgcn_readfirstlane(rows); u.lt = __builtin_amdgcn_readfirstlane(pm - tb[e]);
        return true;
    }
    __device__ __forceinline__ void a_ready(const pg8::Unit&) const {}
    __device__ __forceinline__ void done(const pg8::Unit&) const {}
};

__device__ __forceinline__ void glds16(const void* gsrc, unsigned lds_dst) { unsigned keep;
    asm volatile("s_mov_b32 %0, m0\n\ts_mov_b32 m0, %2\n\ts_nop 0\n\tglobal_load_lds_dwordx4 %1, off\n\ts_mov_b32 m0, %0" : "=&s"(keep) : "v"(gsrc), "s"(lds_dst) : "memory"); }
struct ConvJob { const float* wgu; bf16* wgu_t; const float* wdn; bf16* wdn_t; int nmat; int every; };
__device__ __forceinline__ void da_attn_phase(Frame& F, const bf16* QKV, bf16* AO, float lam, float one_m_li, const float* subg, const unsigned* kmax, gu32* qctr, const ConvJob& cj) { LTID();
    LAS unsigned char* lds = F.lds;
    if (cj.nmat > 0 && (F.vcu % cj.every) == 0) {
        p0_family<1>(F, cj.wgu, cj.wgu_t, cj.nmat, D, 2 * FF, F.vcu / cj.every, (F.G + cj.every - 1) / cj.every);
        p0_family<0>(F, cj.wdn, cj.wdn_t, cj.nmat, FF, D, F.vcu / cj.every, (F.G + cj.every - 1) / cj.every);
        LDS_WAIT(); __syncthreads();
    }
    LAS volatile int* qslot = (LAS volatile int*)(lds + TBL_OFF + 3072);
    LAS float* wred = (LAS float*)(lds + TBL_OFF + 3136);
    if (tid_ == 0) *qslot = (int)__hip_atomic_fetch_add(qctr, 1u, RLX_AGENT);
    LDS_WAIT(); __syncthreads();
    int U = __builtin_amdgcn_readfirstlane(*qslot);
    __syncthreads();
    while (U < 2048) {
        int tid = tid_; asm volatile("" : "+v"(tid));
        const int lane = tid & 63, r32 = lane & 31, hh = lane >> 5, wid = __builtin_amdgcn_readfirstlane(tid >> 6), mp = wid & 1, rg = wid >> 1;
        LAS float* wsf = (LAS float*)(lds + 98304 + wid * 256);
        const int voff = (4 * hh + ((lane & 15) >> 2)) * 64 + ((lane >> 4) & 1) * 32 + (lane & 3) * 8;
        unsigned nxtU = 0u; if (tid == 0) nxtU = __hip_atomic_fetch_add(qctr, 1u, RLX_AGENT);
        const int h = 7 - (U >> 8), qb = 63 - ((U & 255) >> 2), b = U & 3;
        const int q0 = qb * 128, NT = 2 * qb + 2;
        const float sl2 = __builtin_amdgcn_exp2f(-(float)(h + 1)) * LOG2E;
        const size_t rowbase = (size_t)b * SEQ;
        const unsigned* kmp = kmax + ((b * 16 + h * 2 + mp) * 2);
        const float km2 = __builtin_bit_cast(float, __hip_atomic_load(kmp, RLX_AGENT)) + __builtin_bit_cast(float, __hip_atomic_load(kmp + 1, RLX_AGENT));
        bf16x8 qr[4];
        { const bf16* qp = QKV + (rowbase + q0 + rg * 32 + r32) * 3072 + h * 128 + mp * 64 + hh * 8;
#pragma unroll
          for (int d0 = 0; d0 < 4; ++d0) qr[d0] = *(const GAS bf16x8*)(qp + d0 * 16); }
        int t_min = 0; float qkw = 0.f;
        { float qs = 0.f;
#pragma unroll
          for (int d0 = 0; d0 < 4; ++d0)
#pragma unroll
              for (int j = 0; j < 8; ++j) { const float qv = bf2f((unsigned short)qr[d0][j]); qs += qv * qv; }
          qs = xor32_sum(qs); qs = half_max32(qs);
          const float bw = 2.0f * sqrtf(qs * km2) * 1.02f;
          qkw = 0.5f * bw;
          if (lane == 0) wred[wid] = bw;
          LDS_WAIT(); __syncthreads();
          float bm = wred[0];
#pragma unroll
          for (int w8 = 1; w8 < 8; ++w8) bm = __builtin_fmaxf(bm, wred[w8]);
          const float Wk = (bm + 38.0f) / sl2, xx = ((float)q0 - Wk - 63.0f) * (1.0f / 64.0f);
          t_min = (xx > 0.f) ? (int)ceilf(xx) : 0; t_min = __builtin_amdgcn_readfirstlane(t_min); }
        int NIT = NT - t_min;
        const bf16* kg0 = QKV + (rowbase + lane) * 3072 + 1024 + h * 128 + wid * 8;
        const bf16* vg0 = QKV + (rowbase + 16 * (wid & 3) + (lane >> 2)) * 3072 + 2048 + h * 128 + (wid >> 2) * 32 + (lane & 3) * 8;
        const unsigned ldsb = (unsigned)(uintptr_t)lds, kd0 = ldsb + wid * 1024, vd0 = ldsb + 49152 + (wid >> 2) * 4096 + (wid & 3) * 1024;
#define DMA_K(it_, ks) do { const size_t to_ = (size_t)(NT - 1 - (it_)) * 64 * 3072; const unsigned sb_ = (unsigned)(ks) * 16384u; \
        glds16(kg0 + to_, (unsigned)__builtin_amdgcn_readfirstlane(kd0 + sb_)); glds16(kg0 + to_ + 64, (unsigned)__builtin_amdgcn_readfirstlane(kd0 + sb_ + 8192)); } while (0)
#define DMA_V(it_, vs) do { const size_t to_ = (size_t)(NT - 1 - (it_)) * 64 * 3072; const unsigned sb_ = (unsigned)(vs) * 16384u; \
        glds16(vg0 + to_, (unsigned)__builtin_amdgcn_readfirstlane(vd0 + sb_)); glds16(vg0 + to_ + 64, (unsigned)__builtin_amdgcn_readfirstlane(vd0 + sb_ + 8192)); } while (0)
#define DA_QK(P0, P1, it_, ks) do { const int t_ = NT - 1 - (it_), krel0_ = 64 * t_ - q0; const float cb0_ = sl2 * (float)krel0_ + hb - m_ref; LAS const unsigned char* Kb_ = lds + (ks) * 16384; \
        _Pragma("unroll") for (int i = 0; i < 16; ++i) { P0[i] = cb0_ + sl2 * (float)((i & 3) + 8 * (i >> 2)); P1[i] = cb0_ + sl2 * (float)(32 + (i & 3) + 8 * (i >> 2)); } \
        _Pragma("unroll") for (int d0 = 0; d0 < 4; ++d0) { \
            const bf16x8 a0 = *(const LAS bf16x8*)(Kb_ + (mp * 8 + 2 * d0 + hh) * 1024 + r32 * 16), a1 = *(const LAS bf16x8*)(Kb_ + (mp * 8 + 2 * d0 + hh) * 1024 + 512 + r32 * 16); \
            P0 = __builtin_amdgcn_mfma_f32_32x32x16_bf16(a0, qr[d0], P0, 0, 0, 0); P1 = __builtin_amdgcn_mfma_f32_32x32x16_bf16(a1, qr[d0], P1, 0, 0, 0); } \
        if ((it_) < 2) { const int qrel = rg * 32 + r32; \
            _Pragma("unroll") for (int i = 0; i < 16; ++i) { const int kr = krel0_ + crow(i, hh); if (kr > qrel) P0[i] = -INFINITY; if (kr + 32 > qrel) P1[i] = -INFINITY; } } } while (0)
        float tmax = -INFINITY;
        float m_ref = -qkw, l_run = 0.f; f32x16 o[4];
#pragma unroll
        for (int eb = 0; eb < 4; ++eb) o[eb] = (f32x16){0.f, 0.f, 0.f, 0.f, 0.f, 0.f, 0.f, 0.f, 0.f, 0.f, 0.f, 0.f, 0.f, 0.f, 0.f, 0.f};
        const float hb = sl2 * (float)(4 * hh);
        DMA_K(0, 0); DMA_K(1, 1); DMA_V(0, 0);
        if (NIT > 2) { DMA_K(2, 2); DMA_V(1, 1); asm volatile("s_waitcnt vmcnt(8)\n\ts_barrier" ::: "memory"); }
        else { DMA_V(1, 1); asm volatile("s_waitcnt vmcnt(6)\n\ts_barrier" ::: "memory"); }
        f32x16 p0, p1, n0, n1;
        DA_QK(p0, p1, 0, 0);
        n0 = p0; n1 = p1;
        int s3 = 0;
#define DA_MAX3(a, b, c) ({ float r_; asm("v_max3_f32 %0, %1, %2, %3" : "=v"(r_) : "v"(a), "v"(b), "v"(c)); r_; })
#define DA_ITER(P0, P1, N0, N1, it_) do { \
              \
            if ((it_) + 2 < NIT) asm volatile("s_waitcnt vmcnt(4) lgkmcnt(0)\n\ts_barrier" ::: "memory"); \
            else if ((it_) + 1 < NIT) asm volatile("s_waitcnt vmcnt(2) lgkmcnt(0)\n\ts_barrier" ::: "memory"); \
            else asm volatile("s_waitcnt vmcnt(0) lgkmcnt(0)\n\ts_barrier" ::: "memory"); \
            if ((it_) == 2 && NIT > 3) {                           \
                float xm = wred[8]; _Pragma("unroll") for (int w8 = 1; w8 < 8; ++w8) xm = __builtin_fminf(xm, wred[8 + w8]); \
                const int tdrop = (int)floorf(xm * (1.0f / 64.0f)); int nit2 = NT - (tdrop + 1); nit2 = nit2 < 4 ? 4 : nit2; nit2 = __builtin_amdgcn_readfirstlane(nit2); \
                if (nit2 < NIT) NIT = nit2; } \
            const int s3n = (s3 == 2) ? 0 : s3 + 1, s3p = (s3 == 0) ? 2 : s3 - 1; \
            if ((it_) + 3 < NIT) DMA_K((it_) + 3, s3); \
            if ((it_) + 2 < NIT) DMA_V((it_) + 2, s3p); \
            if ((it_) + 1 < NIT) DA_QK(N0, N1, (it_) + 1, s3n); \
            __builtin_amdgcn_sched_barrier(0); \
            float mx = DA_MAX3(P0[0], P1[0], P0[1]); mx = DA_MAX3(mx, P1[1], P0[2]); mx = DA_MAX3(mx, P1[2], P0[3]); mx = DA_MAX3(mx, P1[3], P0[4]); \
            float my = DA_MAX3(P1[4], P0[5], P1[5]); my = DA_MAX3(my, P0[6], P1[6]); my = DA_MAX3(my, P0[7], P1[7]); my = DA_MAX3(my, P0[8], P1[8]); \
            mx = DA_MAX3(mx, P0[9], P1[9]); mx = DA_MAX3(mx, P0[10], P1[10]); mx = DA_MAX3(mx, P0[11], P1[11]); mx = DA_MAX3(mx, P0[12], P1[12]); \
            my = DA_MAX3(my, P0[13], P1[13]); my = DA_MAX3(my, P0[14], P1[14]); my = DA_MAX3(my, P0[15], P1[15]); mx = DA_MAX3(mx, my, my); \
            { float sf_; const float ot_ = swap32_other(mx, sf_); mx = DA_MAX3(sf_, ot_, ot_); } \
            tmax = __builtin_fmaxf(tmax, mx + m_ref);              \
            if (__any(mx > 8.0f)) {                                \
                const float dlt = (mx > 0.f) ? mx : 0.f; m_ref += dlt; \
                _Pragma("unroll") for (int i = 0; i < 16; ++i) { P0[i] -= dlt; P1[i] -= dlt; N0[i] -= dlt; N1[i] -= dlt; } \
                const float f = __builtin_amdgcn_exp2f(-dlt); l_run *= f; \
                if (hh == 0) wsf[r32] = f; \
                LDS_WAIT(); \
                _Pragma("unroll") for (int i = 0; i < 16; ++i) { const float af = wsf[crow(i, hh)]; \
                    _Pragma("unroll") for (int eb = 0; eb < 4; ++eb) o[eb][i] *= af; } \
            } \
            float rs0 = 0.f, rs1 = 0.f; \
            _Pragma("unroll") for (int i = 0; i < 16; ++i) { P0[i] = __builtin_amdgcn_exp2f(P0[i]); P1[i] = __builtin_amdgcn_exp2f(P1[i]); rs0 += P0[i]; rs1 += P1[i]; } \
            l_run += rs0 + rs1; \
            bf16x8 pa[4]; \
            pa[0] = pack8f(P0[0], P0[1], P0[2], P0[3], P0[4], P0[5], P0[6], P0[7]); pa[1] = pack8f(P0[8], P0[9], P0[10], P0[11], P0[12], P0[13], P0[14], P0[15]); \
            pa[2] = pack8f(P1[0], P1[1], P1[2], P1[3], P1[4], P1[5], P1[6], P1[7]); pa[3] = pack8f(P1[8], P1[9], P1[10], P1[11], P1[12], P1[13], P1[14], P1[15]); \
            LAS const unsigned char* Vb = lds + 49152 + s3 * 16384; \
              \
            _Pragma("unroll") for (int ks = 0; ks < 4; ++ks) { bf16x8 vf[4]; \
                _Pragma("unroll") for (int eb = 0; eb < 4; ++eb) vf[eb] = cat8(vtr(Vb + eb * 4096 + ks * 1024 + voff), vtr(Vb + eb * 4096 + ks * 1024 + 512 + voff)); \
                __builtin_amdgcn_sched_barrier(0); \
                _Pragma("unroll") for (int eb = 0; eb < 4; ++eb) o[eb] = __builtin_amdgcn_mfma_f32_32x32x16_bf16(pa[ks], vf[eb], o[eb], 0, 0, 0); \
                __builtin_amdgcn_sched_barrier(0); } \
            if ((it_) == 1) { float tm = tmax; tm = -half_max32(-tm); tm = -xor32_max(-tm);                   \
                if (lane == 0) wred[8 + wid] = (tm - qkw - 38.0f) / sl2 + (float)q0 - 63.0f; }                  \
            s3 = s3n; } while (0)
        int it = 0;
        for (; it + 1 < NIT; it += 2) { DA_ITER(p0, p1, n0, n1, it); DA_ITER(n0, n1, p0, p1, it + 1); }
        if (it < NIT) DA_ITER(p0, p1, n0, n1, it);
#undef DA_ITER
#undef DA_MAX3
#undef DMA_K
#undef DMA_V
#undef DA_QK
        asm volatile("s_waitcnt vmcnt(0)" ::: "memory");
        LDS_WAIT(); __syncthreads();
        const float l_tot = xor32_sum(l_run);
        if (hh == 0) wsf[r32] = 1.f / l_tot;
        LDS_WAIT();
        float rinv[16];
#pragma unroll
        for (int i = 0; i < 16; ++i) rinv[i] = wsf[crow(i, hh)];
        LAS float* comb = (LAS float*)lds + rg * 4096;
        if (mp == 1) {
#pragma unroll
            for (int eb = 0; eb < 4; ++eb)
#pragma unroll
                for (int i = 0; i < 16; ++i) comb[crow(i, hh) * 128 + eb * 32 + r32] = o[eb][i] * rinv[i];
        }
        LDS_WAIT(); __syncthreads();
        if (mp == 0) {
            float ss[16];
#pragma unroll
            for (int i = 0; i < 16; ++i) { float s = 0.f;
#pragma unroll
                for (int eb = 0; eb < 4; ++eb) { const float dlt = o[eb][i] * rinv[i] - lam * comb[crow(i, hh) * 128 + eb * 32 + r32]; o[eb][i] = dlt; s += dlt * dlt; }
                ss[i] = half_sum32(s); }
            float gsc[4];
#pragma unroll
            for (int eb = 0; eb < 4; ++eb) gsc[eb] = subg[eb * 32 + r32] * one_m_li;
#pragma unroll
            for (int i = 0; i < 16; ++i) { const float rr = 1.f / sqrtf(ss[i] * (1.f / 128.f) + LN_EPS);
                LAS bf16* tp = (LAS bf16*)(lds + 65536) + (rg * 32 + crow(i, hh)) * 128 + r32;
#pragma unroll
                for (int eb = 0; eb < 4; ++eb) tp[eb * 32] = (bf16)f2bf(o[eb][i] * rr * gsc[eb]); }
        }
        if (tid == 0) *qslot = (int)nxtU;
        LDS_WAIT(); __syncthreads();
        U = __builtin_amdgcn_readfirstlane(*qslot);
#pragma unroll
        for (int k = 0; k < 4; ++k) { const int idx = tid + 512 * k, row = idx >> 4, c16 = idx & 15;
            *(GAS v4u*)(AO + (rowbase + q0 + row) * 1024 + h * 128 + c16 * 8) = *(const LAS v4u*)(lds + 65536 + idx * 16); }
        LDS_WAIT(); __syncthreads();
    }
}

__device__ __forceinline__ void ret_scan_phase(Frame& F, const bf16* PROJ, bf16* ST, const float (&lg2)[4]) { LTID();
    LAS unsigned char* lds = F.lds;
    for (int L = F.vcu; L < 256; L += F.G) {
        int tid = tid_; asm volatile("" : "+v"(tid));
        const int lane = tid & 63, r32 = lane & 31, hh = lane >> 5, wid = __builtin_amdgcn_readfirstlane(tid >> 6);
        const int voff = (4 * hh + ((lane & 15) >> 2)) * 64 + ((lane >> 4) & 1) * 32 + (lane & 3) * 8;
        const int bh = L >> 4, dkh = (L >> 3) & 1, e8 = L & 7, h = bh & 3;
        const float lgh = h == 0 ? lg2[0] : h == 1 ? lg2[1] : h == 2 ? lg2[2] : lg2[3];
        const float gC = __builtin_amdgcn_exp2f(128.f * lgh);
        const int trow = lane >> 2, chl = lane & 3;
        const bf16* ksrc0 = PROJ + (size_t)T * 1024 + ((size_t)bh * SEQ + 16 * ((2 * wid) & 3) + trow) * 256 + dkh * 128 + ((2 * wid) >> 2) * 32 + chl * 8;
        const bf16* ksrc1 = PROJ + (size_t)T * 1024 + ((size_t)bh * SEQ + 16 * ((2 * wid + 1) & 3) + trow) * 256 + dkh * 128 + ((2 * wid + 1) >> 2) * 32 + chl * 8;
        const bf16* vsrc = PROJ + (size_t)2 * T * 1024 + ((size_t)bh * SEQ + 16 * (wid & 3) + trow) * 512 + e8 * 64 + (wid >> 2) * 32 + chl * 8;
        const unsigned ldsb = (unsigned)(uintptr_t)lds;
#define RS_DMA(m, slot) do { const size_t mk_ = (size_t)(m) * 64 * 256, mv_ = (size_t)(m) * 64 * 512; const unsigned sb_ = ldsb + (unsigned)(slot) * 24576u; \
        glds16(ksrc0 + mk_, (unsigned)__builtin_amdgcn_readfirstlane(sb_ + (2 * wid) * 1024)); glds16(ksrc1 + mk_, (unsigned)__builtin_amdgcn_readfirstlane(sb_ + (2 * wid + 1) * 1024)); \
        glds16(vsrc + mv_, (unsigned)__builtin_amdgcn_readfirstlane(sb_ + 16384 + wid * 1024)); } while (0)
        f32x16 st = (f32x16){0.f, 0.f, 0.f, 0.f, 0.f, 0.f, 0.f, 0.f, 0.f, 0.f, 0.f, 0.f, 0.f, 0.f, 0.f, 0.f};
        const int el = (wid >> 2) * 32 + r32;
        bf16* stg = ST + ((size_t)bh * 64 * 512 + e8 * 64) * 256 + dkh * 128;
        RS_DMA(0, 0); RS_DMA(1, 1); RS_DMA(2, 2);
#pragma unroll 1
        for (int m = 0; m < 128; ++m) {
            const int slot = m & 3, n = m >> 1;
            if (m >= 3 && m + 2 < 128) asm volatile("s_waitcnt vmcnt(8) lgkmcnt(0)\n\ts_barrier" ::: "memory");
            else if (m + 2 < 128) asm volatile("s_waitcnt vmcnt(6) lgkmcnt(0)\n\ts_barrier" ::: "memory");
            else if (m + 1 < 128) asm volatile("s_waitcnt vmcnt(3) lgkmcnt(0)\n\ts_barrier" ::: "memory");
            else asm volatile("s_waitcnt vmcnt(0) lgkmcnt(0)\n\ts_barrier" ::: "memory");
            if (m + 3 < 128) RS_DMA(m + 3, (m + 3) & 3);
            if ((m & 1) == 0) {
                const int bf = n & 1;
                if (n > 0) {
#pragma unroll
                    for (int k2 = 0; k2 < 2; ++k2) { const int p = tid + 512 * k2, e = p >> 4, c = (p & 15) ^ (e & 15);
                        *(GAS v4u*)(stg + ((size_t)(n - 1) * 512 + e) * 256 + c * 8) = *(const LAS v4u*)(lds + 98304 + (bf ^ 1) * 16384 + p * 16); } }
#pragma unroll
                for (int g4 = 0; g4 < 4; ++g4) { v2u w; w.x = pk2(st[4 * g4], st[4 * g4 + 1]); w.y = pk2(st[4 * g4 + 2], st[4 * g4 + 3]);
                    *(LAS v2u*)(lds + 98304 + bf * 16384 + el * 256 + ((((wid & 3) * 4 + g4) ^ (el & 15)) * 16) + hh * 8) = w; }
            }
            LAS const unsigned char* kb = lds + slot * 24576 + (wid & 3) * 4096; LAS const unsigned char* vb = lds + slot * 24576 + 16384 + (wid >> 2) * 4096;
#pragma unroll
            for (int s = 0; s < 4; ++s) { const bf16x8 a = cat8(vtr(kb + s * 1024 + voff), vtr(kb + s * 1024 + 512 + voff)), bb = cat8(vtr(vb + s * 1024 + voff), vtr(vb + s * 1024 + 512 + voff));
                st = __builtin_amdgcn_mfma_f32_32x32x16_bf16(a, bb, st, 0, 0, 0); }
            if (m & 1) {
#pragma unroll
                for (int i = 0; i < 16; ++i) st[i] *= gC; }
        }
#undef RS_DMA
        asm volatile("s_waitcnt vmcnt(0) lgkmcnt(0)\n\ts_barrier" ::: "memory");
#pragma unroll
        for (int k2 = 0; k2 < 2; ++k2) { const int p = tid + 512 * k2, e = p >> 4, c = (p & 15) ^ (e & 15);
            *(GAS v4u*)(stg + ((size_t)63 * 512 + e) * 256 + c * 8) = *(const LAS v4u*)(lds + 98304 + 16384 + p * 16); }
        LDS_WAIT(); __syncthreads();
    }
}
__device__ __forceinline__ void ret_main_phase(Frame& F, const bf16* PROJ, const bf16* ST, bf16* AO) { LTID();
    LAS unsigned char* lds = F.lds;
    LAS float* part = (LAS float*)(lds + TBL_OFF + 512);
    for (int L = F.vcu * 4; L < 1024; L += F.G * 4) for (int uu = 0; uu < 4; ++uu) {
        int tid = tid_; asm volatile("" : "+v"(tid));
        const int lane = tid & 63, r32 = lane & 31, hh = lane >> 5, wid = __builtin_amdgcn_readfirstlane(tid >> 6), rg = wid & 3, e2 = wid >> 2;
        const int voff = (4 * hh + ((lane & 15) >> 2)) * 64 + ((lane >> 4) & 1) * 32 + (lane & 3) * 8;
        const int U = L + uu, bh = U >> 6, n = U & 63, b = bh >> 2, h = bh & 3;
        const size_t tokbase = (size_t)b * SEQ + (size_t)n * 128, hb0 = (size_t)bh * SEQ + (size_t)n * 128;
        const bf16* qrow = PROJ + (hb0 + rg * 32 + r32) * 256 + 8 * hh;
        const bf16* stb = ST + ((size_t)bh * 64 + n) * 512 * 256;
        const unsigned ldsb = (unsigned)(uintptr_t)lds + wid * 1024;
#define RM_WAITBAR() asm volatile("s_waitcnt vmcnt(0) lgkmcnt(0)\n\ts_barrier" ::: "memory")
#define RM_DMA_KS(buf) do { _Pragma("unroll") for (int i = 0; i < 8; ++i) { const int idx = tid + 512 * i, tok = idx >> 5, c = (idx & 31) ^ (tok & 31); \
        glds16(PROJ + (size_t)T * 1024 + (hb0 + tok) * 256 + c * 8, (unsigned)__builtin_amdgcn_readfirstlane(ldsb + (buf) * 65536 + i * 8192)); } } while (0)
#define RM_DMA_V(p, buf) do { _Pragma("unroll") for (int i = 0; i < 8; ++i) { const int idx = tid + 512 * i, tok = (idx >> 2) & 127; \
        glds16(PROJ + (size_t)2 * T * 1024 + (hb0 + tok) * 512 + (p) * 256 + (idx >> 9) * 32 + (idx & 3) * 8, (unsigned)__builtin_amdgcn_readfirstlane(ldsb + (buf) * 65536 + i * 8192)); } } while (0)
#define RM_DMA_ST(p, dkh, buf) do { _Pragma("unroll") for (int i = 0; i < 8; ++i) { const int idx = tid + 512 * i, e = idx >> 4, c = (idx & 15) ^ (e & 15); \
        glds16(stb + (size_t)((p) * 256 + e) * 256 + (dkh) * 128 + c * 8, (unsigned)__builtin_amdgcn_readfirstlane(ldsb + (buf) * 65536 + i * 8192)); } } while (0)
        RM_DMA_KS(0);
        bf16x8 pa[4][2];
        {
            bf16x8 qf[16];
#pragma unroll
            for (int s = 0; s < 16; ++s) qf[s] = *(const GAS bf16x8*)(qrow + 16 * s);
            RM_WAITBAR();
            asm volatile("" :: "v"(qf[0]), "v"(qf[1]), "v"(qf[2]), "v"(qf[3]), "v"(qf[4]), "v"(qf[5]), "v"(qf[6]), "v"(qf[7]), "v"(qf[8]), "v"(qf[9]), "v"(qf[10]), "v"(qf[11]), "v"(qf[12]), "v"(qf[13]), "v"(qf[14]), "v"(qf[15]));
            RM_DMA_V(0, 1);
#pragma unroll
            for (int jb = 0; jb < 4; ++jb) {
                f32x16 S = (f32x16){0.f, 0.f, 0.f, 0.f, 0.f, 0.f, 0.f, 0.f, 0.f, 0.f, 0.f, 0.f, 0.f, 0.f, 0.f, 0.f};
                if (jb <= rg) {
#pragma unroll
                    for (int s = 0; s < 16; ++s) { const bf16x8 a = *(const LAS bf16x8*)(lds + (32 * jb + r32) * 512 + (((2 * s + hh) ^ r32) * 16)); S = __builtin_amdgcn_mfma_f32_32x32x16_bf16(a, qf[s], S, 0, 0, 0); }
                    if (jb == rg) {
#pragma unroll
                        for (int i = 0; i < 16; ++i) if (crow(i, hh) > r32) S[i] = 0.f; }
                }
                pa[jb][0] = pack8f(S[0], S[1], S[2], S[3], S[4], S[5], S[6], S[7]); pa[jb][1] = pack8f(S[8], S[9], S[10], S[11], S[12], S[13], S[14], S[15]);
            }
        }
        f32x16 o[8];
#pragma unroll
        for (int eb = 0; eb < 8; ++eb) o[eb] = (f32x16){0.f, 0.f, 0.f, 0.f, 0.f, 0.f, 0.f, 0.f, 0.f, 0.f, 0.f, 0.f, 0.f, 0.f, 0.f, 0.f};
#define RM_PV(BUF, OB) do { _Pragma("unroll") for (int jb = 0; jb < 4; ++jb) if (jb <= rg) { _Pragma("unroll") for (int s2 = 0; s2 < 2; ++s2) { \
            _Pragma("unroll") for (int j = 0; j < 4; ++j) { LAS const unsigned char* vb = lds + (BUF) * 65536 + (e2 * 4 + j) * 8192 + (32 * jb + 16 * s2) * 64 + voff; \
                o[(OB) + j] = __builtin_amdgcn_mfma_f32_32x32x16_bf16(pa[jb][s2], cat8(vtr(vb), vtr(vb + 512)), o[(OB) + j], 0, 0, 0); } \
            __builtin_amdgcn_sched_barrier(0); } } } while (0)
#define RM_QA(DKH) do { _Pragma("unroll") for (int sl = 0; sl < 8; ++sl) qa[sl] = *(const GAS bf16x8*)(qrow + 16 * ((DKH) * 8 + sl)); } while (0)
#define RM_QA_USE() asm volatile("" :: "v"(qa[0]), "v"(qa[1]), "v"(qa[2]), "v"(qa[3]), "v"(qa[4]), "v"(qa[5]), "v"(qa[6]), "v"(qa[7]))
#define RM_CROSS(BUF, OB) do { \
            _Pragma("unroll") for (int sl = 0; sl < 8; ++sl) { \
                _Pragma("unroll") for (int j = 0; j < 4; ++j) { const bf16x8 bb = *(const LAS bf16x8*)(lds + (BUF) * 65536 + ((e2 * 4 + j) * 32 + r32) * 256 + (((2 * sl + hh) ^ (r32 & 15)) * 16)); \
                    o[(OB) + j] = __builtin_amdgcn_mfma_f32_32x32x16_bf16(qa[sl], bb, o[(OB) + j], 0, 0, 0); } \
                __builtin_amdgcn_sched_barrier(0); } } while (0)
        bf16x8 qa[8];
        RM_WAITBAR(); RM_DMA_V(1, 0);      RM_PV(1, 0);
        RM_WAITBAR(); RM_DMA_ST(0, 0, 1);  RM_PV(0, 4);
        RM_QA(0); RM_WAITBAR(); RM_QA_USE(); RM_DMA_ST(0, 1, 0);  RM_CROSS(1, 0);
        RM_QA(1); RM_WAITBAR(); RM_QA_USE(); RM_DMA_ST(1, 0, 1);  RM_CROSS(0, 0);
        RM_QA(0); RM_WAITBAR(); RM_QA_USE(); RM_DMA_ST(1, 1, 0);  RM_CROSS(1, 4);
        RM_QA(1); RM_WAITBAR(); RM_QA_USE();                      RM_CROSS(0, 4);
#undef RM_QA
#undef RM_QA_USE
#undef RM_DMA_KS
#undef RM_DMA_V
#undef RM_DMA_ST
#undef RM_PV
#undef RM_CROSS
#pragma unroll
        for (int i = 0; i < 16; ++i) { float s1 = 0.f, s2 = 0.f;
#pragma unroll
            for (int eb = 0; eb < 8; ++eb) { s1 += o[eb][i]; s2 += o[eb][i] * o[eb][i]; }
            s1 = half_sum32(s1); s2 = half_sum32(s2);
            if (r32 == 0) { part[(e2 * 128 + rg * 32 + crow(i, hh)) * 2] = s1; part[(e2 * 128 + rg * 32 + crow(i, hh)) * 2 + 1] = s2; } }
        asm volatile("s_waitcnt lgkmcnt(0)\n\ts_barrier" ::: "memory");
#undef RM_WAITBAR
#pragma unroll
        for (int i = 0; i < 16; ++i) { const int rl = rg * 32 + crow(i, hh);
            const float s1 = part[rl * 2] + part[(128 + rl) * 2], s2 = part[rl * 2 + 1] + part[(128 + rl) * 2 + 1];
            const float mean = s1 * (1.f / 512.f), var = __builtin_fmaxf(s2 * (1.f / 512.f) - mean * mean, 0.f), rstd = 1.f / sqrtf(var + LN_EPS);
            LAS bf16* tp = (LAS bf16*)(lds + rl * 1024) + e2 * 128 + r32;
#pragma unroll
            for (int eb = 0; eb < 8; ++eb) tp[(eb >> 2) * 256 + (eb & 3) * 32] = (bf16)f2bf((o[eb][i] - mean) * rstd); }
        v4u gv[16];
#pragma unroll
        for (int k = 0; k < 16; ++k) { const int p = tid + 512 * k, row = p >> 6, c16 = p & 63; gv[k] = __builtin_nontemporal_load((const GAS v4u*)(PROJ + (size_t)4 * T * 1024 + (hb0 + row) * 512 + c16 * 8)); }
        __builtin_amdgcn_sched_barrier(0);
        LDS_WAIT(); __syncthreads();
#pragma unroll
        for (int k = 0; k < 16; ++k) { const int p = tid + 512 * k, row = p >> 6, c16 = p & 63;
            const v4u ov = *(const LAS v4u*)(lds + p * 16); v4u r;
#pragma unroll
            for (int q = 0; q < 4; ++q) { const float g0 = bflo(gv[k][q]), g1 = bfhi(gv[k][q]);
                const float s0 = g0 * __builtin_amdgcn_rcpf(1.0f + __builtin_amdgcn_exp2f(-g0 * LOG2E)), s1 = g1 * __builtin_amdgcn_rcpf(1.0f + __builtin_amdgcn_exp2f(-g1 * LOG2E));
                r[q] = pk2(bflo(ov[q]) * s0, bfhi(ov[q]) * s1); }
            *(GAS v4u*)(AO + (tokbase + row) * 2048 + h * 512 + c16 * 8) = r; }
        LDS_WAIT(); __syncthreads();
    }
}
struct Args { const float* in[20]; float* out; unsigned char* ws; int ph_lo, ph_hi; };
constexpr int N_PHASES = 1 + 2 * (3 + 4) + 2 * (4 + 4);

__global__ void __launch_bounds__(NWAVES * 64, 2) mega_fwd(Args args) {
    extern __shared__ __attribute__((aligned(16))) unsigned char lds[];
    Frame F;
    F.lds = (LAS unsigned char*)lds;
    F.MISC = (volatile LAS unsigned*)(F.lds + MISC_OFF);
    F.G = gridDim.x; { const int bx = blockIdx.x; F.vcu = (F.G % 8 == 0) ? (bx % 8) * (F.G / 8) + bx / 8 : bx; }
    F.ctl = (gu32*)(args.ws + WS_CTL);
    for (int u = threadIdx.x; u < (LDS_BYTES - RING_BYTES) / 4; u += NWAVES * 64) ((LAS unsigned*)(F.lds + RING_BYTES))[u] = 0u;
    __syncthreads();
    if ((threadIdx.x & 63) == 0) *(LAS int*)(F.lds + WAVETBL_OFF + ((int)__builtin_amdgcn_s_getreg((5 << 11) | 4) & 63) * 4) = (int)(threadIdx.x >> 6);
    __syncthreads();
    XcdBarrier bar = xcd_barrier_post((unsigned*)(F.ctl + CW_BAR), F.MISC + 8);

    typedef __attribute__((address_space(4))) const unsigned char* kptr_t;
#define KP() kptr_t kp_ = (kptr_t)__builtin_amdgcn_kernarg_segment_ptr(); asm volatile("" : "+s"(kp_))
#define IN_(i) ((const float*)(*(const GAS float* __attribute__((address_space(4))) const*)(kp_ + 8 * (i))))
#define OUT_() ((float*)(*(GAS float* __attribute__((address_space(4))) const*)(kp_ + 160)))
#define WS_(off) ((unsigned char*)(*(GAS unsigned char* __attribute__((address_space(4))) const*)(kp_ + 168)) + (off))
    const int lo = args.ph_lo, hi = args.ph_hi;
    int ph = 0;
#define RUN() (lo <= ph && ph < hi)
#define REP(k) for (int rep_ = 0; rep_ < ((PROBE_DOUBLE == (k)) ? 2 : 1); ++rep_)
#define SEAM() do { for (int sr_ = 0; sr_ < ((PROBE_DOUBLE == 10) ? 2 : 1); ++sr_) if (ph + 1 < hi) { XcdBarrier b_ = bar; asm volatile("" : "+s"(b_.bar), "+s"(b_.x)); b_.bar = (unsigned*)(GAS unsigned*)b_.bar; xcd_barrier(b_); } } while (0)

    if (RUN()) {
        REP(1) { KP();
        p0_family<0>(F, IN_(1), (bf16*)WS_(WS_WDAIN), 2, D, 3072);
        p0_family<0>(F, IN_(2), (bf16*)WS_(WS_WDAOUT), 2, D, D);
        p0_family<0>(F, IN_(8), (bf16*)WS_(WS_WRETIN), 2, D, 6144);
        p0_family<0>(F, IN_(9), (bf16*)WS_(WS_WRETOUT), 2, 2048, D);
        p0_router_image(F, IN_(10), WS_(WS_WIMG));
        p0_x_to_bf16(F, IN_(0), (bf16*)WS_(WS_XB)); }
        SEAM();
    }
    ++ph;

#pragma unroll 1
    for (int layer = 0; layer < DEPTH; ++layer) {
        const int jm = layer >> 1;
        if ((layer & 1) == 0) {
            if (RUN()) {
                KP(); pg8::Gemm g{(bf16*)WS_(WS_XB), (bf16*)WS_(WS_WDAIN) + (size_t)jm * 3072 * D, T, 3072, D}; pg8::StaticOrder S; S.init(T, 3072, F.G, (int)blockIdx.x);
                pg8::EpiScaleBf16 E{(bf16*)WS_(WS_PROJ), 3072, 1024, 0.125f * LOG2E, (unsigned*)(GAS unsigned*)(F.ctl + CW_KMAX + jm * 256)};

REP(2) {
pg8::gemm_phase<pg8::EpiScaleBf16, pg8::StaticOrder, PG8_ALIGN, PG8_SP2>(F.lds, g, S, E);
}

                SEAM();
            }
            ++ph;
            if (RUN()) {
                KP(); float d1 = 0.f, d2 = 0.f;
                { const float* lq1 = IN_(3) + jm * 64; const float* lk1 = IN_(4) + jm * 64; const float* lq2 = IN_(5) + jm * 64; const float* lk2 = IN_(6) + jm * 64;
                  for (int i = 0; i < 64; ++i) { d1 += lq1[i] * lk1[i]; d2 += lq2[i] * lk2[i]; } }
                const float li = (layer == 0) ? 0.2f : 0.47071301834148437f;
                const float lam = __expf(d1) - __expf(d2) + li;

REP(3)
                {
                  const int l0 = (layer == 0) ? 0 : 2, nl = 2;
                  const ConvJob cj{IN_(12) + (size_t)l0 * NEXP * D * 2 * FF, (bf16*)WS_(WS_WGU) + (size_t)l0 * NEXP * D * 2 * FF, IN_(14) + (size_t)l0 * NEXP * FF * D, (bf16*)WS_(WS_WDN) + (size_t)l0 * NEXP * FF * D, (rep_ == 0) ? nl * NEXP : 0, 2};
                  da_attn_phase(F, (const bf16*)WS_(WS_PROJ), (bf16*)WS_(WS_AO), lam, 1.0f - li, IN_(7) + jm * 128, (const unsigned*)(GAS unsigned*)(F.ctl + CW_KMAX + jm * 256), F.ctl + CW_QCTR + jm * 64 + rep_ * 8, cj); }

                SEAM();
            }
            ++ph;
            if (RUN()) {
                KP(); pg8::Gemm g{(bf16*)WS_(WS_AO), (bf16*)WS_(WS_WDAOUT) + (size_t)jm * D * D, T, D, D}; pg8::StaticOrder S; S.init(T, D, F.G, (int)blockIdx.x);
                pg8::EpiRes E{(bf16*)WS_(WS_XB), (bf16*)WS_(WS_Y), D, DN_ALPHA, (float*)WS_(WS_STATS)};

REP(2) {
pg8::gemm_phase<pg8::EpiRes, pg8::StaticOrder, PG8_ALIGN, PG8_SP2>(F.lds, g, S, E);
}

                SEAM();
            }
            ++ph;
        } else {
            const float lg2[4] = {-0.045803689613124784f, -0.022720076500083584f, -0.011315313227834068f, -0.0056465631411835116f};
            if (RUN()) {
                KP(); pg8::Gemm g{(bf16*)WS_(WS_XB), (bf16*)WS_(WS_WRETIN) + (size_t)jm * 6144 * D, T, 6144, D}; pg8::StaticOrder S; S.init(T, 6144, F.G, (int)blockIdx.x);
                pg8::EpiRetProj E{(bf16*)WS_(WS_PROJ), 6144, {lg2[0], lg2[1], lg2[2], lg2[3]}};

REP(2) {
pg8::gemm_phase<pg8::EpiRetProj, pg8::StaticOrder, PG8_ALIGN, PG8_SP2>(F.lds, g, S, E);
}

                SEAM();
            }
            ++ph;
            if (RUN()) {
 KP(); REP(4) ret_scan_phase(F, (const bf16*)WS_(WS_PROJ), (bf16*)WS_(WS_STATE), lg2);
 SEAM(); }
            ++ph;
            if (RUN()) {
 KP(); REP(5) ret_main_phase(F, (const bf16*)WS_(WS_PROJ), (const bf16*)WS_(WS_STATE), (bf16*)WS_(WS_AO));
 SEAM(); }
            ++ph;
            if (RUN()) {
                KP(); pg8::Gemm g{(bf16*)WS_(WS_AO), (bf16*)WS_(WS_WRETOUT) + (size_t)jm * D * 2048, T, D, 2048}; pg8::StaticOrder S; S.init(T, D, F.G, (int)blockIdx.x);
                pg8::EpiRes E{(bf16*)WS_(WS_XB), (bf16*)WS_(WS_Y), D, DN_ALPHA, (float*)WS_(WS_STATS)};

REP(2) {
pg8::gemm_phase<pg8::EpiRes, pg8::StaticOrder, PG8_ALIGN, PG8_SP2>(F.lds, g, S, E);
}

                SEAM();
            }
            ++ph;
        }
        gu32* cnt = F.ctl + CW_CNT + layer * NEXP * 64;
        if (RUN()) {

            KP();
            ln_router_phase(F, (const bf16*)WS_(WS_Y), (const float*)WS_(WS_STATS), IN_(16) + layer * D, IN_(17) + layer * D, (const unsigned char*)WS_(WS_WIMG) + (size_t)layer * 131072, IN_(11) + layer * NEXP, (bf16*)WS_(WS_XB), (int2*)WS_(WS_SLOT), cnt);
            SEAM();
        }
        ++ph;
        if (RUN()) {
            KP(); build_tables(F, cnt);
            pg8::Gemm g{(bf16*)WS_(WS_XB), (bf16*)WS_(WS_WGU) + (size_t)layer * NEXP * 2048 * D, MT_MAX * 256, 2048, D};
            GroupedOrder S{(const LAS int*)(F.lds + TBL_OFF), 8, 4, F.G, (int)blockIdx.x};
            pg8::EpiSwiGLU E{(bf16*)WS_(WS_ACT), IN_(13) + (size_t)layer * NEXP * 2048};

REP(6) {
pg8::gemm_phase<pg8::EpiSwiGLU, GroupedOrder, PG8_ALIGN, PG8_SP2, true>(F.lds, g, S, E, (const int2*)WS_(WS_SLOT), F.lds + TBL_OFF + 4096);
}

            SEAM();
        }
        ++ph;
        if (RUN()) {
            KP(); build_tables(F, cnt);
            pg8::Gemm g{(bf16*)WS_(WS_ACT), (bf16*)WS_(WS_WDN) + (size_t)layer * NEXP * D * FF, MT_MAX * 256, D, FF};
            GroupedOrder S{(const LAS int*)(F.lds + TBL_OFF), 4, 8, F.G, (int)blockIdx.x};
            pg8::EpiDown E{(bf16*)WS_(WS_YE), IN_(15) + (size_t)layer * NEXP * D, (const int2*)WS_(WS_SLOT), T * TOPK};

REP(6) {
pg8::gemm_phase<pg8::EpiDown, GroupedOrder, PG8_ALIGN, PG8_SP2>(F.lds, g, S, E);
}

            SEAM();
        }
        ++ph;
        if (RUN()) { KP(); combine_ln_phase(F, (const bf16*)WS_(WS_YE), IN_(18) + layer * D, IN_(19) + layer * D, (layer == DEPTH - 1) ? OUT_() : (float*)nullptr, (bf16*)WS_(WS_XB)); SEAM(); }
        ++ph;
    }
#undef RUN
#undef SEAM
}

extern "C" void kernel_launch(void* const* d_in, const int* in_sizes, int n_in, void* d_out, int out_size, void* d_ws, size_t ws_size, hipStream_t stream) {
    static int grid = 0;
    if (grid == 0) {
        if (n_in != 20 || in_sizes[0] != T * D || out_size != T * D || ws_size < WS_END) { fprintf(stderr, "kernel_launch: unexpected shapes (n_in %d, in0 %d, out %d, ws %zu); nothing launched\n", n_in, n_in > 0 ? in_sizes[0] : -1, out_size, ws_size); grid = -1; return; }
        int dev = 0, cus = 0, per_cu = 0;
        if (hipGetDevice(&dev) != hipSuccess || hipDeviceGetAttribute(&cus, hipDeviceAttributeMultiprocessorCount, dev) != hipSuccess) { grid = -1; return; }
        if (hipFuncSetAttribute((const void*)mega_fwd, hipFuncAttributeMaxDynamicSharedMemorySize, LDS_BYTES) != hipSuccess) { fprintf(stderr, "kernel_launch: hipFuncSetAttribute failed\n"); grid = -1; return; }
        if (hipOccupancyMaxActiveBlocksPerMultiprocessor(&per_cu, (const void*)mega_fwd, NWAVES * 64, LDS_BYTES) != hipSuccess || per_cu < 1)
            fprintf(stderr, "kernel_launch: note: occupancy query reports %d workgroups per CU\n", per_cu);
        (void)hipGetLastError();
        grid = cus;
    }
    if (grid < 0) return;
    if (hipMemsetAsync((char*)d_ws + WS_CTL, 0, CTL_ZERO_BYTES, stream) != hipSuccess) return;
    Args a{};
    for (int i = 0; i < 20; ++i) a.in[i] = (const float*)d_in[i];
    a.out = (float*)d_out; a.ws = (unsigned char*)d_ws;
#if MK_N_LAUNCHES == 1
    a.ph_lo = 0; a.ph_hi = N_PHASES;
    hipLaunchKernelGGL(mega_fwd, dim3(grid), dim3(NWAVES * 64), LDS_BYTES, stream, a);
#else
    for (int p = 0; p < N_PHASES; ++p) { a.ph_lo = p; a.ph_hi = p + 1; hipLaunchKernelGGL(mega_fwd, dim3(grid), dim3(NWAVES * 64), LDS_BYTES, stream, a); }
#endif
    const hipError_t le = hipPeekAtLastError();
    if (le != hipSuccess) fprintf(stderr, "kernel_launch: launch failed: %s\n", hipGetErrorName(le));
}
```

```cpp
#include <hip/hip_runtime.h>
#include <cstdio>
#include <cstdint>
constexpr int WAVETBL_OFF = 147456 - 256;
__device__ __forceinline__ int hw_tid(__attribute__((address_space(3))) unsigned char* lds0) {
    const int slot = (int)__builtin_amdgcn_s_getreg((5 << 11) | 4) & 63;
    const int wave = __builtin_amdgcn_readfirstlane(*(const __attribute__((address_space(3))) int*)(lds0 + WAVETBL_OFF + slot * 4));
    unsigned z = 0u; asm volatile("" : "+v"(z));
    int t = wave * 64 + (int)__builtin_amdgcn_mbcnt_hi(~0u, __builtin_amdgcn_mbcnt_lo(~0u, z));
    asm volatile("" : "+v"(t)); return t; }
template <int CTRL> __device__ __forceinline__ float dppf(float v) { return __builtin_bit_cast(float, __builtin_amdgcn_update_dpp(0, __builtin_bit_cast(int, v), CTRL, 0xF, 0xF, true)); }
__device__ __forceinline__ float swap16_other(float v, float& self) { float w; asm volatile("s_nop 1\n\tv_permlane16_swap_b32 %0, %1" : "=v"(w), "+v"(v) : "0"(v)); self = v; return w; }
__device__ __forceinline__ float swap32_other(float v, float& self) { float w; asm volatile("s_nop 1\n\tv_permlane32_swap_b32 %0, %1" : "=v"(w), "+v"(v) : "0"(v)); self = v; return w; }
__device__ __forceinline__ float row_sum16(float v) { v += dppf<0xB1>(v); v += dppf<0x4E>(v); v += dppf<0x141>(v); v += dppf<0x140>(v); return v; }
__device__ __forceinline__ float row_max16(float v) { v = __builtin_fmaxf(v, dppf<0xB1>(v)); v = __builtin_fmaxf(v, dppf<0x4E>(v)); v = __builtin_fmaxf(v, dppf<0x141>(v)); v = __builtin_fmaxf(v, dppf<0x140>(v)); return v; }
__device__ __forceinline__ float half_sum32(float v) { v = row_sum16(v); float a; const float b = swap16_other(v, a); return a + b; }
__device__ __forceinline__ float half_max32(float v) { v = row_max16(v); float a; const float b = swap16_other(v, a); return __builtin_fmaxf(a, b); }
__device__ __forceinline__ float wave_sum(float v) { v = half_sum32(v); float a; const float b = swap32_other(v, a); return a + b; }
__device__ __forceinline__ float wave_max(float v) { v = half_max32(v); float a; const float b = swap32_other(v, a); return __builtin_fmaxf(a, b); }
__device__ __forceinline__ float xor32_sum(float v) { float a; const float b = swap32_other(v, a); return a + b; }
__device__ __forceinline__ float xor32_max(float v) { float a; const float b = swap32_other(v, a); return __builtin_fmaxf(a, b); }
__device__ __forceinline__ float xor16_sum(float v) { float a; const float b = swap16_other(v, a); return a + b; }
namespace pg8 {
#define PG8_LAS __attribute__((address_space(3)))
typedef unsigned short bf16_t;
typedef short bf16x8 __attribute__((ext_vector_type(8)));
typedef float f32x4 __attribute__((ext_vector_type(4)));
typedef unsigned u32x4 __attribute__((ext_vector_type(4)));
constexpr int BM = 256, BK = 64, HALF = 128, HTB = HALF * BK * 2  , STAGE_BYTES = 8 * HTB, NXCD = 8, WGM = 4;

__host__ __device__ __forceinline__ int lds_byte(int r, int c) { const int st = (r >> 4) * 2 + (c >> 5), rr = r & 15, cc = c & 31, ob = rr * 64 + cc * 2; return st * 1024 + (ob ^ (((ob >> 9) & 1) << 5)); }
__host__ __device__ __forceinline__ void stage_rc(int b, int& R, int& C) { const int st = b / 1024, sb = b % 1024, swz = sb ^ (((sb >> 9) & 1) << 5); R = (st >> 1) * 16 + swz / 64; C = (st & 1) * 32 + (swz % 64) / 2; }
__host__ __device__ __forceinline__ int perm32(int rho) { const int n = rho >> 4, i = rho & 15; return 8 * (i >> 2) + 4 * n + (i & 3); }

struct Unit { int pm, pn, pb, aux, rows, lt; };
struct Gemm { const bf16_t* A; const bf16_t* Bt; int M, N, K; };

struct StaticOrder {
    int nM, nN, nwg, G, c;
    __host__ __device__ void init(int M, int N, int G_, int c_) { nM = M / BM; nN = N / BM; nwg = nM * nN; G = G_; c = c_; }
    __host__ __device__ bool next(int i, Unit& u) const {
        const long L = (long)i * G + c; if (L >= nwg) return false;
        int wgid = (int)L; { const int q = nwg / NXCD, r = nwg % NXCD, xcd = wgid % NXCD, off = wgid / NXCD; wgid = (xcd < r ? xcd * (q + 1) : r * (q + 1) + (xcd - r) * q) + off; }
        const int nig = WGM * nN, gid = wgid / nig, fm = gid * WGM, gsz = (nM - fm) < WGM ? (nM - fm) : WGM;
        u.pm = fm + ((wgid % nig) % gsz); u.pn = (wgid % nig) / gsz; u.pb = u.pn; u.aux = 0; u.rows = BM; u.lt = 0; return true;
    }
    __device__ __forceinline__ void a_ready(const Unit&) const {}
    __device__ __forceinline__ void done(const Unit&) const {}
};

__device__ __forceinline__ unsigned cvt_pk_bf16(float lo, float hi) { unsigned r; asm volatile("v_cvt_pk_bf16_f32 %0, %1, %2" : "=v"(r) : "v"(lo), "v"(hi)); return r; }
__device__ __forceinline__ u32x4 pack8(const f32x4 v0, const f32x4 v1) { u32x4 w; w.x = cvt_pk_bf16(v0[0], v0[1]); w.y = cvt_pk_bf16(v0[2], v0[3]); w.z = cvt_pk_bf16(v1[0], v1[1]); w.w = cvt_pk_bf16(v1[2], v1[3]); return w; }

struct EpiScaleBf16 {
    static constexpr bool PERM = true, AFTER_DRAIN = false;
    struct Pre {}; __device__ __forceinline__ void preload(Pre&, const Unit&, int, int, int, int) const {}
    __device__ __forceinline__ void init(f32x4 (&acc)[2][2][4][2], const Pre&) const {
#pragma unroll
        for (int a = 0; a < 2; ++a)
#pragma unroll
            for (int b = 0; b < 2; ++b)
#pragma unroll
                for (int m = 0; m < 4; ++m)
#pragma unroll
                    for (int n = 0; n < 2; ++n) acc[a][b][m][n] = (f32x4){0.f, 0.f, 0.f, 0.f}; }
    bf16_t* O; int ldc; int qcols; float qscale; unsigned* kmax;
    __device__ __forceinline__ void operator()(const f32x4 (&acc)[2][2][4][2], const Unit& u, int wr, int wc, int fr, int fq) const {
        const int row0 = u.pm * BM + wr * 64 + fr, col0 = u.pn * BM + wc * 32 + 8 * fq;
        if (u.pn >= 4 && u.pn < 8) {
#pragma unroll
            for (int bj = 0; bj < 2; ++bj) { float mx = 0.f;
#pragma unroll
                for (int ai = 0; ai < 2; ++ai)
#pragma unroll
                    for (int m = 0; m < 4; ++m) { const f32x4 a = acc[ai][bj][m][0], c = acc[ai][bj][m][1];
                        float ss = (a[0] * a[0] + a[1] * a[1]) + (a[2] * a[2] + a[3] * a[3]) + (c[0] * c[0] + c[1] * c[1]) + (c[2] * c[2] + c[3] * c[3]);
                        ss = xor32_sum(xor16_sum(ss)); mx = __builtin_fmaxf(mx, ss); }
                mx = row_max16(mx);
                if (fr == 0 && fq == 0) { const int b = u.pm >> 5, hm = (u.pn - 4) * 4 + bj * 2 + (wc >> 1);
                    __hip_atomic_fetch_max(kmax + ((b * 16 + hm) * 2 + (wc & 1)), __builtin_bit_cast(unsigned, mx), __ATOMIC_RELAXED, __HIP_MEMORY_SCOPE_AGENT); } }
        }
#pragma unroll
        for (int ai = 0; ai < 2; ++ai)
#pragma unroll
            for (int m = 0; m < 4; ++m) { bf16_t* rowp = O + (size_t)(row0 + ai * HALF + m * 16) * ldc + col0;
#pragma unroll
                for (int bj = 0; bj < 2; ++bj) { const float sc = (col0 + bj * HALF) < qcols ? qscale : 1.f;
                    *(u32x4*)(rowp + bj * HALF) = pack8(acc[ai][bj][m][0] * sc, acc[ai][bj][m][1] * sc); } }
    }
};

struct EpiRetProj {
    static constexpr bool PERM = true, AFTER_DRAIN = false;
    struct Pre {}; __device__ __forceinline__ void preload(Pre&, const Unit&, int, int, int, int) const {}
    __device__ __forceinline__ void init(f32x4 (&acc)[2][2][4][2], const Pre&) const {
#pragma unroll
        for (int a = 0; a < 2; ++a)
#pragma unroll
            for (int b = 0; b < 2; ++b)
#pragma unroll
                for (int m = 0; m < 4; ++m)
#pragma unroll
                    for (int n = 0; n < 2; ++n) acc[a][b][m][n] = (f32x4){0.f, 0.f, 0.f, 0.f}; }
    bf16_t* O; int ldc; float lg2[4];
    __device__ __forceinline__ void operator()(const f32x4 (&acc)[2][2][4][2], const Unit& u, int wr, int wc, int fr, int fq) const {
        const int row0 = u.pm * BM + wr * 64 + fr, cl = wc * 32 + 8 * fq;
#pragma unroll
        for (int bj = 0; bj < 2; ++bj) {
            const int c0 = u.pn * BM + bj * HALF, sect = c0 >> 10;
            int head, width, colh; size_t base;
            if (sect < 2) { head = (c0 >> 8) & 3; width = 256; colh = (c0 & 255) + cl; base = (size_t)sect * 33554432; }
            else if (sect < 4) { head = (c0 - 2048) >> 9; width = 512; colh = ((c0 - 2048) & 511) + cl; base = (size_t)2 * 33554432; }
            else { head = (c0 - 4096) >> 9; width = 512; colh = ((c0 - 4096) & 511) + cl; base = (size_t)4 * 33554432; }
            const float lg = head == 0 ? lg2[0] : head == 1 ? lg2[1] : head == 2 ? lg2[2] : lg2[3];
#pragma unroll
            for (int ai = 0; ai < 2; ++ai)
#pragma unroll
                for (int m = 0; m < 4; ++m) { const int row = row0 + ai * HALF + m * 16; const float jp = (float)((row & 127) + 1);
                    float sc = 1.f; if (sect == 0) sc = __builtin_amdgcn_exp2f(jp * lg); else if (sect == 1) sc = 0.0625f * __builtin_amdgcn_exp2f(-jp * lg);
                    const size_t off = base + ((size_t)(((row >> 13) * 4 + head) * 8192 + (row & 8191))) * width + colh;
                    *(u32x4*)(O + off) = pack8(acc[ai][bj][m][0] * sc, acc[ai][bj][m][1] * sc); } }
    }
};

struct EpiRes {
    static constexpr bool PERM = false, AFTER_DRAIN = false;
    struct Pre {}; __device__ __forceinline__ void preload(Pre&, const Unit&, int, int, int, int) const {}
    __device__ __forceinline__ void init(f32x4 (&acc)[2][2][4][2], const Pre&) const {
#pragma unroll
        for (int a = 0; a < 2; ++a)
#pragma unroll
            for (int b = 0; b < 2; ++b)
#pragma unroll
                for (int m = 0; m < 4; ++m)
#pragma unroll
                    for (int n = 0; n < 2; ++n) acc[a][b][m][n] = (f32x4){0.f, 0.f, 0.f, 0.f}; }
    const bf16_t* XB; bf16_t* Y; int ldc; float alpha; float* STATS;
    __device__ __forceinline__ void operator()(const f32x4 (&acc)[2][2][4][2], const Unit& u, int wr, int wc, int fr, int fq) const {
        typedef unsigned u32x2 __attribute__((ext_vector_type(2)));
        const int row0 = u.pm * BM + wr * 64 + fr, col0 = u.pn * BM + wc * 32 + 4 * fq;
        u32x2 xr[2][4][2][2];
#pragma unroll
        for (int ai = 0; ai < 2; ++ai)
#pragma unroll
            for (int m = 0; m < 4; ++m) { const size_t off = (size_t)(row0 + ai * HALF + m * 16) * ldc + col0;
#pragma unroll
                for (int bj = 0; bj < 2; ++bj)
#pragma unroll
                    for (int n = 0; n < 2; ++n) xr[ai][m][bj][n] = *(const u32x2*)(XB + off + bj * HALF + n * 16); }
        __builtin_amdgcn_sched_barrier(0);
#pragma unroll
        for (int ai = 0; ai < 2; ++ai)
#pragma unroll
            for (int m = 0; m < 4; ++m) { const size_t off = (size_t)(row0 + ai * HALF + m * 16) * ldc + col0; float s1 = 0.f, s2 = 0.f;
#pragma unroll
                for (int bj = 0; bj < 2; ++bj)
#pragma unroll
                    for (int n = 0; n < 2; ++n) { const u32x2 xw = xr[ai][m][bj][n];
                        const f32x4 x = (f32x4){__builtin_bit_cast(float, xw.x << 16), __builtin_bit_cast(float, xw.x & 0xffff0000u), __builtin_bit_cast(float, xw.y << 16), __builtin_bit_cast(float, xw.y & 0xffff0000u)};
                        const f32x4 y = x * alpha + acc[ai][bj][m][n]; { u32x2 yw; yw.x = cvt_pk_bf16(y[0], y[1]); yw.y = cvt_pk_bf16(y[2], y[3]); *(u32x2*)(Y + off + bj * HALF + n * 16) = yw; }
                        s1 += (y[0] + y[1]) + (y[2] + y[3]); s2 += (y[0] * y[0] + y[1] * y[1]) + (y[2] * y[2] + y[3] * y[3]); }
                s1 = xor32_sum(xor16_sum(s1)); s2 = xor32_sum(xor16_sum(s2));
                if (fq == 0) { typedef float f32x2s __attribute__((ext_vector_type(2))); *(f32x2s*)(STATS + ((size_t)(row0 + ai * HALF + m * 16) * 16 + u.pn * 4 + wc) * 2) = (f32x2s){s1, s2}; } }
    }
};

struct EpiSwiGLU {
    static constexpr bool PERM = true, AFTER_DRAIN = false;
    bf16_t* ACT; const float* bgu;
    struct Pre { f32x4 v[4]; };
    __device__ __forceinline__ void preload(Pre& p, const Unit& u, int wr, int wc, int fr, int fq) const {
        const float* be = bgu + (size_t)u.aux * 2048 + u.pn * HALF + wc * 32 + 8 * fq;
        p.v[0] = *(const f32x4*)(be); p.v[1] = *(const f32x4*)(be + 4); p.v[2] = *(const f32x4*)(be + 1024); p.v[3] = *(const f32x4*)(be + 1028); }
    __device__ __forceinline__ void init(f32x4 (&acc)[2][2][4][2], const Pre& p) const {
#pragma unroll
        for (int a = 0; a < 2; ++a)
#pragma unroll
            for (int m = 0; m < 4; ++m) { acc[a][0][m][0] = p.v[0]; acc[a][0][m][1] = p.v[1]; acc[a][1][m][0] = p.v[2]; acc[a][1][m][1] = p.v[3]; } }
    __device__ __forceinline__ void operator()(const f32x4 (&acc)[2][2][4][2], const Unit& u, int wr, int wc, int fr, int fq) const {
        const int row0 = u.pm * BM + wr * 64 + fr, f0 = u.pn * HALF + wc * 32 + 8 * fq;
#pragma unroll
        for (int ai = 0; ai < 2; ++ai)
#pragma unroll
            for (int m = 0; m < 4; ++m) {
                f32x4 o[2];
#pragma unroll
                for (int n = 0; n < 2; ++n) { const f32x4 g4 = acc[ai][0][m][n], u4 = acc[ai][1][m][n];
#pragma unroll
                    for (int i = 0; i < 4; i += 2) {
                        typedef float f32x2p __attribute__((ext_vector_type(2)));
                        const f32x2p g = {__builtin_amdgcn_fmed3f(g4[i], -3.0e38f, 7.0f), __builtin_amdgcn_fmed3f(g4[i + 1], -3.0e38f, 7.0f)}, up = {__builtin_amdgcn_fmed3f(u4[i], -7.0f, 7.0f), __builtin_amdgcn_fmed3f(u4[i + 1], -7.0f, 7.0f)};
                        const f32x2p a = g * (f32x2p){-1.702f * 1.4426950408889634f, -1.702f * 1.4426950408889634f};
                        const f32x2p d = (f32x2p){__builtin_amdgcn_exp2f(a.x), __builtin_amdgcn_exp2f(a.y)} + (f32x2p){1.0f, 1.0f};
                        const f32x2p t = g * (f32x2p){__builtin_amdgcn_rcpf(d.x), __builtin_amdgcn_rcpf(d.y)};
                        const f32x2p r = __builtin_elementwise_fma(t, up, t); o[n][i] = r.x; o[n][i + 1] = r.y; } }
                *(u32x4*)(ACT + (size_t)(row0 + ai * HALF + m * 16) * 1024 + f0) = pack8(o[0], o[1]); }
    }
};

constexpr int GCAP_SLOTS = 32768;
struct EpiDown {
    static constexpr bool PERM = true, AFTER_DRAIN = false;
    struct Pre { f32x4 v[4]; };
    __device__ __forceinline__ void preload(Pre& p, const Unit& u, int wr, int wc, int fr, int fq) const {
        const float* be = bd + (size_t)u.aux * 1024 + u.pn * BM + wc * 32 + 8 * fq;
        p.v[0] = *(const f32x4*)(be); p.v[1] = *(const f32x4*)(be + 4); p.v[2] = *(const f32x4*)(be + HALF); p.v[3] = *(const f32x4*)(be + HALF + 4); }
    __device__ __forceinline__ void init(f32x4 (&acc)[2][2][4][2], const Pre& p) const {
#pragma unroll
        for (int bj = 0; bj < 2; ++bj)
#pragma unroll
            for (int a = 0; a < 2; ++a)
#pragma unroll
                for (int m = 0; m < 4; ++m) { acc[a][bj][m][0] = p.v[2 * bj]; acc[a][bj][m][1] = p.v[2 * bj + 1]; } }
    bf16_t* YE; const float* bd; const int2* SLOT; int dummy_row;
    __device__ __forceinline__ void operator()(const f32x4 (&acc)[2][2][4][2], const Unit& u, int wr, int wc, int fr, int fq) const {
        int rl0 = wr * 64 + fr; asm volatile("" : "+v"(rl0));
        const int col0 = u.pn * BM + wc * 32 + 8 * fq;
        int2 sr[2][4];
#pragma unroll
        for (int ai = 0; ai < 2; ++ai)
#pragma unroll
            for (int m = 0; m < 4; ++m) { const int rl = rl0 + ai * HALF + m * 16;
                sr[ai][m] = SLOT[(size_t)u.aux * GCAP_SLOTS + (size_t)u.lt * BM + (rl < u.rows ? rl : 0)]; }
        __builtin_amdgcn_sched_barrier(0);
#pragma unroll
        for (int ai = 0; ai < 2; ++ai)
#pragma unroll
            for (int m = 0; m < 4; ++m) { const int rl = rl0 + ai * HALF + m * 16; const bool ok = rl < u.rows;
                const int2 s = sr[ai][m]; const float w = __int_as_float(s.y); bf16_t* rowp = YE + (size_t)(ok ? s.x : dummy_row) * 1024 + col0;
#pragma unroll
                for (int bj = 0; bj < 2; ++bj) *(u32x4*)(rowp + bj * HALF) = pack8(acc[ai][bj][m][0] * w, acc[ai][bj][m][1] * w); }
    }
};

constexpr int GCAP = GCAP_SLOTS;
template <class Epi, class Sched, bool ALIGN_EPI = false, bool SP2 = false, bool GATHER = false>
__device__ __forceinline__ void gemm_phase(PG8_LAS unsigned char* lds, const Gemm g, const Sched& S, const Epi& E, const int2* gslot = nullptr, PG8_LAS unsigned char* gtab = nullptr) {
    static_assert(!GATHER || SP2, "the gather path is written for the SP2 loop only");
    const int tid = hw_tid(lds); const int wid = __builtin_amdgcn_readfirstlane(tid >> 6), lane = tid & 63, wr = wid >> 2, wc = wid & 3, fr = lane & 15, fq = lane >> 4;
    const int K = g.K, nt = K / BK;
    unsigned voffA[2], voffB[2];
#pragma unroll
    for (int i = 0; i < 2; ++i) { int R, C; stage_rc(tid * 16 + i * 8192, R, C); const int Rb = Epi::PERM ? ((R & ~31) + perm32(R & 31)) : R;
        voffA[i] = (unsigned)(R * K + C) * 2u; voffB[i] = (unsigned)(Rb * K + C) * 2u; }
    unsigned vC[2][2], vN[2][2]; int grl[2]; unsigned gcb[2];
#pragma unroll
    for (int i = 0; i < 2; ++i) { int R, C; stage_rc(tid * 16 + i * 8192, R, C); grl[i] = R; gcb[i] = (unsigned)C * 2u; }
#pragma unroll
    for (int h = 0; h < 2; ++h)
#pragma unroll
        for (int i = 0; i < 2; ++i) { vC[h][i] = 0u; vN[h][i] = 0u; }
#define PG8_GDMA(u, par) do { int gl_ = lane; asm volatile("" : "+v"(gl_));        \
        if (wid < 2) __builtin_amdgcn_global_load_lds((const unsigned*)((const char*)gslot + ((size_t)(u).aux * GCAP + (size_t)(u).lt * 256) * 8 + (size_t)(wid * 64 + gl_) * 16), \
        (PG8_LAS unsigned*)(gtab + (par) * 2048 + wid * 1024), 16, 0, 0); } while (0)
#define PG8_GREAD(dst, u, par) do { _Pragma("unroll") for (int h_ = 0; h_ < 2; ++h_) _Pragma("unroll") for (int i_ = 0; i_ < 2; ++i_) { const int rl_ = 128 * h_ + grl[i_]; \
        const int tk_ = *(const PG8_LAS int*)(gtab + (par) * 2048 + rl_ * 8); const unsigned tok_ = (rl_ < (u).rows) ? ((unsigned)tk_ >> 2) : 0u; dst[h_][i_] = tok_ * (unsigned)(K * 2) + gcb[i_]; } } while (0)
#define PG8_AH(h) (GATHER ? (size_t)0 : (size_t)(h) * hstep)
#define PG8_VA(arr, h) (GATHER ? arr[h] : voffA)
    const size_t kstep = (size_t)(BK * 2);
    const size_t hstep = (size_t)HALF * K * 2;
    const size_t tstep = 2 * hstep;
    const unsigned ldsw = (unsigned)wid * 1024u;
    const int aoff = lds_byte(wr * 64 + fr, fq * 8), boff = lds_byte(wc * 32 + fr, fq * 8);
#define PG8_SA(b, h) (((b) * 2 + (h)) * HTB)
#define PG8_SB(b, h) ((4 + (b) * 2 + (h)) * HTB)
#define PG8_STAGE(bufoff, gbase, voff) do { _Pragma("unroll") for (int _i = 0; _i < 2; ++_i) \
        __builtin_amdgcn_global_load_lds((const unsigned*)((const char*)(gbase) + (voff)[_i]), (PG8_LAS unsigned*)(lds + (bufoff) + ldsw + _i * 8192), 16, 0, 0); } while (0)
#define PG8_LDA(dst, b, h) do { _Pragma("unroll") for (int m = 0; m < 4; ++m) _Pragma("unroll") for (int k = 0; k < 2; ++k) dst[m][k] = *(const PG8_LAS bf16x8*)(lds + PG8_SA(b, h) + aoff + m * 2048 + k * 1024); } while (0)
#define PG8_LDB(dst, b, h) do { _Pragma("unroll") for (int n = 0; n < 2; ++n) _Pragma("unroll") for (int k = 0; k < 2; ++k) dst[n][k] = *(const PG8_LAS bf16x8*)(lds + PG8_SB(b, h) + boff + n * 2048 + k * 1024); } while (0)
#define PG8_MMA(ai, bj, At, Bt) do { __builtin_amdgcn_s_setprio(1); _Pragma("unroll") for (int m = 0; m < 4; ++m) _Pragma("unroll") for (int n = 0; n < 2; ++n) _Pragma("unroll") for (int k = 0; k < 2; ++k) \
        acc[ai][bj][m][n] = __builtin_amdgcn_mfma_f32_16x16x32_bf16(Bt[n][k], At[m][k], acc[ai][bj][m][n], 0, 0, 0); __builtin_amdgcn_s_setprio(0); } while (0)
#define PG8_WAIT_V(n) asm volatile("s_waitcnt vmcnt(" #n ")" ::: "memory")
#define PG8_WAIT_L(n) asm volatile("s_waitcnt lgkmcnt(" #n ")" ::: "memory")
#define PG8_BAR __builtin_amdgcn_s_barrier()
#define PG8_SCHED __builtin_amdgcn_sched_barrier(0)
    Unit cur, nxt; int ui = 0;
    if (!S.next(0, cur)) return;
    f32x4 acc[2][2][4][2];
    { typename Epi::Pre pre0; E.preload(pre0, cur, wr, wc, fr, fq); E.init(acc, pre0); }
    bf16x8 At[4][2], B0[2][2], B1[2][2];
    const char* cA = GATHER ? (const char*)g.A : (const char*)g.A + (size_t)cur.pm * tstep; const char* cB = (const char*)g.Bt + (size_t)cur.pb * tstep;
    if constexpr (GATHER) { PG8_GDMA(cur, 0); asm volatile("s_waitcnt vmcnt(0)" ::: "memory"); __syncthreads(); PG8_GREAD(vC, cur, 0); }
    S.a_ready(cur);
    if constexpr (SP2) {
        PG8_STAGE(PG8_SB(0, 0), cB, voffB); PG8_STAGE(PG8_SB(0, 1), cB + hstep, voffB); PG8_STAGE(PG8_SA(0, 0), cA, PG8_VA(vC, 0)); PG8_STAGE(PG8_SA(0, 1), cA + PG8_AH(1), PG8_VA(vC, 1));
        if (wr == 1) PG8_BAR;
        PG8_WAIT_V(2); PG8_BAR;
        PG8_STAGE(PG8_SB(1, 0), cB + kstep, voffB); PG8_STAGE(PG8_SA(1, 0), cA + kstep, PG8_VA(vC, 0)); PG8_STAGE(PG8_SB(1, 1), cB + hstep + kstep, voffB);
        PG8_WAIT_V(6); PG8_BAR;
    } else {
        PG8_STAGE(PG8_SB(0, 0), cB, voffB); PG8_STAGE(PG8_SA(0, 0), cA, voffA); PG8_STAGE(PG8_SB(0, 1), cB + hstep, voffB); PG8_STAGE(PG8_SA(0, 1), cA + hstep, voffA);
        if (wr == 1) PG8_BAR;
        PG8_WAIT_V(4); PG8_BAR;
        PG8_STAGE(PG8_SB(1, 0), cB + kstep, voffB); PG8_STAGE(PG8_SA(1, 0), cA + kstep, voffA); PG8_STAGE(PG8_SB(1, 1), cB + hstep + kstep, voffB);
        PG8_WAIT_V(6); PG8_BAR;
    }
    for (;;) {
        const bool has_next = S.next(ui + 1, nxt);
        if constexpr (GATHER) { if (has_next) PG8_GDMA(nxt, (ui + 1) & 1); }
        const char* nA = (has_next && !GATHER) ? (const char*)g.A + (size_t)nxt.pm * tstep : cA; const char* nB = has_next ? (const char*)g.Bt + (size_t)nxt.pb * tstep : cB;
        for (int t = 0; t < nt; t += 2) {
            const bool last = (t == nt - 2);
            const char* a1 = cA + (size_t)(t + 1) * kstep;
            const char* a2 = last ? nA : cA + (size_t)(t + 2) * kstep; const char* b2 = last ? nB : cB + (size_t)(t + 2) * kstep;
            const char* a3 = a2 + kstep; const char* b3 = b2 + kstep;
            if (last && has_next) S.a_ready(nxt);
            if constexpr (GATHER) { if (last) { if (has_next) { PG8_GREAD(vN, nxt, (ui + 1) & 1); } else { _Pragma("unroll") for (int h_ = 0; h_ < 2; ++h_) _Pragma("unroll") for (int i_ = 0; i_ < 2; ++i_) vN[h_][i_] = vC[h_][i_]; } } }
            unsigned vS[2][2];
#pragma unroll
            for (int h_ = 0; h_ < 2; ++h_)
#pragma unroll
                for (int i_ = 0; i_ < 2; ++i_) vS[h_][i_] = (GATHER && last) ? vN[h_][i_] : vC[h_][i_];
            if constexpr (SP2) {
            PG8_LDB(B0, 0, 0); PG8_LDB(B1, 0, 1); PG8_SCHED; PG8_LDA(At, 0, 0); PG8_STAGE(PG8_SA(1, 1), a1 + PG8_AH(1), PG8_VA(vC, 1));
            PG8_WAIT_V(8); PG8_WAIT_L(0); PG8_BAR; PG8_MMA(0, 0, At, B0); PG8_MMA(0, 1, At, B1); PG8_BAR; PG8_SCHED;
            PG8_LDA(At, 0, 1); PG8_STAGE(PG8_SB(0, 0), b2, voffB); PG8_STAGE(PG8_SB(0, 1), b2 + hstep, voffB); PG8_STAGE(PG8_SA(0, 0), a2, PG8_VA(vS, 0));
            PG8_WAIT_V(8); PG8_WAIT_L(0); PG8_BAR; PG8_MMA(1, 0, At, B0); PG8_MMA(1, 1, At, B1); PG8_BAR; PG8_SCHED;
            PG8_LDB(B0, 1, 0); PG8_LDB(B1, 1, 1); PG8_SCHED; PG8_LDA(At, 1, 0); PG8_STAGE(PG8_SA(0, 1), a2 + PG8_AH(1), PG8_VA(vS, 1));
            PG8_WAIT_V(8); PG8_WAIT_L(0); PG8_BAR; PG8_MMA(0, 0, At, B0); PG8_MMA(0, 1, At, B1); PG8_BAR; PG8_SCHED;
            PG8_LDA(At, 1, 1); PG8_STAGE(PG8_SB(1, 0), b3, voffB); PG8_STAGE(PG8_SB(1, 1), b3 + hstep, voffB); PG8_STAGE(PG8_SA(1, 0), a3, PG8_VA(vS, 0));
            PG8_WAIT_V(8); PG8_WAIT_L(0); PG8_BAR; PG8_MMA(1, 0, At, B0); PG8_MMA(1, 1, At, B1); PG8_BAR; PG8_SCHED;
            } else {
            PG8_LDB(B0, 0, 0); PG8_SCHED; PG8_LDA(At, 0, 0); PG8_STAGE(PG8_SA(1, 1), a1 + hstep, voffA);
            PG8_WAIT_L(8); PG8_BAR; PG8_WAIT_L(0); PG8_MMA(0, 0, At, B0); PG8_BAR; PG8_SCHED;
            PG8_LDB(B1, 0, 1); PG8_STAGE(PG8_SB(0, 0), b2, voffB);
            PG8_BAR; PG8_WAIT_L(0); PG8_MMA(0, 1, At, B1); PG8_BAR;
            PG8_LDA(At, 0, 1); PG8_STAGE(PG8_SA(0, 0), a2, voffA);
            PG8_BAR; PG8_WAIT_L(0); PG8_MMA(1, 0, At, B0); PG8_BAR; PG8_SCHED;
            PG8_STAGE(PG8_SB(0, 1), b2 + hstep, voffB);
            PG8_WAIT_V(6); PG8_BAR; PG8_MMA(1, 1, At, B1); PG8_BAR;
            PG8_LDB(B0, 1, 0); PG8_SCHED; PG8_LDA(At, 1, 0); PG8_STAGE(PG8_SA(0, 1), a2 + hstep, voffA);
            PG8_WAIT_L(8); PG8_BAR; PG8_WAIT_L(0); PG8_MMA(0, 0, At, B0); PG8_BAR; PG8_SCHED;
            PG8_LDB(B1, 1, 1); PG8_STAGE(PG8_SB(1, 0), b3, voffB);
            PG8_BAR; PG8_WAIT_L(0); PG8_MMA(0, 1, At, B1); PG8_BAR;
            PG8_LDA(At, 1, 1); PG8_STAGE(PG8_SA(1, 0), a3, voffA);
            PG8_BAR; PG8_WAIT_L(0); PG8_MMA(1, 0, At, B0); PG8_BAR; PG8_SCHED;
            PG8_STAGE(PG8_SB(1, 1), b3 + hstep, voffB);
            PG8_WAIT_V(6); PG8_BAR; PG8_MMA(1, 1, At, B1); PG8_BAR;
            }
        }
        if constexpr (ALIGN_EPI) { if (wr == 0) PG8_BAR; }
        typename Epi::Pre pre; E.preload(pre, has_next ? nxt : cur, wr, wc, fr, fq); __builtin_amdgcn_sched_barrier(0);
        if constexpr (!Epi::AFTER_DRAIN) { E(acc, cur, wr, wc, fr, fq); S.done(cur); }
        if (!has_next) break;
        E.init(acc, pre);
        cur = nxt; cA = nA; cB = nB; ++ui;
        if constexpr (GATHER) { _Pragma("unroll") for (int h_ = 0; h_ < 2; ++h_) _Pragma("unroll") for (int i_ = 0; i_ < 2; ++i_) vC[h_][i_] = vN[h_][i_]; }
        if constexpr (ALIGN_EPI) { if (wr == 1) PG8_BAR; }
    }
    PG8_WAIT_V(0);
    if constexpr (!ALIGN_EPI) { if (wr == 0) PG8_BAR; }
    PG8_BAR;
    if constexpr (Epi::AFTER_DRAIN) { E.fused(acc, cur, wr, wc, fr, fq, lds, wid, lane); S.done(cur); }
#undef PG8_SA
#undef PG8_GDMA
#undef PG8_GREAD
#undef PG8_AH
#undef PG8_VA
#undef PG8_SB
#undef PG8_STAGE
#undef PG8_LDA
#undef PG8_LDB
#undef PG8_MMA
#undef PG8_WAIT_V
#undef PG8_WAIT_L
#undef PG8_BAR
#undef PG8_SCHED
}
}
#ifndef PG8_SP2
#define PG8_SP2 true
#endif
#ifndef PG8_ALIGN
#define PG8_ALIGN true
#endif
#ifndef PROBE_DOUBLE
#define PROBE_DOUBLE 0
#endif
#ifndef MK_N_LAUNCHES
#define MK_N_LAUNCHES 1
#endif

constexpr int NWAVES = 8;
constexpr int BATCH = 4, SEQ = 8192, D = 1024, T = BATCH * SEQ, DEPTH = 4;
constexpr int NEXP = 32, TOPK = 4, FF = 1024;
constexpr int DA_H = 8, RET_H = 4;
constexpr float LN_EPS = 1e-5f;
constexpr float DN_ALPHA = 1.6817928305074290f;
constexpr float LOG2E = 1.4426950408889634f;
constexpr int MT_MAX = T * TOPK / 256 + NEXP;

constexpr size_t MiB = 1u << 20;
constexpr size_t WS_CTL = 0, CTL_ZERO_BYTES = 192 * 1024;
constexpr size_t WS_WIMG = 2 * MiB;
constexpr size_t WS_STATS = 4 * MiB;
constexpr size_t WS_WDAIN = 16 * MiB;
constexpr size_t WS_WDAOUT = 28 * MiB;
constexpr size_t WS_WRETIN = 32 * MiB;
constexpr size_t WS_WRETOUT = 56 * MiB;
constexpr size_t WS_WGU = 64 * MiB;
constexpr size_t WS_WDN = 576 * MiB;
constexpr size_t WS_XB = 832 * MiB;
constexpr size_t WS_Y = 896 * MiB;
constexpr size_t WS_PROJ = 1024 * MiB;
constexpr size_t WS_AO = 1408 * MiB;
constexpr size_t WS_STATE = 1536 * MiB;
constexpr size_t WS_XS = 1792 * MiB;
constexpr size_t WS_ACT = 2064 * MiB;
constexpr size_t WS_YE = 2336 * MiB;
constexpr size_t WS_ROUTE = 2592 * MiB;
constexpr size_t WS_SLOT = 2596 * MiB;
constexpr size_t WS_END = 2608 * MiB;
constexpr int CW_BAR = 4096;
constexpr int CW_CNT = 16384;
constexpr int CW_KMAX = 32768;
constexpr int CW_QCTR = 33280;
constexpr int RING_BYTES = 131072;
constexpr int MISC_OFF = RING_BYTES + 320;
constexpr int TBL_OFF = RING_BYTES + 1024;
constexpr int LDS_BYTES = 147456;

#define GAS __attribute__((address_space(1)))
#define LAS __attribute__((address_space(3)))
typedef unsigned short bf16;
typedef unsigned v4u __attribute__((ext_vector_type(4)));
typedef unsigned v2u __attribute__((ext_vector_type(2)));
typedef float f32x4 __attribute__((ext_vector_type(4)));
typedef float f32x16 __attribute__((ext_vector_type(16)));
typedef short bf16x8 __attribute__((ext_vector_type(8)));
typedef short s16x4 __attribute__((ext_vector_type(4)));
typedef GAS unsigned gu32;
#define RLX_AGENT __ATOMIC_RELAXED, __HIP_MEMORY_SCOPE_AGENT
#define LDS_WAIT() asm volatile("s_waitcnt lgkmcnt(0)" ::: "memory")
#define VM_WAIT() asm volatile("s_waitcnt vmcnt(0)" ::: "memory")
__device__ __forceinline__ unsigned f2bf(float f) { unsigned u = __builtin_bit_cast(unsigned, f); return (u + 0x7fffu + ((u >> 16) & 1u)) >> 16; }
typedef float f32x2_t __attribute__((ext_vector_type(2))); typedef __bf16 bf16x2_t __attribute__((ext_vector_type(2)));
__device__ __forceinline__ unsigned pk2(float lo, float hi) { f32x2_t v = {lo, hi}; bf16x2_t b = __builtin_convertvector(v, bf16x2_t); return __builtin_bit_cast(unsigned, b); }
__device__ __forceinline__ float bf2f(unsigned short h) { return __builtin_bit_cast(float, (unsigned)h << 16); }
__device__ __forceinline__ float bflo(unsigned w) { return __builtin_bit_cast(float, w << 16); }
__device__ __forceinline__ float bfhi(unsigned w) { return __builtin_bit_cast(float, w & 0xffff0000u); }
__device__ __forceinline__ int crow(int r, int hi) { return (r & 3) + 8 * (r >> 2) + 4 * hi; }
typedef short v4i16_t __attribute__((ext_vector_type(4)));
__device__ __forceinline__ s16x4 vtr(LAS const unsigned char* p) { return __builtin_bit_cast(s16x4, __builtin_amdgcn_ds_read_tr16_b64_v4i16((LAS v4i16_t*)p)); }
__device__ __forceinline__ bf16x8 cat8(s16x4 lo, s16x4 hi) { return (bf16x8){lo[0], lo[1], lo[2], lo[3], hi[0], hi[1], hi[2], hi[3]}; }
__device__ __forceinline__ bf16x8 pack8f(float a0, float a1, float a2, float a3, float a4, float a5, float a6, float a7) {
    v4u w; w.x = pk2(a0, a1); w.y = pk2(a2, a3); w.z = pk2(a4, a5); w.w = pk2(a6, a7); return __builtin_bit_cast(bf16x8, w); }
#define XB_TMO      128
#define XB_XCNT(j)  (256  + 64 * (j))
#define XB_XSUB(j)  (1280 + 64 * (j))
#define XB_XGEN(j)  (2304 + 64 * (j))
#define XB_TOP      3328
#define XB_TOPGEN   3392
#define XCD_BAR_WORDS 3456
#define XB_SPIN_CAP (1u << 24)

__device__ __forceinline__ unsigned xb_ld(unsigned* p)              { return __hip_atomic_load(p, __ATOMIC_RELAXED, __HIP_MEMORY_SCOPE_AGENT); }
__device__ __forceinline__ unsigned xb_add(unsigned* p, unsigned v) { return __hip_atomic_fetch_add(p, v, __ATOMIC_RELAXED, __HIP_MEMORY_SCOPE_AGENT); }
__device__ __forceinline__ unsigned xb_xcc_id() { return (unsigned)__builtin_amdgcn_s_getreg((3 << 11) | 20) & 0xFu; }
#define XB_SPIN(cond, bar) do { unsigned _sp = 0; while (cond) { __builtin_amdgcn_s_sleep(1); \
    if ((++_sp & 255u) == 0u) { if (xb_ld(&(bar)[XB_TMO])) break; if (_sp > XB_SPIN_CAP) { atomicAdd(&(bar)[XB_TMO], 1u); break; } } } } while (0)

struct XcdBarrier {
    unsigned* bar; unsigned x;
    volatile LAS unsigned* st;
};

__device__ __forceinline__ XcdBarrier xcd_barrier_post(unsigned* bar, volatile LAS unsigned* st) {
    XcdBarrier b; b.bar = bar; b.x = xb_xcc_id(); b.st = st;
    if (threadIdx.x == 0) (void)xb_add(&bar[XB_XCNT(b.x)], 1u);
    return b;
}
__device__ __forceinline__ void xcd_barrier_complete(unsigned* bar, unsigned x, unsigned& nloc, unsigned& nx) {
    const unsigned G = gridDim.x * gridDim.y * gridDim.z;
    unsigned sum, cnt, mine, sp = 0u;
    for (;;) {
        sum = 0u; cnt = 0u; mine = 0u;
#pragma unroll
        for (unsigned j = 0; j < 16; ++j) { const unsigned c = xb_ld(&bar[XB_XCNT(j)]); sum += c; cnt += (c > 0u) ? 1u : 0u; mine = (j == x) ? c : mine; }
        if (sum == G) break;
        __builtin_amdgcn_s_sleep(1);
        if ((++sp & 255u) == 0u) { if (xb_ld(&bar[XB_TMO])) break; if (sp > XB_SPIN_CAP) { atomicAdd(&bar[XB_TMO], 1u); break; } }
    }
    nloc = mine > 0u ? mine : 1u; nx = cnt > 0u ? cnt : 1u;
}

__device__ __forceinline__ void xcd_barrier(const XcdBarrier& b) {
    asm volatile("s_waitcnt vmcnt(0)" ::: "memory");
    __syncthreads();
    if (threadIdx.x == 0) {
        unsigned* bar = b.bar;
        __builtin_amdgcn_s_waitcnt(0);
        unsigned nloc = b.st[0], nx = b.st[1];
        if (nloc == 0u) { xcd_barrier_complete(bar, b.x, nloc, nx); b.st[0] = nloc; b.st[1] = nx; }
        const unsigned old = xb_add(&bar[XB_XSUB(b.x)], 1u);
        const unsigned gen = old / nloc;
        if (old + 1u == (gen + 1u) * nloc) {
            __builtin_amdgcn_fence(__ATOMIC_RELEASE, "agent");
            asm volatile("s_waitcnt vmcnt(0)" ::: "memory");
            const unsigned og = xb_add(&bar[XB_TOP], 1u);
            const unsigned tg = og / nx;
            if (og + 1u == (tg + 1u) * nx) xb_add(&bar[XB_TOPGEN], 1u);
            else XB_SPIN(xb_ld(&bar[XB_TOPGEN]) == tg, bar);
            __builtin_amdgcn_fence(__ATOMIC_ACQUIRE, "agent");
            xb_add(&bar[XB_XGEN(b.x)], 1u);
            asm volatile("s_waitcnt vmcnt(0)" ::: "memory");
        } else {
            XB_SPIN(xb_ld(&bar[XB_XGEN(b.x)]) == gen, bar);
            __builtin_amdgcn_fence(__ATOMIC_ACQUIRE, "agent");
            asm volatile("s_waitcnt vmcnt(0)" ::: "memory");
        }
    }
    __syncthreads();
}
struct Frame {
    LAS unsigned char* lds;
    volatile LAS unsigned* MISC;
    gu32* ctl;
    int vcu, G;
};

#define LTID() const int tid_ = hw_tid(F.lds), lane_ = tid_ & 63, wave_ = __builtin_amdgcn_readfirstlane(tid_ >> 6); (void)lane_; (void)wave_
template <int MODE>
__device__ __forceinline__ int p0_dest_row(int n0) { return (MODE == 1) ? ((n0 < 1024) ? (256 * (n0 >> 7) + (n0 & 127)) : (256 * ((n0 - 1024) >> 7) + 128 + ((n0 - 1024) & 127))) : n0; }
template <int MODE>
__device__ __forceinline__ void p0_family(Frame& F, const float* W, bf16* WT, int nmat, int K, int N, int wg_rank = -1, int wg_count = 0) { LTID();
    LAS float* scr = (LAS float*)(F.lds + wave_ * 16384);
    const int gw = (wg_rank < 0 ? F.vcu : wg_rank) * NWAVES + wave_, NGW = (wg_rank < 0 ? F.G : wg_count) * NWAVES, lane = lane_;
    const int nblk = N / 32, ipm = (K / 64) * nblk, total = nmat * ipm;
    f32x4 cur[8], nxt[8], nx2[8], nx3[8];
#define P0_LOAD(dst, it_) do { const int mat_ = (it_) / ipm, r_ = (it_) - mat_ * ipm, kb_ = r_ / nblk, nb_ = r_ - kb_ * nblk; \
        const float* src_ = W + (size_t)mat_ * K * N + (size_t)(64 * kb_ + (lane >> 3)) * N + 32 * nb_ + 4 * (lane & 7); \
        _Pragma("unroll") for (int i = 0; i < 8; ++i) dst[i] = __builtin_nontemporal_load((const GAS f32x4*)(src_ + (size_t)(8 * i) * N)); } while (0)
    int it = gw;
    if (it < total) P0_LOAD(cur, it);
    if (it + NGW < total) P0_LOAD(nxt, it + NGW);
    if (it + 2 * NGW < total) P0_LOAD(nx2, it + 2 * NGW);
    for (; it < total; it += NGW) {
        const int itn = it + 3 * NGW;
        if (itn < total) P0_LOAD(nx3, itn);
        const int mat = it / ipm, r = it - mat * ipm, kb = r / nblk, nb = r - kb * nblk, k0 = 64 * kb, r0 = p0_dest_row<MODE>(32 * nb);
#pragma unroll
        for (int i = 0; i < 8; ++i) { LAS float* sw = scr + (8 * i + (lane >> 3)) * 33 + 4 * (lane & 7); sw[0] = cur[i].x; sw[1] = cur[i].y; sw[2] = cur[i].z; sw[3] = cur[i].w; }
        LDS_WAIT(); asm volatile("" ::: "memory");
        const int c = lane & 7; bf16* wt = WT + (size_t)mat * K * N;
#pragma unroll
        for (int j = 0; j < 4; ++j) { const int n = (lane >> 3) + 8 * j; const LAS float* sp = scr + (8 * c) * 33 + n;
            v4u o; o.x = pk2(sp[0 * 33], sp[1 * 33]); o.y = pk2(sp[2 * 33], sp[3 * 33]); o.z = pk2(sp[4 * 33], sp[5 * 33]); o.w = pk2(sp[6 * 33], sp[7 * 33]);
            __builtin_nontemporal_store(o, (GAS v4u*)(wt + (size_t)(r0 + n) * K + k0 + 8 * c)); }
        LDS_WAIT(); asm volatile("" ::: "memory");
#pragma unroll
        for (int i = 0; i < 8; ++i) { cur[i] = nxt[i]; nxt[i] = nx2[i]; nx2[i] = nx3[i]; }
    }
#undef P0_LOAD
}
__device__ __forceinline__ void p0_x_to_bf16(Frame& F, const float* x, bf16* XB) { LTID();
    const int gw = F.vcu * NWAVES + wave_, NGW = F.G * NWAVES;
    for (int m = gw; m < T; m += NGW) {
        const GAS f32x4* xr = (const GAS f32x4*)(x + (size_t)m * D) + lane_; GAS v2u* o = (GAS v2u*)(XB + (size_t)m * D) + lane_;
#pragma unroll
        for (int j = 0; j < 4; ++j) { const f32x4 v = __builtin_nontemporal_load(xr + 64 * j); v2u w; w.x = pk2(v.x, v.y); w.y = pk2(v.z, v.w); o[64 * j] = w; } }
}

__device__ __forceinline__ void ln_apply(f32x4 (&v)[4], const float* g, const float* b, int lane) {
    float s = 0.f;
#pragma unroll
    for (int j = 0; j < 4; ++j) s += (v[j].x + v[j].y) + (v[j].z + v[j].w);
    const float mean = wave_sum(s) * (1.f / D); float s2 = 0.f;
#pragma unroll
    for (int j = 0; j < 4; ++j) { v[j] = v[j] - mean; s2 += (v[j].x * v[j].x + v[j].y * v[j].y) + (v[j].z * v[j].z + v[j].w * v[j].w); }
    const float rstd = 1.f / sqrtf(wave_sum(s2) * (1.f / D) + LN_EPS);
#pragma unroll
    for (int j = 0; j < 4; ++j) { const f32x4 gg = *((const GAS f32x4*)g + lane + 64 * j), bb = *((const GAS f32x4*)b + lane + 64 * j); v[j] = v[j] * rstd * gg + bb; }
}
__device__ __forceinline__ void store_x(const f32x4 (&v)[4], float* X, bf16* XB, size_t row, int lane) {
    GAS v2u* bo = (GAS v2u*)(XB + row * D) + lane;
#pragma unroll
    for (int j = 0; j < 4; ++j) { v2u w; w.x = pk2(v[j].x, v[j].y); w.y = pk2(v[j].z, v[j].w); bo[64 * j] = w; }
    if (X) { GAS f32x4* xo = (GAS f32x4*)(X + row * D) + lane;
#pragma unroll
        for (int j = 0; j < 4; ++j) __builtin_nontemporal_store(v[j], xo + 64 * j); }
}
__device__ __forceinline__ void p0_router_image(Frame& F, const float* Wr_all, unsigned char* IMG) { LTID();
    const int gt = (F.vcu * NWAVES + wave_) * 64 + lane_;
    if (gt < DEPTH * NEXP * 128) { const int L = gt >> 12, e = (gt >> 7) & 31, c = gt & 127; const float* w = Wr_all + (size_t)L * D * NEXP + (size_t)(8 * c) * NEXP + e;
        float x[8]; v4u hi, lo;
#pragma unroll
        for (int j = 0; j < 8; ++j) x[j] = w[j * NEXP];
#pragma unroll
        for (int j = 0; j < 4; ++j) { hi[j] = pk2(x[2 * j], x[2 * j + 1]); lo[j] = pk2(x[2 * j] - bflo(hi[j]), x[2 * j + 1] - bfhi(hi[j])); }
        unsigned char* dst = IMG + (size_t)L * 131072 + e * 2048 + ((c ^ (e & 15)) * 16);
        *(GAS v4u*)dst = hi; *(GAS v4u*)(dst + 65536) = lo; }
}
__device__ __forceinline__ void ln_router_phase(Frame& F, const bf16* Y, const float* STATS, const float* g, const float* b, const unsigned char* WIMG, const float* br, bf16* XB, int2* SLOT, gu32* cnt) { LTID();
    LAS unsigned char* lds = F.lds;
#pragma unroll 4
    for (int i = 0; i < 16; ++i) { const int idx = tid_ + 512 * i; *(LAS v4u*)(lds + idx * 16) = *(const GAS v4u*)(WIMG + idx * 16); }
    LAS int* lcnt = (LAS int*)(lds + TBL_OFF + 4096);
    typedef int v4i_t __attribute__((ext_vector_type(4)));
    LAS v4i_t* rec = (LAS v4i_t*)(lds + TBL_OFF + 4096 + 256);
    for (int rt = F.vcu; rt < T / 128; rt += F.G) {
        if (tid_ < 32) lcnt[tid_] = 0;
        LDS_WAIT(); __syncthreads();
        int tid = tid_; asm volatile("" : "+v"(tid));
        const int lane = tid & 63, wid = __builtin_amdgcn_readfirstlane(tid >> 6), r = lane & 15, kg = lane >> 4;
        const size_t row = (size_t)rt * 128 + wid * 16 + r;
        const bf16* yr = Y + row * D + kg * 8;
        float s1, s2;
        { const GAS f32x4* sp = (const GAS f32x4*)(STATS + (row * 16 + kg * 4) * 2); const f32x4 a = sp[0], c = sp[1]; s1 = (a.x + a.z) + (c.x + c.z); s2 = (a.y + a.w) + (c.y + c.w); }
        { float t0; float o0 = swap16_other(s1, t0); s1 = t0 + o0; o0 = swap32_other(s1, t0); s1 = t0 + o0; o0 = swap16_other(s2, t0); s2 = t0 + o0; o0 = swap32_other(s2, t0); s2 = t0 + o0; }
        const float mean = s1 * (1.f / D), rstd = 1.f / sqrtf(__builtin_fmaxf(s2 * (1.f / D) - mean * mean, 0.f) + LN_EPS);
        pg8::f32x4 c0 = (pg8::f32x4){0.f, 0.f, 0.f, 0.f}, c1 = c0;
        bf16* xbr = XB + row * D + kg * 8;
        LAS const unsigned char* wb = lds + r * 2048;
        v4u ywn[4];
#pragma unroll
        for (int t = 0; t < 4; ++t) ywn[t] = __builtin_nontemporal_load((const GAS v4u*)(yr + 32 * t));
#pragma unroll
        for (int q = 0; q < 8; ++q) {
            f32x4 ga[4], gb[4], ba[4], bb[4]; v4u ywc[4];
#pragma unroll
            for (int t = 0; t < 4; ++t) { const int s = 4 * q + t; ga[t] = *(const GAS f32x4*)(g + 32 * s + kg * 8); gb[t] = *(const GAS f32x4*)(g + 32 * s + kg * 8 + 4); ba[t] = *(const GAS f32x4*)(b + 32 * s + kg * 8); bb[t] = *(const GAS f32x4*)(b + 32 * s + kg * 8 + 4); ywc[t] = ywn[t]; }
            if (q < 7) {
#pragma unroll
                for (int t = 0; t < 4; ++t) ywn[t] = __builtin_nontemporal_load((const GAS v4u*)(yr + 32 * (4 * q + 4 + t))); }
            __builtin_amdgcn_sched_barrier(0);
#pragma unroll
            for (int t = 0; t < 4; ++t) { const int s = 4 * q + t; const v4u yw = ywc[t];
            const f32x4 ya = (f32x4){bflo(yw[0]), bfhi(yw[0]), bflo(yw[1]), bfhi(yw[1])}, yb = (f32x4){bflo(yw[2]), bfhi(yw[2]), bflo(yw[3]), bfhi(yw[3])};
            const f32x4 xa = (ya - mean) * rstd * ga[t] + ba[t], xb = (yb - mean) * rstd * gb[t] + bb[t];
            v4u hi, lo; hi[0] = pk2(xa.x, xa.y); hi[1] = pk2(xa.z, xa.w); hi[2] = pk2(xb.x, xb.y); hi[3] = pk2(xb.z, xb.w);
            lo[0] = pk2(xa.x - bflo(hi[0]), xa.y - bfhi(hi[0])); lo[1] = pk2(xa.z - bflo(hi[1]), xa.w - bfhi(hi[1])); lo[2] = pk2(xb.x - bflo(hi[2]), xb.y - bfhi(hi[2])); lo[3] = pk2(xb.z - bflo(hi[3]), xb.w - bfhi(hi[3]));
            *(GAS v4u*)(xbr + 32 * s) = hi;
            const int co = ((4 * s + kg) ^ r) * 16;
            const bf16x8 bh0 = *(const LAS bf16x8*)(wb + co), bh1 = *(const LAS bf16x8*)(wb + 32768 + co), bl0 = *(const LAS bf16x8*)(wb + 65536 + co), bl1 = *(const LAS bf16x8*)(wb + 98304 + co);
            const bf16x8 ah = __builtin_bit_cast(bf16x8, hi), al = __builtin_bit_cast(bf16x8, lo);
            c0 = __builtin_amdgcn_mfma_f32_16x16x32_bf16(ah, bh0, c0, 0, 0, 0); c1 = __builtin_amdgcn_mfma_f32_16x16x32_bf16(ah, bh1, c1, 0, 0, 0);
            c0 = __builtin_amdgcn_mfma_f32_16x16x32_bf16(al, bh0, c0, 0, 0, 0); c1 = __builtin_amdgcn_mfma_f32_16x16x32_bf16(al, bh1, c1, 0, 0, 0);
            c0 = __builtin_amdgcn_mfma_f32_16x16x32_bf16(ah, bl0, c0, 0, 0, 0); c1 = __builtin_amdgcn_mfma_f32_16x16x32_bf16(ah, bl1, c1, 0, 0, 0); }
            __builtin_amdgcn_sched_barrier(0);
        }
        const float bi0 = br[r], bi1 = br[16 + r];
#pragma unroll
        for (int rr = 0; rr < 4; ++rr) {
            float v0 = c0[rr] + bi0, v1 = c1[rr] + bi1; int ei[4]; float ev[4];
#pragma unroll
            for (int k = 0; k < 4; ++k) { const float m = row_max16(__builtin_fmaxf(v0, v1));
                const unsigned long long m0 = __ballot(v0 == m), m1 = __ballot(v1 == m);
                const unsigned q0b = (unsigned)(m0 >> (16 * kg)) & 0xffffu, q1b = (unsigned)(m1 >> (16 * kg)) & 0xffffu;
                const int idx = q0b ? (__ffs((int)q0b) - 1) : (16 + __ffs((int)q1b) - 1);
                ev[k] = m; ei[k] = idx;
                if (idx < 16) { if (r == idx) v0 = -INFINITY; } else { if (r == idx - 16) v1 = -INFINITY; } }
            const float p1 = __expf(ev[1] - ev[0]), p2 = __expf(ev[2] - ev[0]), p3 = __expf(ev[3] - ev[0]); const float inv = 1.f / (((1.f + p1) + p2) + p3);
            if (r < 4) { const int me = r == 0 ? ei[0] : r == 1 ? ei[1] : r == 2 ? ei[2] : ei[3]; const float mw = (r == 0 ? 1.f : r == 1 ? p1 : r == 2 ? p2 : p3) * inv;
                const int lr = __hip_atomic_fetch_add(lcnt + me, 1, __ATOMIC_RELAXED, __HIP_MEMORY_SCOPE_WORKGROUP);
                rec[(wid * 16 + 4 * kg + rr) * 4 + r] = (v4i_t){me, lr, __float_as_int(mw), 0}; }
        }
        LDS_WAIT(); __syncthreads();
        if (tid < NEXP) { const int c = lcnt[tid]; lcnt[32 + tid] = c ? (int)__hip_atomic_fetch_add(cnt + tid * 64, (unsigned)c, RLX_AGENT) : 0; }
        LDS_WAIT(); __syncthreads();
        { const v4i_t rc = rec[tid]; typedef int v2i_t __attribute__((ext_vector_type(2)));
          *(GAS v2i_t*)(SLOT + (size_t)rc.x * pg8::GCAP_SLOTS + (lcnt[32 + rc.x] + rc.y)) = (v2i_t){(rt * 128 + (tid >> 2)) * 4 + (tid & 3), rc.z}; }
        LDS_WAIT(); __syncthreads();
    }
}
__device__ __forceinline__ void build_tables(Frame& F, gu32* cnt) { LTID();
    LAS int* tb = (LAS int*)(F.lds + TBL_OFF);
    __syncthreads();
    if (tid_ < NEXP) tb[40 + tid_] = (int)__hip_atomic_load(cnt + tid_ * 64, RLX_AGENT);
    LDS_WAIT(); __syncthreads();
    if (tid_ == 0) { int acc = 0; for (int e = 0; e < NEXP; ++e) { tb[e] = acc; acc += (tb[40 + e] + 255) >> 8; } tb[NEXP] = acc; }
    LDS_WAIT(); __syncthreads();
    for (int pm = tid_; pm < MT_MAX; pm += 512) { int e = 0;
#pragma unroll
        for (int j = 1; j < NEXP; ++j) e += (tb[j] <= pm) ? 1 : 0;
        tb[128 + pm] = e; }
    LDS_WAIT(); __syncthreads();
}
__device__ __forceinline__ void gather_phase(Frame& F, const bf16* XB, const int4* ROUTE, bf16* XS, int2* SLOT) { LTID();
    const LAS int* tb = (const LAS int*)(F.lds + TBL_OFF);
    const int gw = F.vcu * NWAVES + wave_, NGW = F.G * NWAVES, lane = lane_;
    for (int t = gw; t < T; t += NGW) {
        const int4 r = ROUTE[(size_t)t * 4 + (lane & 3)];
        const GAS v4u* src = (const GAS v4u*)(XB + (size_t)t * D); const v4u a = src[lane], c = src[64 + lane];
#pragma unroll
        for (int k = 0; k < 4; ++k) { const int e = __shfl(r.x, k), rk = __shfl(r.y, k), wb = __shfl(r.z, k); const int dest = 256 * tb[e] + rk;
            GAS v4u* dst = (GAS v4u*)(XS + (size_t)dest * D); dst[lane] = a; dst[64 + lane] = c;
            if (lane == 0) SLOT[dest] = make_int2(t * 4 + k, wb); }
    }
}
__device__ __forceinline__ void combine_ln_phase(Frame& F, const bf16* YE, const float* g, const float* b, float* X, bf16* XB) { LTID();
    const int gw = F.vcu * NWAVES + wave_, NGW = F.G * NWAVES, lane = lane_;
    v2u xw[4], yw[4][4];
#define CL_LOAD(r_) do { _Pragma("unroll") for (int j = 0; j < 4; ++j) xw[j] = *((const GAS v2u*)(XB + (size_t)(r_) * D) + lane + 64 * j); \
        _Pragma("unroll") for (int k = 0; k < 4; ++k) { const GAS v2u* yr = (const GAS v2u*)(YE + ((size_t)(r_) * 4 + k) * D) + lane; _Pragma("unroll") for (int j = 0; j < 4; ++j) yw[k][j] = __builtin_nontemporal_load(yr + 64 * j); } } while (0)
    if (gw < T) CL_LOAD(gw);
    for (int row = gw; row < T; row += NGW) {
        f32x4 v[4];
#pragma unroll
        for (int j = 0; j < 4; ++j) { const v2u w = xw[j]; v[j] = (f32x4){bflo(w.x), bfhi(w.x), bflo(w.y), bfhi(w.y)} * DN_ALPHA; }
#pragma unroll
        for (int k = 0; k < 4; ++k) {
#pragma unroll
            for (int j = 0; j < 4; ++j) { const v2u w = yw[k][j]; v[j].x += bflo(w.x); v[j].y += bfhi(w.x); v[j].z += bflo(w.y); v[j].w += bfhi(w.y); } }
        if (row + NGW < T) CL_LOAD(row + NGW);
        __builtin_amdgcn_sched_barrier(0);
        ln_apply(v, g, b, lane);
        store_x(v, X, XB, (size_t)row, lane);
    }
#undef CL_LOAD
}

struct GroupedOrder {
    const LAS int* tb; int NT, GM, G, bx;
    __device__ __forceinline__ bool next(int i, pg8::Unit& u) const {
        const int MT = tb[NEXP]; int pm, pn;
        if (G == 256) { const int x = bx & 7, j = bx >> 3, s = i * 8 + x; pm = s * GM + j / NT; pn = j % NT; }
        else { const int L = i * G + bx; pm = L / NT; pn = L % NT; }
        if (pm >= MT) return false;
        const int e = tb[128 + pm];
        int rows = tb[40 + e] - 256 * (pm - tb[e]); rows = rows > 256 ? 256 : rows;
        u.pm = __builtin_amdgcn_readfirstlane(pm); u.pn = __builtin_amdgcn_readfirstlane(pn); u.pb = __builtin_amdgcn_readfirstlane(e * NT + pn); u.aux = __builtin_amdgcn_readfirstlane(e); u.rows = __builtin_amdgcn_readfirstlane(rows); u.lt = __builtin_amdgcn_readfirstlane(pm - tb[e]);
        return true;
    }
    __device__ __forceinline__ void a_ready(const pg8::Unit&) const {}
    __device__ __forceinline__ void done(const pg8::Unit&) const {}
};

__device__ __forceinline__ void glds16(const void* gsrc, unsigned lds_dst) { unsigned keep;
    asm volatile("s_mov_b32 %0, m0\n\ts_mov_b32 m0, %2\n\ts_nop 0\n\tglobal_load_lds_dwordx4 %1, off\n\ts_mov_b32 m0, %0" : "=&s"(keep) : "v"(gsrc), "s"(lds_dst) : "memory"); }
struct ConvJob { const float* wgu; bf16* wgu_t; const float* wdn; bf16* wdn_t; int nmat; int every; };
__device__ __forceinline__ void da_attn_phase(Frame& F, const bf16* QKV, bf16* AO, float lam, float one_m_li, const float* subg, const unsigned* kmax, gu32* qctr, const ConvJob& cj) { LTID();
    LAS unsigned char* lds = F.lds;
    if (cj.nmat > 0 && (F.vcu % cj.every) == 0) {
        p0_family<1>(F, cj.wgu, cj.wgu_t, cj.nmat, D, 2 * FF, F.vcu / cj.every, (F.G + cj.every - 1) / cj.every);
        p0_family<0>(F, cj.wdn, cj.wdn_t, cj.nmat, FF, D, F.vcu / cj.every, (F.G + cj.every - 1) / cj.every);
        LDS_WAIT(); __syncthreads();
    }
    LAS volatile int* qslot = (LAS volatile int*)(lds + TBL_OFF + 3072);
    LAS float* wred = (LAS float*)(lds + TBL_OFF + 3136);
    if (tid_ == 0) *qslot = (int)__hip_atomic_fetch_add(qctr, 1u, RLX_AGENT);
    LDS_WAIT(); __syncthreads();
    int U = __builtin_amdgcn_readfirstlane(*qslot);
    __syncthreads();
    while (U < 2048) {
        int tid = tid_; asm volatile("" : "+v"(tid));
        const int lane = tid & 63, r32 = lane & 31, hh = lane >> 5, wid = __builtin_amdgcn_readfirstlane(tid >> 6), mp = wid & 1, rg = wid >> 1;
        LAS float* wsf = (LAS float*)(lds + 98304 + wid * 256);
        const int voff = (4 * hh + ((lane & 15) >> 2)) * 64 + ((lane >> 4) & 1) * 32 + (lane & 3) * 8;
        unsigned nxtU = 0u; if (tid == 0) nxtU = __hip_atomic_fetch_add(qctr, 1u, RLX_AGENT);
        const int h = 7 - (U >> 8), qb = 63 - ((U & 255) >> 2), b = U & 3;
        const int q0 = qb * 128, NT = 2 * qb + 2;
        const float sl2 = __builtin_amdgcn_exp2f(-(float)(h + 1)) * LOG2E;
        const size_t rowbase = (size_t)b * SEQ;
        const unsigned* kmp = kmax + ((b * 16 + h * 2 + mp) * 2);
        const float km2 = __builtin_bit_cast(float, __hip_atomic_load(kmp, RLX_AGENT)) + __builtin_bit_cast(float, __hip_atomic_load(kmp + 1, RLX_AGENT));
        bf16x8 qr[4];
        { const bf16* qp = QKV + (rowbase + q0 + rg * 32 + r32) * 3072 + h * 128 + mp * 64 + hh * 8;
#pragma unroll
          for (int d0 = 0; d0 < 4; ++d0) qr[d0] = *(const GAS bf16x8*)(qp + d0 * 16); }
        int t_min = 0; float qkw = 0.f;
        { float qs = 0.f;
#pragma unroll
          for (int d0 = 0; d0 < 4; ++d0)
#pragma unroll
              for (int j = 0; j < 8; ++j) { const float qv = bf2f((unsigned short)qr[d0][j]); qs += qv * qv; }
          qs = xor32_sum(qs); qs = half_max32(qs);
          const float bw = 2.0f * sqrtf(qs * km2) * 1.02f;
          qkw = 0.5f * bw;
          if (lane == 0) wred[wid] = bw;
          LDS_WAIT(); __syncthreads();
          float bm = wred[0];
#pragma unroll
          for (int w8 = 1; w8 < 8; ++w8) bm = __builtin_fmaxf(bm, wred[w8]);
          const float Wk = (bm + 38.0f) / sl2, xx = ((float)q0 - Wk - 63.0f) * (1.0f / 64.0f);
          t_min = (xx > 0.f) ? (int)ceilf(xx) : 0; t_min = __builtin_amdgcn_readfirstlane(t_min); }
        int NIT = NT - t_min;
        const bf16* kg0 = QKV + (rowbase + lane) * 3072 + 1024 + h * 128 + wid * 8;
        const bf16* vg0 = QKV + (rowbase + 16 * (wid & 3) + (lane >> 2)) * 3072 + 2048 + h * 128 + (wid >> 2) * 32 + (lane & 3) * 8;
        const unsigned ldsb = (unsigned)(uintptr_t)lds, kd0 = ldsb + wid * 1024, vd0 = ldsb + 49152 + (wid >> 2) * 4096 + (wid & 3) * 1024;
#define DMA_K(it_, ks) do { const size_t to_ = (size_t)(NT - 1 - (it_)) * 64 * 3072; const unsigned sb_ = (unsigned)(ks) * 16384u; \
        glds16(kg0 + to_, (unsigned)__builtin_amdgcn_readfirstlane(kd0 + sb_)); glds16(kg0 + to_ + 64, (unsigned)__builtin_amdgcn_readfirstlane(kd0 + sb_ + 8192)); } while (0)
#define DMA_V(it_, vs) do { const size_t to_ = (size_t)(NT - 1 - (it_)) * 64 * 3072; const unsigned sb_ = (unsigned)(vs) * 16384u; \
        glds16(vg0 + to_, (unsigned)__builtin_amdgcn_readfirstlane(vd0 + sb_)); glds16(vg0 + to_ + 64, (unsigned)__builtin_amdgcn_readfirstlane(vd0 + sb_ + 8192)); } while (0)
#define DA_QK(P0, P1, it_, ks) do { const int t_ = NT - 1 - (it_), krel0_ = 64 * t_ - q0; const float cb0_ = sl2 * (float)krel0_ + hb - m_ref; LAS const unsigned char* Kb_ = lds + (ks) * 16384; \
        _Pragma("unroll") for (int i = 0; i < 16; ++i) { P0[i] = cb0_ + sl2 * (float)((i & 3) + 8 * (i >> 2)); P1[i] = cb0_ + sl2 * (float)(32 + (i & 3) + 8 * (i >> 2)); } \
        _Pragma("unroll") for (int d0 = 0; d0 < 4; ++d0) { \
            const bf16x8 a0 = *(const LAS bf16x8*)(Kb_ + (mp * 8 + 2 * d0 + hh) * 1024 + r32 * 16), a1 = *(const LAS bf16x8*)(Kb_ + (mp * 8 + 2 * d0 + hh) * 1024 + 512 + r32 * 16); \
            P0 = __builtin_amdgcn_mfma_f32_32x32x16_bf16(a0, qr[d0], P0, 0, 0, 0); P1 = __builtin_amdgcn_mfma_f32_32x32x16_bf16(a1, qr[d0], P1, 0, 0, 0); } \
        if ((it_) < 2) { const int qrel = rg * 32 + r32; \
            _Pragma("unroll") for (int i = 0; i < 16; ++i) { const int kr = krel0_ + crow(i, hh); if (kr > qrel) P0[i] = -INFINITY; if (kr + 32 > qrel) P1[i] = -INFINITY; } } } while (0)
        float tmax = -INFINITY;
        float m_ref = -qkw, l_run = 0.f; f32x16 o[4];
#pragma unroll
        for (int eb = 0; eb < 4; ++eb) o[eb] = (f32x16){0.f, 0.f, 0.f, 0.f, 0.f, 0.f, 0.f, 0.f, 0.f, 0.f, 0.f, 0.f, 0.f, 0.f, 0.f, 0.f};
        const float hb = sl2 * (float)(4 * hh);
        DMA_K(0, 0); DMA_K(1, 1); DMA_V(0, 0);
        if (NIT > 2) { DMA_K(2, 2); DMA_V(1, 1); asm volatile("s_waitcnt vmcnt(8)\n\ts_barrier" ::: "memory"); }
        else { DMA_V(1, 1); asm volatile("s_waitcnt vmcnt(6)\n\ts_barrier" ::: "memory"); }
        f32x16 p0, p1, n0, n1;
        DA_QK(p0, p1, 0, 0);
        n0 = p0; n1 = p1;
        int s3 = 0;
#define DA_MAX3(a, b, c) ({ float r_; asm("v_max3_f32 %0, %1, %2, %3" : "=v"(r_) : "v"(a), "v"(b), "v"(c)); r_; })
#define DA_ITER(P0, P1, N0, N1, it_) do { \
              \
            if ((it_) + 2 < NIT) asm volatile("s_waitcnt vmcnt(4) lgkmcnt(0)\n\ts_barrier" ::: "memory"); \
            else if ((it_) + 1 < NIT) asm volatile("s_waitcnt vmcnt(2) lgkmcnt(0)\n\ts_barrier" ::: "memory"); \
            else asm volatile("s_waitcnt vmcnt(0) lgkmcnt(0)\n\ts_barrier" ::: "memory"); \
            if ((it_) == 2 && NIT > 3) {                           \
                float xm = wred[8]; _Pragma("unroll") for (int w8 = 1; w8 < 8; ++w8) xm = __builtin_fminf(xm, wred[8 + w8]); \
                const int tdrop = (int)floorf(xm * (1.0f / 64.0f)); int nit2 = NT - (tdrop + 1); nit2 = nit2 < 4 ? 4 : nit2; nit2 = __builtin_amdgcn_readfirstlane(nit2); \
                if (nit2 < NIT) NIT = nit2; } \
            const int s3n = (s3 == 2) ? 0 : s3 + 1, s3p = (s3 == 0) ? 2 : s3 - 1; \
            if ((it_) + 3 < NIT) DMA_K((it_) + 3, s3); \
            if ((it_) + 2 < NIT) DMA_V((it_) + 2, s3p); \
            if ((it_) + 1 < NIT) DA_QK(N0, N1, (it_) + 1, s3n); \
            __builtin_amdgcn_sched_barrier(0); \
            float mx = DA_MAX3(P0[0], P1[0], P0[1]); mx = DA_MAX3(mx, P1[1], P0[2]); mx = DA_MAX3(mx, P1[2], P0[3]); mx = DA_MAX3(mx, P1[3], P0[4]); \
            float my = DA_MAX3(P1[4], P0[5], P1[5]); my = DA_MAX3(my, P0[6], P1[6]); my = DA_MAX3(my, P0[7], P1[7]); my = DA_MAX3(my, P0[8], P1[8]); \
            mx = DA_MAX3(mx, P0[9], P1[9]); mx = DA_MAX3(mx, P0[10], P1[10]); mx = DA_MAX3(mx, P0[11], P1[11]); mx = DA_MAX3(mx, P0[12], P1[12]); \
            my = DA_MAX3(my, P0[13], P1[13]); my = DA_MAX3(my, P0[14], P1[14]); my = DA_MAX3(my, P0[15], P1[15]); mx = DA_MAX3(mx, my, my); \
            { float sf_; const float ot_ = swap32_other(mx, sf_); mx = DA_MAX3(sf_, ot_, ot_); } \
            tmax = __builtin_fmaxf(tmax, mx + m_ref);              \
            if (__any(mx > 8.0f)) {                                \
                const float dlt = (mx > 0.f) ? mx : 0.f; m_ref += dlt; \
                _Pragma("unroll") for (int i = 0; i < 16; ++i) { P0[i] -= dlt; P1[i] -= dlt; N0[i] -= dlt; N1[i] -= dlt; } \
                const float f = __builtin_amdgcn_exp2f(-dlt); l_run *= f; \
                if (hh == 0) wsf[r32] = f; \
                LDS_WAIT(); \
                _Pragma("unroll") for (int i = 0; i < 16; ++i) { const float af = wsf[crow(i, hh)]; \
                    _Pragma("unroll") for (int eb = 0; eb < 4; ++eb) o[eb][i] *= af; } \
            } \
            float rs0 = 0.f, rs1 = 0.f; \
            _Pragma("unroll") for (int i = 0; i < 16; ++i) { P0[i] = __builtin_amdgcn_exp2f(P0[i]); P1[i] = __builtin_amdgcn_exp2f(P1[i]); rs0 += P0[i]; rs1 += P1[i]; } \
            l_run += rs0 + rs1; \
            bf16x8 pa[4]; \
            pa[0] = pack8f(P0[0], P0[1], P0[2], P0[3], P0[4], P0[5], P0[6], P0[7]); pa[1] = pack8f(P0[8], P0[9], P0[10], P0[11], P0[12], P0[13], P0[14], P0[15]); \
            pa[2] = pack8f(P1[0], P1[1], P1[2], P1[3], P1[4], P1[5], P1[6], P1[7]); pa[3] = pack8f(P1[8], P1[9], P1[10], P1[11], P1[12], P1[13], P1[14], P1[15]); \
            LAS const unsigned char* Vb = lds + 49152 + s3 * 16384; \
              \
            _Pragma("unroll") for (int ks = 0; ks < 4; ++ks) { bf16x8 vf[4]; \
                _Pragma("unroll") for (int eb = 0; eb < 4; ++eb) vf[eb] = cat8(vtr(Vb + eb * 4096 + ks * 1024 + voff), vtr(Vb + eb * 4096 + ks * 1024 + 512 + voff)); \
                __builtin_amdgcn_sched_barrier(0); \
                _Pragma("unroll") for (int eb = 0; eb < 4; ++eb) o[eb] = __builtin_amdgcn_mfma_f32_32x32x16_bf16(pa[ks], vf[eb], o[eb], 0, 0, 0); \
                __builtin_amdgcn_sched_barrier(0); } \
            if ((it_) == 1) { float tm = tmax; tm = -half_max32(-tm); tm = -xor32_max(-tm);                   \
                if (lane == 0) wred[8 + wid] = (tm - qkw - 38.0f) / sl2 + (float)q0 - 63.0f; }                  \
            s3 = s3n; } while (0)
        int it = 0;
        for (; it + 1 < NIT; it += 2) { DA_ITER(p0, p1, n0, n1, it); DA_ITER(n0, n1, p0, p1, it + 1); }
        if (it < NIT) DA_ITER(p0, p1, n0, n1, it);
#undef DA_ITER
#undef DA_MAX3
#undef DMA_K
#undef DMA_V
#undef DA_QK
        asm volatile("s_waitcnt vmcnt(0)" ::: "memory");
        LDS_WAIT(); __syncthreads();
        const float l_tot = xor32_sum(l_run);
        if (hh == 0) wsf[r32] = 1.f / l_tot;
        LDS_WAIT();
        float rinv[16];
#pragma unroll
        for (int i = 0; i < 16; ++i) rinv[i] = wsf[crow(i, hh)];
        LAS float* comb = (LAS float*)lds + rg * 4096;
        if (mp == 1) {
#pragma unroll
            for (int eb = 0; eb < 4; ++eb)
#pragma unroll
                for (int i = 0; i < 16; ++i) comb[crow(i, hh) * 128 + eb * 32 + r32] = o[eb][i] * rinv[i];
        }
        LDS_WAIT(); __syncthreads();
        if (mp == 0) {
            float ss[16];
#pragma unroll
            for (int i = 0; i < 16; ++i) { float s = 0.f;
#pragma unroll
                for (int eb = 0; eb < 4; ++eb) { const float dlt = o[eb][i] * rinv[i] - lam * comb[crow(i, hh) * 128 + eb * 32 + r32]; o[eb][i] = dlt; s += dlt * dlt; }
                ss[i] = half_sum32(s); }
            float gsc[4];
#pragma unroll
            for (int eb = 0; eb < 4; ++eb) gsc[eb] = subg[eb * 32 + r32] * one_m_li;
#pragma unroll
            for (int i = 0; i < 16; ++i) { const float rr = 1.f / sqrtf(ss[i] * (1.f / 128.f) + LN_EPS);
                LAS bf16* tp = (LAS bf16*)(lds + 65536) + (rg * 32 + crow(i, hh)) * 128 + r32;
#pragma unroll
                for (int eb = 0; eb < 4; ++eb) tp[eb * 32] = (bf16)pk2(o[eb][i] * rr * gsc[eb], 0.f); }
        }
        if (tid == 0) *qslot = (int)nxtU;
        LDS_WAIT(); __syncthreads();
        U = __builtin_amdgcn_readfirstlane(*qslot);
#pragma unroll
        for (int k = 0; k < 4; ++k) { const int idx = tid + 512 * k, row = idx >> 4, c16 = idx & 15;
            *(GAS v4u*)(AO + (rowbase + q0 + row) * 1024 + h * 128 + c16 * 8) = *(const LAS v4u*)(lds + 65536 + idx * 16); }
        LDS_WAIT(); __syncthreads();
    }
}

__device__ __forceinline__ void ret_scan_phase(Frame& F, const bf16* PROJ, bf16* ST, const float (&lg2)[4]) { LTID();
    LAS unsigned char* lds = F.lds;
    for (int L = F.vcu; L < 256; L += F.G) {
        int tid = tid_; asm volatile("" : "+v"(tid));
        const int lane = tid & 63, r32 = lane & 31, hh = lane >> 5, wid = __builtin_amdgcn_readfirstlane(tid >> 6);
        const int voff = (4 * hh + ((lane & 15) >> 2)) * 64 + ((lane >> 4) & 1) * 32 + (lane & 3) * 8;
        const int bh = L >> 4, dkh = (L >> 3) & 1, e8 = L & 7, h = bh & 3;
        const float lgh = h == 0 ? lg2[0] : h == 1 ? lg2[1] : h == 2 ? lg2[2] : lg2[3];
        const float gC = __builtin_amdgcn_exp2f(128.f * lgh);
        const int trow = lane >> 2, chl = lane & 3;
        const bf16* ksrc0 = PROJ + (size_t)T * 1024 + ((size_t)bh * SEQ + 16 * ((2 * wid) & 3) + trow) * 256 + dkh * 128 + ((2 * wid) >> 2) * 32 + chl * 8;
        const bf16* ksrc1 = PROJ + (size_t)T * 1024 + ((size_t)bh * SEQ + 16 * ((2 * wid + 1) & 3) + trow) * 256 + dkh * 128 + ((2 * wid + 1) >> 2) * 32 + chl * 8;
        const bf16* vsrc = PROJ + (size_t)2 * T * 1024 + ((size_t)bh * SEQ + 16 * (wid & 3) + trow) * 512 + e8 * 64 + (wid >> 2) * 32 + chl * 8;
        const unsigned ldsb = (unsigned)(uintptr_t)lds;
#define RS_DMA(m, slot) do { const size_t mk_ = (size_t)(m) * 64 * 256, mv_ = (size_t)(m) * 64 * 512; const unsigned sb_ = ldsb + (unsigned)(slot) * 24576u; \
        glds16(ksrc0 + mk_, (unsigned)__builtin_amdgcn_readfirstlane(sb_ + (2 * wid) * 1024)); glds16(ksrc1 + mk_, (unsigned)__builtin_amdgcn_readfirstlane(sb_ + (2 * wid + 1) * 1024)); \
        glds16(vsrc + mv_, (unsigned)__builtin_amdgcn_readfirstlane(sb_ + 16384 + wid * 1024)); } while (0)
        f32x16 st = (f32x16){0.f, 0.f, 0.f, 0.f, 0.f, 0.f, 0.f, 0.f, 0.f, 0.f, 0.f, 0.f, 0.f, 0.f, 0.f, 0.f};
        const int el = (wid >> 2) * 32 + r32;
        bf16* stg = ST + ((size_t)bh * 64 * 512 + e8 * 64) * 256 + dkh * 128;
        RS_DMA(0, 0); RS_DMA(1, 1); RS_DMA(2, 2);
#pragma unroll 1
        for (int m = 0; m < 128; ++m) {
            const int slot = m & 3, n = m >> 1;
            if (m >= 3 && m + 2 < 128) asm volatile("s_waitcnt vmcnt(8) lgkmcnt(0)\n\ts_barrier" ::: "memory");
            else if (m + 2 < 128) asm volatile("s_waitcnt vmcnt(6) lgkmcnt(0)\n\ts_barrier" ::: "memory");
            else if (m + 1 < 128) asm volatile("s_waitcnt vmcnt(3) lgkmcnt(0)\n\ts_barrier" ::: "memory");
            else asm volatile("s_waitcnt vmcnt(0) lgkmcnt(0)\n\ts_barrier" ::: "memory");
            if (m + 3 < 128) RS_DMA(m + 3, (m + 3) & 3);
            if ((m & 1) == 0) {
                const int bf = n & 1;
                if (n > 0) {
#pragma unroll
                    for (int k2 = 0; k2 < 2; ++k2) { const int p = tid + 512 * k2, e = p >> 4, c = (p & 15) ^ (e & 15);
                        *(GAS v4u*)(stg + ((size_t)(n - 1) * 512 + e) * 256 + c * 8) = *(const LAS v4u*)(lds + 98304 + (bf ^ 1) * 16384 + p * 16); } }
#pragma unroll
                for (int g4 = 0; g4 < 4; ++g4) { v2u w; w.x = pk2(st[4 * g4], st[4 * g4 + 1]); w.y = pk2(st[4 * g4 + 2], st[4 * g4 + 3]);
                    *(LAS v2u*)(lds + 98304 + bf * 16384 + el * 256 + ((((wid & 3) * 4 + g4) ^ (el & 15)) * 16) + hh * 8) = w; }
            }
            LAS const unsigned char* kb = lds + slot * 24576 + (wid & 3) * 4096; LAS const unsigned char* vb = lds + slot * 24576 + 16384 + (wid >> 2) * 4096;
#pragma unroll
            for (int s = 0; s < 4; ++s) { const bf16x8 a = cat8(vtr(kb + s * 1024 + voff), vtr(kb + s * 1024 + 512 + voff)), bb = cat8(vtr(vb + s * 1024 + voff), vtr(vb + s * 1024 + 512 + voff));
                st = __builtin_amdgcn_mfma_f32_32x32x16_bf16(a, bb, st, 0, 0, 0); }
            if (m & 1) {
#pragma unroll
                for (int i = 0; i < 16; ++i) st[i] *= gC; }
        }
#undef RS_DMA
        asm volatile("s_waitcnt vmcnt(0) lgkmcnt(0)\n\ts_barrier" ::: "memory");
#pragma unroll
        for (int k2 = 0; k2 < 2; ++k2) { const int p = tid + 512 * k2, e = p >> 4, c = (p & 15) ^ (e & 15);
            *(GAS v4u*)(stg + ((size_t)63 * 512 + e) * 256 + c * 8) = *(const LAS v4u*)(lds + 98304 + 16384 + p * 16); }
        LDS_WAIT(); __syncthreads();
    }
}
__device__ __forceinline__ void ret_main_phase(Frame& F, const bf16* PROJ, const bf16* ST, bf16* AO) { LTID();
    LAS unsigned char* lds = F.lds;
    LAS float* part = (LAS float*)(lds + TBL_OFF + 512);
    for (int L = F.vcu * 4; L < 1024; L += F.G * 4) for (int uu = 0; uu < 4; ++uu) {
        int tid = tid_; asm volatile("" : "+v"(tid));
        const int lane = tid & 63, r32 = lane & 31, hh = lane >> 5, wid = __builtin_amdgcn_readfirstlane(tid >> 6), rg = wid & 3, e2 = wid >> 2;
        const int voff = (4 * hh + ((lane & 15) >> 2)) * 64 + ((lane >> 4) & 1) * 32 + (lane & 3) * 8;
        const int U = L + uu, bh = U >> 6, n = U & 63, b = bh >> 2, h = bh & 3;
        const size_t tokbase = (size_t)b * SEQ + (size_t)n * 128, hb0 = (size_t)bh * SEQ + (size_t)n * 128;
        const bf16* qrow = PROJ + (hb0 + rg * 32 + r32) * 256 + 8 * hh;
        const bf16* stb = ST + ((size_t)bh * 64 + n) * 512 * 256;
        const unsigned ldsb = (unsigned)(uintptr_t)lds + wid * 1024;
#define RM_WAITBAR() asm volatile("s_waitcnt vmcnt(0) lgkmcnt(0)\n\ts_barrier" ::: "memory")
#define RM_DMA_KS(buf) do { _Pragma("unroll") for (int i = 0; i < 8; ++i) { const int idx = tid + 512 * i, tok = idx >> 5, c = (idx & 31) ^ (tok & 31); \
        glds16(PROJ + (size_t)T * 1024 + (hb0 + tok) * 256 + c * 8, (unsigned)__builtin_amdgcn_readfirstlane(ldsb + (buf) * 65536 + i * 8192)); } } while (0)
#define RM_DMA_V(p, buf) do { _Pragma("unroll") for (int i = 0; i < 8; ++i) { const int idx = tid + 512 * i, tok = (idx >> 2) & 127; \
        glds16(PROJ + (size_t)2 * T * 1024 + (hb0 + tok) * 512 + (p) * 256 + (idx >> 9) * 32 + (idx & 3) * 8, (unsigned)__builtin_amdgcn_readfirstlane(ldsb + (buf) * 65536 + i * 8192)); } } while (0)
#define RM_DMA_ST(p, dkh, buf) do { _Pragma("unroll") for (int i = 0; i < 8; ++i) { const int idx = tid + 512 * i, e = idx >> 4, c = (idx & 15) ^ (e & 15); \
        glds16(stb + (size_t)((p) * 256 + e) * 256 + (dkh) * 128 + c * 8, (unsigned)__builtin_amdgcn_readfirstlane(ldsb + (buf) * 65536 + i * 8192)); } } while (0)
        RM_DMA_KS(0);
        bf16x8 pa[4][2];
        {
            bf16x8 qf[16];
#pragma unroll
            for (int s = 0; s < 16; ++s) qf[s] = *(const GAS bf16x8*)(qrow + 16 * s);
            RM_WAITBAR();
            asm volatile("" :: "v"(qf[0]), "v"(qf[1]), "v"(qf[2]), "v"(qf[3]), "v"(qf[4]), "v"(qf[5]), "v"(qf[6]), "v"(qf[7]), "v"(qf[8]), "v"(qf[9]), "v"(qf[10]), "v"(qf[11]), "v"(qf[12]), "v"(qf[13]), "v"(qf[14]), "v"(qf[15]));
            RM_DMA_V(0, 1);
#pragma unroll
            for (int jb = 0; jb < 4; ++jb) {
                f32x16 S = (f32x16){0.f, 0.f, 0.f, 0.f, 0.f, 0.f, 0.f, 0.f, 0.f, 0.f, 0.f, 0.f, 0.f, 0.f, 0.f, 0.f};
                if (jb <= rg) {
#pragma unroll
                    for (int s = 0; s < 16; ++s) { const bf16x8 a = *(const LAS bf16x8*)(lds + (32 * jb + r32) * 512 + (((2 * s + hh) ^ r32) * 16)); S = __builtin_amdgcn_mfma_f32_32x32x16_bf16(a, qf[s], S, 0, 0, 0); }
                    if (jb == rg) {
#pragma unroll
                        for (int i = 0; i < 16; ++i) if (crow(i, hh) > r32) S[i] = 0.f; }
                }
                pa[jb][0] = pack8f(S[0], S[1], S[2], S[3], S[4], S[5], S[6], S[7]); pa[jb][1] = pack8f(S[8], S[9], S[10], S[11], S[12], S[13], S[14], S[15]);
            }
        }
        f32x16 o[8];
#pragma unroll
        for (int eb = 0; eb < 8; ++eb) o[eb] = (f32x16){0.f, 0.f, 0.f, 0.f, 0.f, 0.f, 0.f, 0.f, 0.f, 0.f, 0.f, 0.f, 0.f, 0.f, 0.f, 0.f};
#define RM_PV(BUF, OB) do { _Pragma("unroll") for (int jb = 0; jb < 4; ++jb) if (jb <= rg) { _Pragma("unroll") for (int s2 = 0; s2 < 2; ++s2) { \
            _Pragma("unroll") for (int j = 0; j < 4; ++j) { LAS const unsigned char* vb = lds + (BUF) * 65536 + (e2 * 4 + j) * 8192 + (32 * jb + 16 * s2) * 64 + voff; \
                o[(OB) + j] = __builtin_amdgcn_mfma_f32_32x32x16_bf16(pa[jb][s2], cat8(vtr(vb), vtr(vb + 512)), o[(OB) + j], 0, 0, 0); } \
            __builtin_amdgcn_sched_barrier(0); } } } while (0)
#define RM_QA(DKH) do { _Pragma("unroll") for (int sl = 0; sl < 8; ++sl) qa[sl] = *(const GAS bf16x8*)(qrow + 16 * ((DKH) * 8 + sl)); } while (0)
#define RM_QA_USE() asm volatile("" :: "v"(qa[0]), "v"(qa[1]), "v"(qa[2]), "v"(qa[3]), "v"(qa[4]), "v"(qa[5]), "v"(qa[6]), "v"(qa[7]))
#define RM_CROSS(BUF, OB) do { \
            _Pragma("unroll") for (int sl = 0; sl < 8; ++sl) { \
                _Pragma("unroll") for (int j = 0; j < 4; ++j) { const bf16x8 bb = *(const LAS bf16x8*)(lds + (BUF) * 65536 + ((e2 * 4 + j) * 32 + r32) * 256 + (((2 * sl + hh) ^ (r32 & 15)) * 16)); \
                    o[(OB) + j] = __builtin_amdgcn_mfma_f32_32x32x16_bf16(qa[sl], bb, o[(OB) + j], 0, 0, 0); } \
                __builtin_amdgcn_sched_barrier(0); } } while (0)
        bf16x8 qa[8];
        RM_WAITBAR(); RM_DMA_V(1, 0);      RM_PV(1, 0);
        RM_WAITBAR(); RM_DMA_ST(0, 0, 1);  RM_PV(0, 4);
        RM_QA(0); RM_WAITBAR(); RM_QA_USE(); RM_DMA_ST(0, 1, 0);  RM_CROSS(1, 0);
        RM_QA(1); RM_WAITBAR(); RM_QA_USE(); RM_DMA_ST(1, 0, 1);  RM_CROSS(0, 0);
        RM_QA(0); RM_WAITBAR(); RM_QA_USE(); RM_DMA_ST(1, 1, 0);  RM_CROSS(1, 4);
        RM_QA(1); RM_WAITBAR(); RM_QA_USE();                      RM_CROSS(0, 4);
#undef RM_QA
#undef RM_QA_USE
#undef RM_DMA_KS
#undef RM_DMA_V
#undef RM_DMA_ST
#undef RM_PV
#undef RM_CROSS
#pragma unroll
        for (int i = 0; i < 16; ++i) { float s1 = 0.f, s2 = 0.f;
#pragma unroll
            for (int eb = 0; eb < 8; ++eb) { s1 += o[eb][i]; s2 += o[eb][i] * o[eb][i]; }
            s1 = half_sum32(s1); s2 = half_sum32(s2);
            if (r32 == 0) { part[(e2 * 128 + rg * 32 + crow(i, hh)) * 2] = s1; part[(e2 * 128 + rg * 32 + crow(i, hh)) * 2 + 1] = s2; } }
        asm volatile("s_waitcnt lgkmcnt(0)\n\ts_barrier" ::: "memory");
#undef RM_WAITBAR
#pragma unroll
        for (int i = 0; i < 16; ++i) { const int rl = rg * 32 + crow(i, hh);
            const float s1 = part[rl * 2] + part[(128 + rl) * 2], s2 = part[rl * 2 + 1] + part[(128 + rl) * 2 + 1];
            const float mean = s1 * (1.f / 512.f), var = __builtin_fmaxf(s2 * (1.f / 512.f) - mean * mean, 0.f), rstd = 1.f / sqrtf(var + LN_EPS);
            LAS bf16* tp = (LAS bf16*)(lds + rl * 1024) + e2 * 128 + r32;
#pragma unroll
            for (int eb = 0; eb < 8; ++eb) tp[(eb >> 2) * 256 + (eb & 3) * 32] = (bf16)pk2((o[eb][i] - mean) * rstd, 0.f); }
        v4u gv[16];
#pragma unroll
        for (int k = 0; k < 16; ++k) { const int p = tid + 512 * k, row = p >> 6, c16 = p & 63; gv[k] = __builtin_nontemporal_load((const GAS v4u*)(PROJ + (size_t)4 * T * 1024 + (hb0 + row) * 512 + c16 * 8)); }
        __builtin_amdgcn_sched_barrier(0);
        LDS_WAIT(); __syncthreads();
#pragma unroll
        for (int k = 0; k < 16; ++k) { const int p = tid + 512 * k, row = p >> 6, c16 = p & 63;
            const v4u ov = *(const LAS v4u*)(lds + p * 16); v4u r;
#pragma unroll
            for (int q = 0; q < 4; ++q) { const float g0 = bflo(gv[k][q]), g1 = bfhi(gv[k][q]);
                const float s0 = g0 * __builtin_amdgcn_rcpf(1.0f + __builtin_amdgcn_exp2f(-g0 * LOG2E)), s1 = g1 * __builtin_amdgcn_rcpf(1.0f + __builtin_amdgcn_exp2f(-g1 * LOG2E));
                r[q] = pk2(bflo(ov[q]) * s0, bfhi(ov[q]) * s1); }
            *(GAS v4u*)(AO + (tokbase + row) * 2048 + h * 512 + c16 * 8) = r; }
        LDS_WAIT(); __syncthreads();
    }
}
struct Args { const float* in[20]; float* out; unsigned char* ws; int ph_lo, ph_hi; };
constexpr int N_PHASES = 1 + 2 * (3 + 4) + 2 * (4 + 4);

__global__ void __launch_bounds__(NWAVES * 64, 2) mega_fwd(Args args) {
    extern __shared__ __attribute__((aligned(16))) unsigned char lds[];
    Frame F;
    F.lds = (LAS unsigned char*)lds;
    F.MISC = (volatile LAS unsigned*)(F.lds + MISC_OFF);
    F.G = gridDim.x; { const int bx = blockIdx.x; F.vcu = (F.G % 8 == 0) ? (bx % 8) * (F.G / 8) + bx / 8 : bx; }
    F.ctl = (gu32*)(args.ws + WS_CTL);
    for (int u = threadIdx.x; u < (LDS_BYTES - RING_BYTES) / 4; u += NWAVES * 64) ((LAS unsigned*)(F.lds + RING_BYTES))[u] = 0u;
    __syncthreads();
    if ((threadIdx.x & 63) == 0) *(LAS int*)(F.lds + WAVETBL_OFF + ((int)__builtin_amdgcn_s_getreg((5 << 11) | 4) & 63) * 4) = (int)(threadIdx.x >> 6);
    __syncthreads();
    XcdBarrier bar = xcd_barrier_post((unsigned*)(F.ctl + CW_BAR), F.MISC + 8);

    typedef __attribute__((address_space(4))) const unsigned char* kptr_t;
#define KP() kptr_t kp_ = (kptr_t)__builtin_amdgcn_kernarg_segment_ptr(); asm volatile("" : "+s"(kp_))
#define IN_(i) ((const float*)(*(const GAS float* __attribute__((address_space(4))) const*)(kp_ + 8 * (i))))
#define OUT_() ((float*)(*(GAS float* __attribute__((address_space(4))) const*)(kp_ + 160)))
#define WS_(off) ((unsigned char*)(*(GAS unsigned char* __attribute__((address_space(4))) const*)(kp_ + 168)) + (off))
    const int lo = args.ph_lo, hi = args.ph_hi;
    int ph = 0;
#define RUN() (lo <= ph && ph < hi)
#define REP(k) for (int rep_ = 0; rep_ < ((PROBE_DOUBLE == (k)) ? 2 : 1); ++rep_)
#define SEAM() do { for (int sr_ = 0; sr_ < ((PROBE_DOUBLE == 10) ? 2 : 1); ++sr_) if (ph + 1 < hi) { XcdBarrier b_ = bar; asm volatile("" : "+s"(b_.bar), "+s"(b_.x)); b_.bar = (unsigned*)(GAS unsigned*)b_.bar; xcd_barrier(b_); } } while (0)

    if (RUN()) {
        REP(1) { KP();
        p0_family<0>(F, IN_(1), (bf16*)WS_(WS_WDAIN), 2, D, 3072);
        p0_family<0>(F, IN_(2), (bf16*)WS_(WS_WDAOUT), 2, D, D);
        p0_family<0>(F, IN_(8), (bf16*)WS_(WS_WRETIN), 2, D, 6144);
        p0_family<0>(F, IN_(9), (bf16*)WS_(WS_WRETOUT), 2, 2048, D);
        p0_router_image(F, IN_(10), WS_(WS_WIMG));
        p0_x_to_bf16(F, IN_(0), (bf16*)WS_(WS_XB)); }
        SEAM();
    }
    ++ph;

#pragma unroll 1
    for (int layer = 0; layer < DEPTH; ++layer) {
        const int jm = layer >> 1;
        if ((layer & 1) == 0) {
            if (RUN()) {
                KP(); pg8::Gemm g{(bf16*)WS_(WS_XB), (bf16*)WS_(WS_WDAIN) + (size_t)jm * 3072 * D, T, 3072, D}; pg8::StaticOrder S; S.init(T, 3072, F.G, (int)blockIdx.x);
                pg8::EpiScaleBf16 E{(bf16*)WS_(WS_PROJ), 3072, 1024, 0.125f * LOG2E, (unsigned*)(GAS unsigned*)(F.ctl + CW_KMAX + jm * 256)};

REP(2) {
pg8::gemm_phase<pg8::EpiScaleBf16, pg8::StaticOrder, PG8_ALIGN, PG8_SP2>(F.lds, g, S, E);
}

                SEAM();
            }
            ++ph;
            if (RUN()) {
                KP(); float d1 = 0.f, d2 = 0.f;
                { const float* lq1 = IN_(3) + jm * 64; const float* lk1 = IN_(4) + jm * 64; const float* lq2 = IN_(5) + jm * 64; const float* lk2 = IN_(6) + jm * 64;
                  for (int i = 0; i < 64; ++i) { d1 += lq1[i] * lk1[i]; d2 += lq2[i] * lk2[i]; } }
                const float li = (layer == 0) ? 0.2f : 0.47071301834148437f;
                const float lam = __expf(d1) - __expf(d2) + li;

REP(3)
                {
                  const int l0 = (layer == 0) ? 0 : 2, nl = 2;
                  const ConvJob cj{IN_(12) + (size_t)l0 * NEXP * D * 2 * FF, (bf16*)WS_(WS_WGU) + (size_t)l0 * NEXP * D * 2 * FF, IN_(14) + (size_t)l0 * NEXP * FF * D, (bf16*)WS_(WS_WDN) + (size_t)l0 * NEXP * FF * D, (rep_ == 0) ? nl * NEXP : 0, 2};
                  da_attn_phase(F, (const bf16*)WS_(WS_PROJ), (bf16*)WS_(WS_AO), lam, 1.0f - li, IN_(7) + jm * 128, (const unsigned*)(GAS unsigned*)(F.ctl + CW_KMAX + jm * 256), F.ctl + CW_QCTR + jm * 64 + rep_ * 8, cj); }

                SEAM();
            }
            ++ph;
            if (RUN()) {
                KP(); pg8::Gemm g{(bf16*)WS_(WS_AO), (bf16*)WS_(WS_WDAOUT) + (size_t)jm * D * D, T, D, D}; pg8::StaticOrder S; S.init(T, D, F.G, (int)blockIdx.x);
                pg8::EpiRes E{(bf16*)WS_(WS_XB), (bf16*)WS_(WS_Y), D, DN_ALPHA, (float*)WS_(WS_STATS)};

REP(2) {
pg8::gemm_phase<pg8::EpiRes, pg8::StaticOrder, PG8_ALIGN, PG8_SP2>(F.lds, g, S, E);
}

                SEAM();
            }
            ++ph;
        } else {
            const float lg2[4] = {-0.045803689613124784f, -0.022720076500083584f, -0.011315313227834068f, -0.0056465631411835116f};
            if (RUN()) {
                KP(); pg8::Gemm g{(bf16*)WS_(WS_XB), (bf16*)WS_(WS_WRETIN) + (size_t)jm * 6144 * D, T, 6144, D}; pg8::StaticOrder S; S.init(T, 6144, F.G, (int)blockIdx.x);
                pg8::EpiRetProj E{(bf16*)WS_(WS_PROJ), 6144, {lg2[0], lg2[1], lg2[2], lg2[3]}};

REP(2) {
pg8::gemm_phase<pg8::EpiRetProj, pg8::StaticOrder, PG8_ALIGN, PG8_SP2>(F.lds, g, S, E);
}

                SEAM();
            }
            ++ph;
            if (RUN()) {
 KP(); REP(4) ret_scan_phase(F, (const bf16*)WS_(WS_PROJ), (bf16*)WS_(WS_STATE), lg2);
 SEAM(); }
            ++ph;
            if (RUN()) {
 KP(); REP(5) ret_main_phase(F, (const bf16*)WS_(WS_PROJ), (const bf16*)WS_(WS_STATE), (bf16*)WS_(WS_AO));
 SEAM(); }
            ++ph;
            if (RUN()) {
                KP(); pg8::Gemm g{(bf16*)WS_(WS_AO), (bf16*)WS_(WS_WRETOUT) + (size_t)jm * D * 2048, T, D, 2048}; pg8::StaticOrder S; S.init(T, D, F.G, (int)blockIdx.x);
                pg8::EpiRes E{(bf16*)WS_(WS_XB), (bf16*)WS_(WS_Y), D, DN_ALPHA, (float*)WS_(WS_STATS)};

REP(2) {
pg8::gemm_phase<pg8::EpiRes, pg8::StaticOrder, PG8_ALIGN, PG8_SP2>(F.lds, g, S, E);
}

                SEAM();
            }
            ++ph;
        }
        gu32* cnt = F.ctl + CW_CNT + layer * NEXP * 64;
        if (RUN()) {

            KP();
            ln_router_phase(F, (const bf16*)WS_(WS_Y), (const float*)WS_(WS_STATS), IN_(16) + layer * D, IN_(17) + layer * D, (const unsigned char*)WS_(WS_WIMG) + (size_t)layer * 131072, IN_(11) + layer * NEXP, (bf16*)WS_(WS_XB), (int2*)WS_(WS_SLOT), cnt);
            SEAM();
        }
        ++ph;
        if (RUN()) {
            KP(); build_tables(F, cnt);
            pg8::Gemm g{(bf16*)WS_(WS_XB), (bf16*)WS_(WS_WGU) + (size_t)layer * NEXP * 2048 * D, MT_MAX * 256, 2048, D};
            GroupedOrder S{(const LAS int*)(F.lds + TBL_OFF), 8, 4, F.G, (int)blockIdx.x};
            pg8::EpiSwiGLU E{(bf16*)WS_(WS_ACT), IN_(13) + (size_t)layer * NEXP * 2048};

REP(6) {
pg8::gemm_phase<pg8::EpiSwiGLU, GroupedOrder, PG8_ALIGN, PG8_SP2, true>(F.lds, g, S, E, (const int2*)WS_(WS_SLOT), F.lds + TBL_OFF + 4096);
}

            SEAM();
        }
        ++ph;
        if (RUN()) {
            KP(); build_tables(F, cnt);
            pg8::Gemm g{(bf16*)WS_(WS_ACT), (bf16*)WS_(WS_WDN) + (size_t)layer * NEXP * D * FF, MT_MAX * 256, D, FF};
            GroupedOrder S{(const LAS int*)(F.lds + TBL_OFF), 4, 8, F.G, (int)blockIdx.x};
            pg8::EpiDown E{(bf16*)WS_(WS_YE), IN_(15) + (size_t)layer * NEXP * D, (const int2*)WS_(WS_SLOT), T * TOPK};

REP(6) {
pg8::gemm_phase<pg8::EpiDown, GroupedOrder, PG8_ALIGN, PG8_SP2>(F.lds, g, S, E);
}

            SEAM();
        }
        ++ph;
        if (RUN()) { KP(); combine_ln_phase(F, (const bf16*)WS_(WS_YE), IN_(18) + layer * D, IN_(19) + layer * D, (layer == DEPTH - 1) ? OUT_() : (float*)nullptr, (bf16*)WS_(WS_XB)); SEAM(); }
        ++ph;
    }
#undef RUN
#undef SEAM
}

extern "C" void kernel_launch(void* const* d_in, const int* in_sizes, int n_in, void* d_out, int out_size, void* d_ws, size_t ws_size, hipStream_t stream) {
    static int grid = 0;
    if (grid == 0) {
        if (n_in != 20 || in_sizes[0] != T * D || out_size != T * D || ws_size < WS_END) { fprintf(stderr, "kernel_launch: unexpected shapes (n_in %d, in0 %d, out %d, ws %zu); nothing launched\n", n_in, n_in > 0 ? in_sizes[0] : -1, out_size, ws_size); grid = -1; return; }
        int dev = 0, cus = 0, per_cu = 0;
        if (hipGetDevice(&dev) != hipSuccess || hipDeviceGetAttribute(&cus, hipDeviceAttributeMultiprocessorCount, dev) != hipSuccess) { grid = -1; return; }
        if (hipFuncSetAttribute((const void*)mega_fwd, hipFuncAttributeMaxDynamicSharedMemorySize, LDS_BYTES) != hipSuccess) { fprintf(stderr, "kernel_launch: hipFuncSetAttribute failed\n"); grid = -1; return; }
        if (hipOccupancyMaxActiveBlocksPerMultiprocessor(&per_cu, (const void*)mega_fwd, NWAVES * 64, LDS_BYTES) != hipSuccess || per_cu < 1)
            fprintf(stderr, "kernel_launch: note: occupancy query reports %d workgroups per CU\n", per_cu);
        (void)hipGetLastError();
        grid = cus;
    }
    if (grid < 0) return;
    if (hipMemsetAsync((char*)d_ws + WS_CTL, 0, CTL_ZERO_BYTES, stream) != hipSuccess) return;
    Args a{};
    for (int i = 0; i < 20; ++i) a.in[i] = (const float*)d_in[i];
    a.out = (float*)d_out; a.ws = (unsigned char*)d_ws;
#if MK_N_LAUNCHES == 1
    a.ph_lo = 0; a.ph_hi = N_PHASES;
    hipLaunchKernelGGL(mega_fwd, dim3(grid), dim3(NWAVES * 64), LDS_BYTES, stream, a);
#else
    for (int p = 0; p < N_PHASES; ++p) { a.ph_lo = p; a.ph_hi = p + 1; hipLaunchKernelGGL(mega_fwd, dim3(grid), dim3(NWAVES * 64), LDS_BYTES, stream, a); }
#endif
    const hipError_t le = hipPeekAtLastError();
    if (le != hipSuccess) fprintf(stderr, "kernel_launch: launch failed: %s\n", hipGetErrorName(le));
}
```

```cpp
#include <hip/hip_runtime.h>
#include <cstdio>
#include <cstdint>
constexpr int WAVETBL_OFF = 147456 - 256;
__device__ __forceinline__ int hw_tid(__attribute__((address_space(3))) unsigned char* lds0) {
    const int slot = (int)__builtin_amdgcn_s_getreg((5 << 11) | 4) & 63;
    const int wave = __builtin_amdgcn_readfirstlane(*(const __attribute__((address_space(3))) int*)(lds0 + WAVETBL_OFF + slot * 4));
    unsigned z = 0u; asm volatile("" : "+v"(z));
    int t = wave * 64 + (int)__builtin_amdgcn_mbcnt_hi(~0u, __builtin_amdgcn_mbcnt_lo(~0u, z));
    asm volatile("" : "+v"(t)); return t; }
template <int CTRL> __device__ __forceinline__ float dppf(float v) { return __builtin_bit_cast(float, __builtin_amdgcn_update_dpp(0, __builtin_bit_cast(int, v), CTRL, 0xF, 0xF, true)); }
__device__ __forceinline__ float swap16_other(float v, float& self) { float w; asm volatile("s_nop 1\n\tv_permlane16_swap_b32 %0, %1" : "=v"(w), "+v"(v) : "0"(v)); self = v; return w; }
__device__ __forceinline__ float swap32_other(float v, float& self) { float w; asm volatile("s_nop 1\n\tv_permlane32_swap_b32 %0, %1" : "=v"(w), "+v"(v) : "0"(v)); self = v; return w; }
__device__ __forceinline__ float row_sum16(float v) { v += dppf<0xB1>(v); v += dppf<0x4E>(v); v += dppf<0x141>(v); v += dppf<0x140>(v); return v; }
__device__ __forceinline__ float row_max16(float v) { v = __builtin_fmaxf(v, dppf<0xB1>(v)); v = __builtin_fmaxf(v, dppf<0x4E>(v)); v = __builtin_fmaxf(v, dppf<0x141>(v)); v = __builtin_fmaxf(v, dppf<0x140>(v)); return v; }
__device__ __forceinline__ float half_sum32(float v) { v = row_sum16(v); float a; const float b = swap16_other(v, a); return a + b; }
__device__ __forceinline__ float half_max32(float v) { v = row_max16(v); float a; const float b = swap16_other(v, a); return __builtin_fmaxf(a, b); }
__device__ __forceinline__ float wave_sum(float v) { v = half_sum32(v); float a; const float b = swap32_other(v, a); return a + b; }
__device__ __forceinline__ float wave_max(float v) { v = half_max32(v); float a; const float b = swap32_other(v, a); return __builtin_fmaxf(a, b); }
__device__ __forceinline__ float xor32_sum(float v) { float a; const float b = swap32_other(v, a); return a + b; }
__device__ __forceinline__ float xor32_max(float v) { float a; const float b = swap32_other(v, a); return __builtin_fmaxf(a, b); }
__device__ __forceinline__ float xor16_sum(float v) { float a; const float b = swap16_other(v, a); return a + b; }
namespace pg8 {
#define PG8_LAS __attribute__((address_space(3)))
typedef unsigned short bf16_t;
typedef short bf16x8 __attribute__((ext_vector_type(8)));
typedef float f32x4 __attribute__((ext_vector_type(4)));
typedef unsigned u32x4 __attribute__((ext_vector_type(4)));
constexpr int BM = 256, BK = 64, HALF = 128, HTB = HALF * BK * 2  , STAGE_BYTES = 8 * HTB, NXCD = 8, WGM = 4;

__host__ __device__ __forceinline__ int lds_byte(int r, int c) { const int st = (r >> 4) * 2 + (c >> 5), rr = r & 15, cc = c & 31, ob = rr * 64 + cc * 2; return st * 1024 + (ob ^ (((ob >> 9) & 1) << 5)); }
__host__ __device__ __forceinline__ void stage_rc(int b, int& R, int& C) { const int st = b / 1024, sb = b % 1024, swz = sb ^ (((sb >> 9) & 1) << 5); R = (st >> 1) * 16 + swz / 64; C = (st & 1) * 32 + (swz % 64) / 2; }
__host__ __device__ __forceinline__ int perm32(int rho) { const int n = rho >> 4, i = rho & 15; return 8 * (i >> 2) + 4 * n + (i & 3); }

struct Unit { int pm, pn, pb, aux, rows, lt; };
struct Gemm { const bf16_t* A; const bf16_t* Bt; int M, N, K; };

struct StaticOrder {
    int nM, nN, nwg, G, c;
    __host__ __device__ void init(int M, int N, int G_, int c_) { nM = M / BM; nN = N / BM; nwg = nM * nN; G = G_; c = c_; }
    __host__ __device__ bool next(int i, Unit& u) const {
        const long L = (long)i * G + c; if (L >= nwg) return false;
        int wgid = (int)L; { const int q = nwg / NXCD, r = nwg % NXCD, xcd = wgid % NXCD, off = wgid / NXCD; wgid = (xcd < r ? xcd * (q + 1) : r * (q + 1) + (xcd - r) * q) + off; }
        const int nig = WGM * nN, gid = wgid / nig, fm = gid * WGM, gsz = (nM - fm) < WGM ? (nM - fm) : WGM;
        u.pm = fm + ((wgid % nig) % gsz); u.pn = (wgid % nig) / gsz; u.pb = u.pn; u.aux = 0; u.rows = BM; u.lt = 0; return true;
    }
    __device__ __forceinline__ void a_ready(const Unit&) const {}
    __device__ __forceinline__ void done(const Unit&) const {}
};

__device__ __forceinline__ unsigned cvt_pk_bf16(float lo, float hi) { unsigned r; asm volatile("v_cvt_pk_bf16_f32 %0, %1, %2" : "=v"(r) : "v"(lo), "v"(hi)); return r; }
__device__ __forceinline__ u32x4 pack8(const f32x4 v0, const f32x4 v1) { u32x4 w; w.x = cvt_pk_bf16(v0[0], v0[1]); w.y = cvt_pk_bf16(v0[2], v0[3]); w.z = cvt_pk_bf16(v1[0], v1[1]); w.w = cvt_pk_bf16(v1[2], v1[3]); return w; }

struct EpiScaleBf16 {
    static constexpr bool PERM = true, AFTER_DRAIN = false;
    struct Pre {}; __device__ __forceinline__ void preload(Pre&, const Unit&, int, int, int, int) const {}
    __device__ __forceinline__ void init(f32x4 (&acc)[2][2][4][2], const Pre&) const {
#pragma unroll
        for (int a = 0; a < 2; ++a)
#pragma unroll
            for (int b = 0; b < 2; ++b)
#pragma unroll
                for (int m = 0; m < 4; ++m)
#pragma unroll
                    for (int n = 0; n < 2; ++n) acc[a][b][m][n] = (f32x4){0.f, 0.f, 0.f, 0.f}; }
    bf16_t* O; int ldc; int qcols; float qscale; unsigned* kmax;
    __device__ __forceinline__ void operator()(const f32x4 (&acc)[2][2][4][2], const Unit& u, int wr, int wc, int fr, int fq) const {
        const int row0 = u.pm * BM + wr * 64 + fr, col0 = u.pn * BM + wc * 32 + 8 * fq;
        if (u.pn >= 4 && u.pn < 8) {
#pragma unroll
            for (int bj = 0; bj < 2; ++bj) { float mx = 0.f;
#pragma unroll
                for (int ai = 0; ai < 2; ++ai)
#pragma unroll
                    for (int m = 0; m < 4; ++m) { const f32x4 a = acc[ai][bj][m][0], c = acc[ai][bj][m][1];
                        float ss = (a[0] * a[0] + a[1] * a[1]) + (a[2] * a[2] + a[3] * a[3]) + (c[0] * c[0] + c[1] * c[1]) + (c[2] * c[2] + c[3] * c[3]);
                        ss = xor32_sum(xor16_sum(ss)); mx = __builtin_fmaxf(mx, ss); }
                mx = row_max16(mx);
                if (fr == 0 && fq == 0) { const int b = u.pm >> 5, hm = (u.pn - 4) * 4 + bj * 2 + (wc >> 1);
                    __hip_atomic_fetch_max(kmax + ((b * 16 + hm) * 2 + (wc & 1)), __builtin_bit_cast(unsigned, mx), __ATOMIC_RELAXED, __HIP_MEMORY_SCOPE_AGENT); } }
        }
#pragma unroll
        for (int ai = 0; ai < 2; ++ai)
#pragma unroll
            for (int m = 0; m < 4; ++m) { bf16_t* rowp = O + (size_t)(row0 + ai * HALF + m * 16) * ldc + col0;
#pragma unroll
                for (int bj = 0; bj < 2; ++bj) { const float sc = (col0 + bj * HALF) < qcols ? qscale : 1.f;
                    *(u32x4*)(rowp + bj * HALF) = pack8(acc[ai][bj][m][0] * sc, acc[ai][bj][m][1] * sc); } }
    }
};

struct EpiRetProj {
    static constexpr bool PERM = true, AFTER_DRAIN = false;
    struct Pre {}; __device__ __forceinline__ void preload(Pre&, const Unit&, int, int, int, int) const {}
    __device__ __forceinline__ void init(f32x4 (&acc)[2][2][4][2], const Pre&) const {
#pragma unroll
        for (int a = 0; a < 2; ++a)
#pragma unroll
            for (int b = 0; b < 2; ++b)
#pragma unroll
                for (int m = 0; m < 4; ++m)
#pragma unroll
                    for (int n = 0; n < 2; ++n) acc[a][b][m][n] = (f32x4){0.f, 0.f, 0.f, 0.f}; }
    bf16_t* O; int ldc; float lg2[4];
    __device__ __forceinline__ void operator()(const f32x4 (&acc)[2][2][4][2], const Unit& u, int wr, int wc, int fr, int fq) const {
        const int row0 = u.pm * BM + wr * 64 + fr, cl = wc * 32 + 8 * fq;
#pragma unroll
        for (int bj = 0; bj < 2; ++bj) {
            const int c0 = u.pn * BM + bj * HALF, sect = c0 >> 10;
            int head, width, colh; size_t base;
            if (sect < 2) { head = (c0 >> 8) & 3; width = 256; colh = (c0 & 255) + cl; base = (size_t)sect * 33554432; }
            else if (sect < 4) { head = (c0 - 2048) >> 9; width = 512; colh = ((c0 - 2048) & 511) + cl; base = (size_t)2 * 33554432; }
            else { head = (c0 - 4096) >> 9; width = 512; colh = ((c0 - 4096) & 511) + cl; base = (size_t)4 * 33554432; }
            const float lg = head == 0 ? lg2[0] : head == 1 ? lg2[1] : head == 2 ? lg2[2] : lg2[3];
#pragma unroll
            for (int ai = 0; ai < 2; ++ai)
#pragma unroll
                for (int m = 0; m < 4; ++m) { const int row = row0 + ai * HALF + m * 16; const float jp = (float)((row & 127) + 1);
                    float sc = 1.f; if (sect == 0) sc = __builtin_amdgcn_exp2f(jp * lg); else if (sect == 1) sc = 0.0625f * __builtin_amdgcn_exp2f(-jp * lg);
                    const size_t off = base + ((size_t)(((row >> 13) * 4 + head) * 8192 + (row & 8191))) * width + colh;
                    *(u32x4*)(O + off) = pack8(acc[ai][bj][m][0] * sc, acc[ai][bj][m][1] * sc); } }
    }
};

struct EpiRes {
    static constexpr bool PERM = false, AFTER_DRAIN = false;
    struct Pre {}; __device__ __forceinline__ void preload(Pre&, const Unit&, int, int, int, int) const {}
    __device__ __forceinline__ void init(f32x4 (&acc)[2][2][4][2], const Pre&) const {
#pragma unroll
        for (int a = 0; a < 2; ++a)
#pragma unroll
            for (int b = 0; b < 2; ++b)
#pragma unroll
                for (int m = 0; m < 4; ++m)
#pragma unroll
                    for (int n = 0; n < 2; ++n) acc[a][b][m][n] = (f32x4){0.f, 0.f, 0.f, 0.f}; }
    const bf16_t* XB; bf16_t* Y; int ldc; float alpha; float* STATS;
    __device__ __forceinline__ void operator()(const f32x4 (&acc)[2][2][4][2], const Unit& u, int wr, int wc, int fr, int fq) const {
        typedef unsigned u32x2 __attribute__((ext_vector_type(2)));
        const int row0 = u.pm * BM + wr * 64 + fr, col0 = u.pn * BM + wc * 32 + 4 * fq;
        u32x2 xr[2][4][2][2];
#pragma unroll
        for (int ai = 0; ai < 2; ++ai)
#pragma unroll
            for (int m = 0; m < 4; ++m) { const size_t off = (size_t)(row0 + ai * HALF + m * 16) * ldc + col0;
#pragma unroll
                for (int bj = 0; bj < 2; ++bj)
#pragma unroll
                    for (int n = 0; n < 2; ++n) xr[ai][m][bj][n] = *(const u32x2*)(XB + off + bj * HALF + n * 16); }
        __builtin_amdgcn_sched_barrier(0);
#pragma unroll
        for (int ai = 0; ai < 2; ++ai)
#pragma unroll
            for (int m = 0; m < 4; ++m) { const size_t off = (size_t)(row0 + ai * HALF + m * 16) * ldc + col0; float s1 = 0.f, s2 = 0.f;
#pragma unroll
                for (int bj = 0; bj < 2; ++bj)
#pragma unroll
                    for (int n = 0; n < 2; ++n) { const u32x2 xw = xr[ai][m][bj][n];
                        const f32x4 x = (f32x4){__builtin_bit_cast(float, xw.x << 16), __builtin_bit_cast(float, xw.x & 0xffff0000u), __builtin_bit_cast(float, xw.y << 16), __builtin_bit_cast(float, xw.y & 0xffff0000u)};
                        const f32x4 y = x * alpha + acc[ai][bj][m][n]; { u32x2 yw; yw.x = cvt_pk_bf16(y[0], y[1]); yw.y = cvt_pk_bf16(y[2], y[3]); *(u32x2*)(Y + off + bj * HALF + n * 16) = yw; }
                        s1 += (y[0] + y[1]) + (y[2] + y[3]); s2 += (y[0] * y[0] + y[1] * y[1]) + (y[2] * y[2] + y[3] * y[3]); }
                s1 = xor32_sum(xor16_sum(s1)); s2 = xor32_sum(xor16_sum(s2));
                if (fq == 0) { typedef float f32x2s __attribute__((ext_vector_type(2))); *(f32x2s*)(STATS + ((size_t)(row0 + ai * HALF + m * 16) * 16 + u.pn * 4 + wc) * 2) = (f32x2s){s1, s2}; } }
    }
};

struct EpiSwiGLU {
    static constexpr bool PERM = true, AFTER_DRAIN = false;
    bf16_t* ACT; const float* bgu;
    struct Pre { f32x4 v[4]; };
    __device__ __forceinline__ void preload(Pre& p, const Unit& u, int wr, int wc, int fr, int fq) const {
        const float* be = bgu + (size_t)u.aux * 2048 + u.pn * HALF + wc * 32 + 8 * fq;
        p.v[0] = *(const f32x4*)(be); p.v[1] = *(const f32x4*)(be + 4); p.v[2] = *(const f32x4*)(be + 1024); p.v[3] = *(const f32x4*)(be + 1028); }
    __device__ __forceinline__ void init(f32x4 (&acc)[2][2][4][2], const Pre& p) const {
#pragma unroll
        for (int a = 0; a < 2; ++a)
#pragma unroll
            for (int m = 0; m < 4; ++m) { acc[a][0][m][0] = p.v[0]; acc[a][0][m][1] = p.v[1]; acc[a][1][m][0] = p.v[2]; acc[a][1][m][1] = p.v[3]; } }
    __device__ __forceinline__ void operator()(const f32x4 (&acc)[2][2][4][2], const Unit& u, int wr, int wc, int fr, int fq) const {
        const int row0 = u.pm * BM + wr * 64 + fr, f0 = u.pn * HALF + wc * 32 + 8 * fq;
#pragma unroll
        for (int ai = 0; ai < 2; ++ai)
#pragma unroll
            for (int m = 0; m < 4; ++m) {
                f32x4 o[2];
#pragma unroll
                for (int n = 0; n < 2; ++n) { const f32x4 g4 = acc[ai][0][m][n], u4 = acc[ai][1][m][n];
#pragma unroll
                    for (int i = 0; i < 4; i += 2) {
                        typedef float f32x2p __attribute__((ext_vector_type(2)));
                        const f32x2p g = {__builtin_amdgcn_fmed3f(g4[i], -3.0e38f, 7.0f), __builtin_amdgcn_fmed3f(g4[i + 1], -3.0e38f, 7.0f)}, up = {__builtin_amdgcn_fmed3f(u4[i], -7.0f, 7.0f), __builtin_amdgcn_fmed3f(u4[i + 1], -7.0f, 7.0f)};
                        const f32x2p a = g * (f32x2p){-1.702f * 1.4426950408889634f, -1.702f * 1.4426950408889634f};
                        const f32x2p d = (f32x2p){__builtin_amdgcn_exp2f(a.x), __builtin_amdgcn_exp2f(a.y)} + (f32x2p){1.0f, 1.0f};
                        const f32x2p t = g * (f32x2p){__builtin_amdgcn_rcpf(d.x), __builtin_amdgcn_rcpf(d.y)};
                        const f32x2p r = __builtin_elementwise_fma(t, up, t); o[n][i] = r.x; o[n][i + 1] = r.y; } }
                *(u32x4*)(ACT + (size_t)(row0 + ai * HALF + m * 16) * 1024 + f0) = pack8(o[0], o[1]); }
    }
};

constexpr int GCAP_SLOTS = 32768;
struct EpiDown {
    static constexpr bool PERM = true, AFTER_DRAIN = false;
    struct Pre { f32x4 v[4]; };
    __device__ __forceinline__ void preload(Pre& p, const Unit& u, int wr, int wc, int fr, int fq) const {
        const float* be = bd + (size_t)u.aux * 1024 + u.pn * BM + wc * 32 + 8 * fq;
        p.v[0] = *(const f32x4*)(be); p.v[1] = *(const f32x4*)(be + 4); p.v[2] = *(const f32x4*)(be + HALF); p.v[3] = *(const f32x4*)(be + HALF + 4); }
    __device__ __forceinline__ void init(f32x4 (&acc)[2][2][4][2], const Pre& p) const {
#pragma unroll
        for (int bj = 0; bj < 2; ++bj)
#pragma unroll
            for (int a = 0; a < 2; ++a)
#pragma unroll
                for (int m = 0; m < 4; ++m) { acc[a][bj][m][0] = p.v[2 * bj]; acc[a][bj][m][1] = p.v[2 * bj + 1]; } }
    bf16_t* YE; const float* bd; const int2* SLOT; int dummy_row;
    __device__ __forceinline__ void operator()(const f32x4 (&acc)[2][2][4][2], const Unit& u, int wr, int wc, int fr, int fq) const {
        int rl0 = wr * 64 + fr; asm volatile("" : "+v"(rl0));
        const int col0 = u.pn * BM + wc * 32 + 8 * fq;
        int2 sr[2][4];
#pragma unroll
        for (int ai = 0; ai < 2; ++ai)
#pragma unroll
            for (int m = 0; m < 4; ++m) { const int rl = rl0 + ai * HALF + m * 16;
                sr[ai][m] = SLOT[(size_t)u.aux * GCAP_SLOTS + (size_t)u.lt * BM + (rl < u.rows ? rl : 0)]; }
        __builtin_amdgcn_sched_barrier(0);
#pragma unroll
        for (int ai = 0; ai < 2; ++ai)
#pragma unroll
            for (int m = 0; m < 4; ++m) { const int rl = rl0 + ai * HALF + m * 16; const bool ok = rl < u.rows;
                const int2 s = sr[ai][m]; const float w = __int_as_float(s.y); bf16_t* rowp = YE + (size_t)(ok ? s.x : dummy_row) * 1024 + col0;
#pragma unroll
                for (int bj = 0; bj < 2; ++bj) *(u32x4*)(rowp + bj * HALF) = pack8(acc[ai][bj][m][0] * w, acc[ai][bj][m][1] * w); }
    }
};

constexpr int GCAP = GCAP_SLOTS;
template <class Epi, class Sched, bool ALIGN_EPI = false, bool SP2 = false, bool GATHER = false>
__device__ __forceinline__ void gemm_phase(PG8_LAS unsigned char* lds, const Gemm g, const Sched& S, const Epi& E, const int2* gslot = nullptr, PG8_LAS unsigned char* gtab = nullptr) {
    static_assert(!GATHER || SP2, "the gather path is written for the SP2 loop only");
    const int tid = hw_tid(lds); const int wid = __builtin_amdgcn_readfirstlane(tid >> 6), lane = tid & 63, wr = wid >> 2, wc = wid & 3, fr = lane & 15, fq = lane >> 4;
    const int K = g.K, nt = K / BK;
    unsigned voffA[2], voffB[2];
#pragma unroll
    for (int i = 0; i < 2; ++i) { int R, C; stage_rc(tid * 16 + i * 8192, R, C); const int Rb = Epi::PERM ? ((R & ~31) + perm32(R & 31)) : R;
        voffA[i] = (unsigned)(R * K + C) * 2u; voffB[i] = (unsigned)(Rb * K + C) * 2u; }
    unsigned vC[2][2], vN[2][2]; int grl[2]; unsigned gcb[2];
#pragma unroll
    for (int i = 0; i < 2; ++i) { int R, C; stage_rc(tid * 16 + i * 8192, R, C); grl[i] = R; gcb[i] = (unsigned)C * 2u; }
#pragma unroll
    for (int h = 0; h < 2; ++h)
#pragma unroll
        for (int i = 0; i < 2; ++i) { vC[h][i] = 0u; vN[h][i] = 0u; }
#define PG8_GDMA(u, par) do { int gl_ = lane; asm volatile("" : "+v"(gl_));        \
        if (wid < 2) __builtin_amdgcn_global_load_lds((const unsigned*)((const char*)gslot + ((size_t)(u).aux * GCAP + (size_t)(u).lt * 256) * 8 + (size_t)(wid * 64 + gl_) * 16), \
        (PG8_LAS unsigned*)(gtab + (par) * 2048 + wid * 1024), 16, 0, 0); } while (0)
#define PG8_GREAD(dst, u, par) do { _Pragma("unroll") for (int h_ = 0; h_ < 2; ++h_) _Pragma("unroll") for (int i_ = 0; i_ < 2; ++i_) { const int rl_ = 128 * h_ + grl[i_]; \
        const int tk_ = *(const PG8_LAS int*)(gtab + (par) * 2048 + rl_ * 8); const unsigned tok_ = (rl_ < (u).rows) ? ((unsigned)tk_ >> 2) : 0u; dst[h_][i_] = tok_ * (unsigned)(K * 2) + gcb[i_]; } } while (0)
#define PG8_AH(h) (GATHER ? (size_t)0 : (size_t)(h) * hstep)
#define PG8_VA(arr, h) (GATHER ? arr[h] : voffA)
    const size_t kstep = (size_t)(BK * 2);
    const size_t hstep = (size_t)HALF * K * 2;
    const size_t tstep = 2 * hstep;
    const unsigned ldsw = (unsigned)wid * 1024u;
    const int aoff = lds_byte(wr * 64 + fr, fq * 8), boff = lds_byte(wc * 32 + fr, fq * 8);
#define PG8_SA(b, h) (((b) * 2 + (h)) * HTB)
#define PG8_SB(b, h) ((4 + (b) * 2 + (h)) * HTB)
#define PG8_STAGE(bufoff, gbase, voff) do { _Pragma("unroll") for (int _i = 0; _i < 2; ++_i) \
        __builtin_amdgcn_global_load_lds((const unsigned*)((const char*)(gbase) + (voff)[_i]), (PG8_LAS unsigned*)(lds + (bufoff) + ldsw + _i * 8192), 16, 0, 0); } while (0)
#define PG8_LDA(dst, b, h) do { _Pragma("unroll") for (int m = 0; m < 4; ++m) _Pragma("unroll") for (int k = 0; k < 2; ++k) dst[m][k] = *(const PG8_LAS bf16x8*)(lds + PG8_SA(b, h) + aoff + m * 2048 + k * 1024); } while (0)
#define PG8_LDB(dst, b, h) do { _Pragma("unroll") for (int n = 0; n < 2; ++n) _Pragma("unroll") for (int k = 0; k < 2; ++k) dst[n][k] = *(const PG8_LAS bf16x8*)(lds + PG8_SB(b, h) + boff + n * 2048 + k * 1024); } while (0)
#define PG8_MMA(ai, bj, At, Bt) do { __builtin_amdgcn_s_setprio(1); _Pragma("unroll") for (int m = 0; m < 4; ++m) _Pragma("unroll") for (int n = 0; n < 2; ++n) _Pragma("unroll") for (int k = 0; k < 2; ++k) \
        acc[ai][bj][m][n] = __builtin_amdgcn_mfma_f32_16x16x32_bf16(Bt[n][k], At[m][k], acc[ai][bj][m][n], 0, 0, 0); __builtin_amdgcn_s_setprio(0); } while (0)
#define PG8_WAIT_V(n) asm volatile("s_waitcnt vmcnt(" #n ")" ::: "memory")
#define PG8_WAIT_L(n) asm volatile("s_waitcnt lgkmcnt(" #n ")" ::: "memory")
#define PG8_BAR __builtin_amdgcn_s_barrier()
#define PG8_SCHED __builtin_amdgcn_sched_barrier(0)
    Unit cur, nxt; int ui = 0;
    if (!S.next(0, cur)) return;
    f32x4 acc[2][2][4][2];
    { typename Epi::Pre pre0; E.preload(pre0, cur, wr, wc, fr, fq); E.init(acc, pre0); }
    bf16x8 At[4][2], B0[2][2], B1[2][2];
    const char* cA = GATHER ? (const char*)g.A : (const char*)g.A + (size_t)cur.pm * tstep; const char* cB = (const char*)g.Bt + (size_t)cur.pb * tstep;
    if constexpr (GATHER) { PG8_GDMA(cur, 0); asm volatile("s_waitcnt vmcnt(0)" ::: "memory"); __syncthreads(); PG8_GREAD(vC, cur, 0); }
    S.a_ready(cur);
    if constexpr (SP2) {
        PG8_STAGE(PG8_SB(0, 0), cB, voffB); PG8_STAGE(PG8_SB(0, 1), cB + hstep, voffB); PG8_STAGE(PG8_SA(0, 0), cA, PG8_VA(vC, 0)); PG8_STAGE(PG8_SA(0, 1), cA + PG8_AH(1), PG8_VA(vC, 1));
        if (wr == 1) PG8_BAR;
        PG8_WAIT_V(2); PG8_BAR;
        PG8_STAGE(PG8_SB(1, 0), cB + kstep, voffB); PG8_STAGE(PG8_SA(1, 0), cA + kstep, PG8_VA(vC, 0)); PG8_STAGE(PG8_SB(1, 1), cB + hstep + kstep, voffB);
        PG8_WAIT_V(6); PG8_BAR;
    } else {
        PG8_STAGE(PG8_SB(0, 0), cB, voffB); PG8_STAGE(PG8_SA(0, 0), cA, voffA); PG8_STAGE(PG8_SB(0, 1), cB + hstep, voffB); PG8_STAGE(PG8_SA(0, 1), cA + hstep, voffA);
        if (wr == 1) PG8_BAR;
        PG8_WAIT_V(4); PG8_BAR;
        PG8_STAGE(PG8_SB(1, 0), cB + kstep, voffB); PG8_STAGE(PG8_SA(1, 0), cA + kstep, voffA); PG8_STAGE(PG8_SB(1, 1), cB + hstep + kstep, voffB);
        PG8_WAIT_V(6); PG8_BAR;
    }
    for (;;) {
        const bool has_next = S.next(ui + 1, nxt);
        if constexpr (GATHER) { if (has_next) PG8_GDMA(nxt, (ui + 1) & 1); }
        const char* nA = (has_next && !GATHER) ? (const char*)g.A + (size_t)nxt.pm * tstep : cA; const char* nB = has_next ? (const char*)g.Bt + (size_t)nxt.pb * tstep : cB;
        for (int t = 0; t < nt; t += 2) {
            const bool last = (t == nt - 2);
            const char* a1 = cA + (size_t)(t + 1) * kstep;
            const char* a2 = last ? nA : cA + (size_t)(t + 2) * kstep; const char* b2 = last ? nB : cB + (size_t)(t + 2) * kstep;
            const char* a3 = a2 + kstep; const char* b3 = b2 + kstep;
            if (last && has_next) S.a_ready(nxt);
            if constexpr (GATHER) { if (last) { if (has_next) { PG8_GREAD(vN, nxt, (ui + 1) & 1); } else { _Pragma("unroll") for (int h_ = 0; h_ < 2; ++h_) _Pragma("unroll") for (int i_ = 0; i_ < 2; ++i_) vN[h_][i_] = vC[h_][i_]; } } }
            unsigned vS[2][2];
#pragma unroll
            for (int h_ = 0; h_ < 2; ++h_)
#pragma unroll
                for (int i_ = 0; i_ < 2; ++i_) vS[h_][i_] = (GATHER && last) ? vN[h_][i_] : vC[h_][i_];
            if constexpr (SP2) {
            PG8_LDB(B0, 0, 0); PG8_LDB(B1, 0, 1); PG8_SCHED; PG8_LDA(At, 0, 0); PG8_STAGE(PG8_SA(1, 1), a1 + PG8_AH(1), PG8_VA(vC, 1));
            PG8_WAIT_V(8); PG8_WAIT_L(0); PG8_BAR; PG8_MMA(0, 0, At, B0); PG8_MMA(0, 1, At, B1); PG8_BAR; PG8_SCHED;
            PG8_LDA(At, 0, 1); PG8_STAGE(PG8_SB(0, 0), b2, voffB); PG8_STAGE(PG8_SB(0, 1), b2 + hstep, voffB); PG8_STAGE(PG8_SA(0, 0), a2, PG8_VA(vS, 0));
            PG8_WAIT_V(8); PG8_WAIT_L(0); PG8_BAR; PG8_MMA(1, 0, At, B0); PG8_MMA(1, 1, At, B1); PG8_BAR; PG8_SCHED;
            PG8_LDB(B0, 1, 0); PG8_LDB(B1, 1, 1); PG8_SCHED; PG8_LDA(At, 1, 0); PG8_STAGE(PG8_SA(0, 1), a2 + PG8_AH(1), PG8_VA(vS, 1));
            PG8_WAIT_V(8); PG8_WAIT_L(0); PG8_BAR; PG8_MMA(0, 0, At, B0); PG8_MMA(0, 1, At, B1); PG8_BAR; PG8_SCHED;
            PG8_LDA(At, 1, 1); PG8_STAGE(PG8_SB(1, 0), b3, voffB); PG8_STAGE(PG8_SB(1, 1), b3 + hstep, voffB); PG8_STAGE(PG8_SA(1, 0), a3, PG8_VA(vS, 0));
            PG8_WAIT_V(8); PG8_WAIT_L(0); PG8_BAR; PG8_MMA(1, 0, At, B0); PG8_MMA(1, 1, At, B1); PG8_BAR; PG8_SCHED;
            } else {
            PG8_LDB(B0, 0, 0); PG8_SCHED; PG8_LDA(At, 0, 0); PG8_STAGE(PG8_SA(1, 1), a1 + hstep, voffA);
            PG8_WAIT_L(8); PG8_BAR; PG8_WAIT_L(0); PG8_MMA(0, 0, At, B0); PG8_BAR; PG8_SCHED;
            PG8_LDB(B1, 0, 1); PG8_STAGE(PG8_SB(0, 0), b2, voffB);
            PG8_BAR; PG8_WAIT_L(0); PG8_MMA(0, 1, At, B1); PG8_BAR;
            PG8_LDA(At, 0, 1); PG8_STAGE(PG8_SA(0, 0), a2, voffA);
            PG8_BAR; PG8_WAIT_L(0); PG8_MMA(1, 0, At, B0); PG8_BAR; PG8_SCHED;
            PG8_STAGE(PG8_SB(0, 1), b2 + hstep, voffB);
            PG8_WAIT_V(6); PG8_BAR; PG8_MMA(1, 1, At, B1); PG8_BAR;
            PG8_LDB(B0, 1, 0); PG8_SCHED; PG8_LDA(At, 1, 0); PG8_STAGE(PG8_SA(0, 1), a2 + hstep, voffA);
            PG8_WAIT_L(8); PG8_BAR; PG8_WAIT_L(0); PG8_MMA(0, 0, At, B0); PG8_BAR; PG8_SCHED;
            PG8_LDB(B1, 1, 1); PG8_STAGE(PG8_SB(1, 0), b3, voffB);
            PG8_BAR; PG8_WAIT_L(0); PG8_MMA(0, 1, At, B1); PG8_BAR;
            PG8_LDA(At, 1, 1); PG8_STAGE(PG8_SA(1, 0), a3, voffA);
            PG8_BAR; PG8_WAIT_L(0); PG8_MMA(1, 0, At, B0); PG8_BAR; PG8_SCHED;
            PG8_STAGE(PG8_SB(1, 1), b3 + hstep, voffB);
            PG8_WAIT_V(6); PG8_BAR; PG8_MMA(1, 1, At, B1); PG8_BAR;
            }
        }
        if constexpr (ALIGN_EPI) { if (wr == 0) PG8_BAR; }
        typename Epi::Pre pre; E.preload(pre, has_next ? nxt : cur, wr, wc, fr, fq); __builtin_amdgcn_sched_barrier(0);
        if constexpr (!Epi::AFTER_DRAIN) { E(acc, cur, wr, wc, fr, fq); S.done(cur); }
        if (!has_next) break;
        E.init(acc, pre);
        cur = nxt; cA = nA; cB = nB; ++ui;
        if constexpr (GATHER) { _Pragma("unroll") for (int h_ = 0; h_ < 2; ++h_) _Pragma("unroll") for (int i_ = 0; i_ < 2; ++i_) vC[h_][i_] = vN[h_][i_]; }
        if constexpr (ALIGN_EPI) { if (wr == 1) PG8_BAR; }
    }
    PG8_WAIT_V(0);
    if constexpr (!ALIGN_EPI) { if (wr == 0) PG8_BAR; }
    PG8_BAR;
    if constexpr (Epi::AFTER_DRAIN) { E.fused(acc, cur, wr, wc, fr, fq, lds, wid, lane); S.done(cur); }
#undef PG8_SA
#undef PG8_GDMA
#undef PG8_GREAD
#undef PG8_AH
#undef PG8_VA
#undef PG8_SB
#undef PG8_STAGE
#undef PG8_LDA
#undef PG8_LDB
#undef PG8_MMA
#undef PG8_WAIT_V
#undef PG8_WAIT_L
#undef PG8_BAR
#undef PG8_SCHED
}
}
#ifndef PG8_SP2
#define PG8_SP2 true
#endif
#ifndef PG8_ALIGN
#define PG8_ALIGN true
#endif
#ifndef PROBE_DOUBLE
#define PROBE_DOUBLE 0
#endif
#ifndef MK_N_LAUNCHES
#define MK_N_LAUNCHES 1
#endif

constexpr int NWAVES = 8;
constexpr int BATCH = 4, SEQ = 8192, D = 1024, T = BATCH * SEQ, DEPTH = 4;
constexpr int NEXP = 32, TOPK = 4, FF = 1024;
constexpr int DA_H = 8, RET_H = 4;
constexpr float LN_EPS = 1e-5f;
constexpr float DN_ALPHA = 1.6817928305074290f;
constexpr float LOG2E = 1.4426950408889634f;
constexpr int MT_MAX = T * TOPK / 256 + NEXP;

constexpr size_t MiB = 1u << 20;
constexpr size_t WS_CTL = 0, CTL_ZERO_BYTES = 192 * 1024;
constexpr size_t WS_WIMG = 2 * MiB;
constexpr size_t WS_STATS = 4 * MiB;
constexpr size_t WS_WDAIN = 16 * MiB;
constexpr size_t WS_WDAOUT = 28 * MiB;
constexpr size_t WS_WRETIN = 32 * MiB;
constexpr size_t WS_WRETOUT = 56 * MiB;
constexpr size_t WS_WGU = 64 * MiB;
constexpr size_t WS_WDN = 576 * MiB;
constexpr size_t WS_XB = 832 * MiB;
constexpr size_t WS_Y = 896 * MiB;
constexpr size_t WS_PROJ = 1024 * MiB;
constexpr size_t WS_AO = 1408 * MiB;
constexpr size_t WS_STATE = 1536 * MiB;
constexpr size_t WS_XS = 1792 * MiB;
constexpr size_t WS_ACT = 2064 * MiB;
constexpr size_t WS_YE = 2336 * MiB;
constexpr size_t WS_ROUTE = 2592 * MiB;
constexpr size_t WS_SLOT = 2596 * MiB;
constexpr size_t WS_END = 2608 * MiB;
constexpr int CW_BAR = 4096;
constexpr int CW_CNT = 16384;
constexpr int CW_KMAX = 32768;
constexpr int CW_QCTR = 33280;
constexpr int RING_BYTES = 131072;
constexpr int MISC_OFF = RING_BYTES + 320;
constexpr int TBL_OFF = RING_BYTES + 1024;
constexpr int LDS_BYTES = 147456;

#define GAS __attribute__((address_space(1)))
#define LAS __attribute__((address_space(3)))
typedef unsigned short bf16;
typedef unsigned v4u __attribute__((ext_vector_type(4)));
typedef unsigned v2u __attribute__((ext_vector_type(2)));
typedef float f32x4 __attribute__((ext_vector_type(4)));
typedef float f32x16 __attribute__((ext_vector_type(16)));
typedef short bf16x8 __attribute__((ext_vector_type(8)));
typedef short s16x4 __attribute__((ext_vector_type(4)));
typedef GAS unsigned gu32;
#define RLX_AGENT __ATOMIC_RELAXED, __HIP_MEMORY_SCOPE_AGENT
#define LDS_WAIT() asm volatile("s_waitcnt lgkmcnt(0)" ::: "memory")
#define VM_WAIT() asm volatile("s_waitcnt vmcnt(0)" ::: "memory")
__device__ __forceinline__ unsigned f2bf(float f) { unsigned u = __builtin_bit_cast(unsigned, f); return (u + 0x7fffu + ((u >> 16) & 1u)) >> 16; }
typedef float f32x2_t __attribute__((ext_vector_type(2))); typedef __bf16 bf16x2_t __attribute__((ext_vector_type(2)));
__device__ __forceinline__ unsigned pk2(float lo, float hi) { f32x2_t v = {lo, hi}; bf16x2_t b = __builtin_convertvector(v, bf16x2_t); return __builtin_bit_cast(unsigned, b); }
__device__ __forceinline__ float bf2f(unsigned short h) { return __builtin_bit_cast(float, (unsigned)h << 16); }
__device__ __forceinline__ float bflo(unsigned w) { return __builtin_bit_cast(float, w << 16); }
__device__ __forceinline__ float bfhi(unsigned w) { return __builtin_bit_cast(float, w & 0xffff0000u); }
__device__ __forceinline__ int crow(int r, int hi) { return (r & 3) + 8 * (r >> 2) + 4 * hi; }
typedef short v4i16_t __attribute__((ext_vector_type(4)));
__device__ __forceinline__ s16x4 vtr(LAS const unsigned char* p) { return __builtin_bit_cast(s16x4, __builtin_amdgcn_ds_read_tr16_b64_v4i16((LAS v4i16_t*)p)); }
__device__ __forceinline__ bf16x8 cat8(s16x4 lo, s16x4 hi) { return (bf16x8){lo[0], lo[1], lo[2], lo[3], hi[0], hi[1], hi[2], hi[3]}; }
__device__ __forceinline__ bf16x8 pack8f(float a0, float a1, float a2, float a3, float a4, float a5, float a6, float a7) {
    v4u w; w.x = pk2(a0, a1); w.y = pk2(a2, a3); w.z = pk2(a4, a5); w.w = pk2(a6, a7); return __builtin_bit_cast(bf16x8, w); }
#define XB_TMO      128
#define XB_XCNT(j)  (256  + 64 * (j))
#define XB_XSUB(j)  (1280 + 64 * (j))
#define XB_XGEN(j)  (2304 + 64 * (j))
#define XB_TOP      3328
#define XB_TOPGEN   3392
#define XCD_BAR_WORDS 3456
#define XB_SPIN_CAP (1u << 24)

__device__ __forceinline__ unsigned xb_ld(unsigned* p)              { return __hip_atomic_load(p, __ATOMIC_RELAXED, __HIP_MEMORY_SCOPE_AGENT); }
__device__ __forceinline__ unsigned xb_add(unsigned* p, unsigned v) { return __hip_atomic_fetch_add(p, v, __ATOMIC_RELAXED, __HIP_MEMORY_SCOPE_AGENT); }
__device__ __forceinline__ unsigned xb_xcc_id() { return (unsigned)__builtin_amdgcn_s_getreg((3 << 11) | 20) & 0xFu; }
#define XB_SPIN(cond, bar) do { unsigned _sp = 0; while (cond) { __builtin_amdgcn_s_sleep(1); \
    if ((++_sp & 255u) == 0u) { if (xb_ld(&(bar)[XB_TMO])) break; if (_sp > XB_SPIN_CAP) { atomicAdd(&(bar)[XB_TMO], 1u); break; } } } } while (0)

struct XcdBarrier {
    unsigned* bar; unsigned x;
    volatile LAS unsigned* st;
};

__device__ __forceinline__ XcdBarrier xcd_barrier_post(unsigned* bar, volatile LAS unsigned* st) {
    XcdBarrier b; b.bar = bar; b.x = xb_xcc_id(); b.st = st;
    if (threadIdx.x == 0) (void)xb_add(&bar[XB_XCNT(b.x)], 1u);
    return b;
}
__device__ __forceinline__ void xcd_barrier_complete(unsigned* bar, unsigned x, unsigned& nloc, unsigned& nx) {
    const unsigned G = gridDim.x * gridDim.y * gridDim.z;
    unsigned sum, cnt, mine, sp = 0u;
    for (;;) {
        sum = 0u; cnt = 0u; mine = 0u;
#pragma unroll
        for (unsigned j = 0; j < 16; ++j) { const unsigned c = xb_ld(&bar[XB_XCNT(j)]); sum += c; cnt += (c > 0u) ? 1u : 0u; mine = (j == x) ? c : mine; }
        if (sum == G) break;
        __builtin_amdgcn_s_sleep(1);
        if ((++sp & 255u) == 0u) { if (xb_ld(&bar[XB_TMO])) break; if (sp > XB_SPIN_CAP) { atomicAdd(&bar[XB_TMO], 1u); break; } }
    }
    nloc = mine > 0u ? mine : 1u; nx = cnt > 0u ? cnt : 1u;
}

__device__ __forceinline__ void xcd_barrier(const XcdBarrier& b) {
    asm volatile("s_waitcnt vmcnt(0)" ::: "memory");
    __syncthreads();
    if (threadIdx.x == 0) {
        unsigned* bar = b.bar;
        __builtin_amdgcn_s_waitcnt(0);
        unsigned nloc = b.st[0], nx = b.st[1];
        if (nloc == 0u) { xcd_barrier_complete(bar, b.x, nloc, nx); b.st[0] = nloc; b.st[1] = nx; }
        const unsigned old = xb_add(&bar[XB_XSUB(b.x)], 1u);
        const unsigned gen = old / nloc;
        if (old + 1u == (gen + 1u) * nloc) {
            __builtin_amdgcn_fence(__ATOMIC_RELEASE, "agent");
            asm volatile("s_waitcnt vmcnt(0)" ::: "memory");
            const unsigned og = xb_add(&bar[XB_TOP], 1u);
            const unsigned tg = og / nx;
            if (og + 1u == (tg + 1u) * nx) xb_add(&bar[XB_TOPGEN], 1u);
            else XB_SPIN(xb_ld(&bar[XB_TOPGEN]) == tg, bar);
            __builtin_amdgcn_fence(__ATOMIC_ACQUIRE, "agent");
            xb_add(&bar[XB_XGEN(b.x)], 1u);
            asm volatile("s_waitcnt vmcnt(0)" ::: "memory");
        } else {
            XB_SPIN(xb_ld(&bar[XB_XGEN(b.x)]) == gen, bar);
            __builtin_amdgcn_fence(__ATOMIC_ACQUIRE, "agent");
            asm volatile("s_waitcnt vmcnt(0)" ::: "memory");
        }
    }
    __syncthreads();
}
struct Frame {
    LAS unsigned char* lds;
    volatile LAS unsigned* MISC;
    gu32* ctl;
    int vcu, G;
};

#define LTID() const int tid_ = hw_tid(F.lds), lane_ = tid_ & 63, wave_ = __builtin_amdgcn_readfirstlane(tid_ >> 6); (void)lane_; (void)wave_
template <int MODE>
__device__ __forceinline__ int p0_dest_row(int n0) { return (MODE == 1) ? ((n0 < 1024) ? (256 * (n0 >> 7) + (n0 & 127)) : (256 * ((n0 - 1024) >> 7) + 128 + ((n0 - 1024) & 127))) : n0; }
template <int MODE>
__device__ __forceinline__ void p0_family(Frame& F, const float* W, bf16* WT, int nmat, int K, int N, int wg_rank = -1, int wg_count = 0) { LTID();
    LAS float* scr = (LAS float*)(F.lds + wave_ * 16384);
    const int gw = (wg_rank < 0 ? F.vcu : wg_rank) * NWAVES + wave_, NGW = (wg_rank < 0 ? F.G : wg_count) * NWAVES, lane = lane_;
    const int nblk = N / 32, ipm = (K / 64) * nblk, total = nmat * ipm;
    f32x4 cur[8], nxt[8], nx2[8], nx3[8];
#define P0_LOAD(dst, it_) do { const int mat_ = (it_) / ipm, r_ = (it_) - mat_ * ipm, kb_ = r_ / nblk, nb_ = r_ - kb_ * nblk; \
        const float* src_ = W + (size_t)mat_ * K * N + (size_t)(64 * kb_ + (lane >> 3)) * N + 32 * nb_ + 4 * (lane & 7); \
        _Pragma("unroll") for (int i = 0; i < 8; ++i) dst[i] = __builtin_nontemporal_load((const GAS f32x4*)(src_ + (size_t)(8 * i) * N)); } while (0)
    int it = gw;
    if (it < total) P0_LOAD(cur, it);
    if (it + NGW < total) P0_LOAD(nxt, it + NGW);
    if (it + 2 * NGW < total) P0_LOAD(nx2, it + 2 * NGW);
    for (; it < total; it += NGW) {
        const int itn = it + 3 * NGW;
        if (itn < total) P0_LOAD(nx3, itn);
        const int mat = it / ipm, r = it - mat * ipm, kb = r / nblk, nb = r - kb * nblk, k0 = 64 * kb, r0 = p0_dest_row<MODE>(32 * nb);
#pragma unroll
        for (int i = 0; i < 8; ++i) { LAS float* sw = scr + (8 * i + (lane >> 3)) * 33 + 4 * (lane & 7); sw[0] = cur[i].x; sw[1] = cur[i].y; sw[2] = cur[i].z; sw[3] = cur[i].w; }
        LDS_WAIT(); asm volatile("" ::: "memory");
        const int c = lane & 7; bf16* wt = WT + (size_t)mat * K * N;
#pragma unroll
        for (int j = 0; j < 4; ++j) { const int n = (lane >> 3) + 8 * j; const LAS float* sp = scr + (8 * c) * 33 + n;
            v4u o; o.x = pk2(sp[0 * 33], sp[1 * 33]); o.y = pk2(sp[2 * 33], sp[3 * 33]); o.z = pk2(sp[4 * 33], sp[5 * 33]); o.w = pk2(sp[6 * 33], sp[7 * 33]);
            __builtin_nontemporal_store(o, (GAS v4u*)(wt + (size_t)(r0 + n) * K + k0 + 8 * c)); }
        LDS_WAIT(); asm volatile("" ::: "memory");
#pragma unroll
        for (int i = 0; i < 8; ++i) { cur[i] = nxt[i]; nxt[i] = nx2[i]; nx2[i] = nx3[i]; }
    }
#undef P0_LOAD
}
__device__ __forceinline__ void p0_x_to_bf16(Frame& F, const float* x, bf16* XB) { LTID();
    const int gw = F.vcu * NWAVES + wave_, NGW = F.G * NWAVES;
    for (int m = gw; m < T; m += NGW) {
        const GAS f32x4* xr = (const GAS f32x4*)(x + (size_t)m * D) + lane_; GAS v2u* o = (GAS v2u*)(XB + (size_t)m * D) + lane_;
#pragma unroll
        for (int j = 0; j < 4; ++j) { const f32x4 v = __builtin_nontemporal_load(xr + 64 * j); v2u w; w.x = pk2(v.x, v.y); w.y = pk2(v.z, v.w); o[64 * j] = w; } }
}

__device__ __forceinline__ void ln_apply(f32x4 (&v)[4], const float* g, const float* b, int lane) {
    float s = 0.f, s2 = 0.f;
#pragma unroll
    for (int j = 0; j < 4; ++j) { s += (v[j].x + v[j].y) + (v[j].z + v[j].w); s2 += (v[j].x * v[j].x + v[j].y * v[j].y) + (v[j].z * v[j].z + v[j].w * v[j].w); }
    s = wave_sum(s); s2 = wave_sum(s2);
    const float mean = s * (1.f / D), rstd = 1.f / sqrtf(__builtin_fmaxf(s2 * (1.f / D) - mean * mean, 0.f) + LN_EPS);
#pragma unroll
    for (int j = 0; j < 4; ++j) { const f32x4 gg = *((const GAS f32x4*)g + lane + 64 * j), bb = *((const GAS f32x4*)b + lane + 64 * j); v[j] = (v[j] - mean) * rstd * gg + bb; }
}
__device__ __forceinline__ void store_x(const f32x4 (&v)[4], float* X, bf16* XB, size_t row, int lane) {
    GAS v2u* bo = (GAS v2u*)(XB + row * D) + lane;
#pragma unroll
    for (int j = 0; j < 4; ++j) { v2u w; w.x = pk2(v[j].x, v[j].y); w.y = pk2(v[j].z, v[j].w); bo[64 * j] = w; }
    if (X) { GAS f32x4* xo = (GAS f32x4*)(X + row * D) + lane;
#pragma unroll
        for (int j = 0; j < 4; ++j) __builtin_nontemporal_store(v[j], xo + 64 * j); }
}
__device__ __forceinline__ void p0_router_image(Frame& F, const float* Wr_all, unsigned char* IMG) { LTID();
    const int gt = (F.vcu * NWAVES + wave_) * 64 + lane_;
    if (gt < DEPTH * NEXP * 128) { const int L = gt >> 12, e = (gt >> 7) & 31, c = gt & 127; const float* w = Wr_all + (size_t)L * D * NEXP + (size_t)(8 * c) * NEXP + e;
        float x[8]; v4u hi, lo;
#pragma unroll
        for (int j = 0; j < 8; ++j) x[j] = w[j * NEXP];
#pragma unroll
        for (int j = 0; j < 4; ++j) { hi[j] = pk2(x[2 * j], x[2 * j + 1]); lo[j] = pk2(x[2 * j] - bflo(hi[j]), x[2 * j + 1] - bfhi(hi[j])); }
        unsigned char* dst = IMG + (size_t)L * 131072 + e * 2048 + ((c ^ (e & 15)) * 16);
        *(GAS v4u*)dst = hi; *(GAS v4u*)(dst + 65536) = lo; }
}
__device__ __forceinline__ void ln_router_phase(Frame& F, const bf16* Y, const float* STATS, const float* g, const float* b, const unsigned char* WIMG, const float* br, bf16* XB, int2* SLOT, gu32* cnt) { LTID();
    LAS unsigned char* lds = F.lds;
#pragma unroll 4
    for (int i = 0; i < 16; ++i) { const int idx = tid_ + 512 * i; *(LAS v4u*)(lds + idx * 16) = *(const GAS v4u*)(WIMG + idx * 16); }
    LAS int* lcnt = (LAS int*)(lds + TBL_OFF + 4096);
    typedef int v4i_t __attribute__((ext_vector_type(4)));
    LAS v4i_t* rec = (LAS v4i_t*)(lds + TBL_OFF + 4096 + 256);
    for (int rt = F.vcu; rt < T / 128; rt += F.G) {
        if (tid_ < 32) lcnt[tid_] = 0;
        LDS_WAIT(); __syncthreads();
        int tid = tid_; asm volatile("" : "+v"(tid));
        const int lane = tid & 63, wid = __builtin_amdgcn_readfirstlane(tid >> 6), r = lane & 15, kg = lane >> 4;
        const size_t row = (size_t)rt * 128 + wid * 16 + r;
        const bf16* yr = Y + row * D + kg * 8;
        float s1, s2;
        { const GAS f32x4* sp = (const GAS f32x4*)(STATS + (row * 16 + kg * 4) * 2); const f32x4 a = sp[0], c = sp[1]; s1 = (a.x + a.z) + (c.x + c.z); s2 = (a.y + a.w) + (c.y + c.w); }
        { float t0; float o0 = swap16_other(s1, t0); s1 = t0 + o0; o0 = swap32_other(s1, t0); s1 = t0 + o0; o0 = swap16_other(s2, t0); s2 = t0 + o0; o0 = swap32_other(s2, t0); s2 = t0 + o0; }
        const float mean = s1 * (1.f / D), rstd = 1.f / sqrtf(__builtin_fmaxf(s2 * (1.f / D) - mean * mean, 0.f) + LN_EPS);
        pg8::f32x4 c0 = (pg8::f32x4){0.f, 0.f, 0.f, 0.f}, c1 = c0;
        bf16* xbr = XB + row * D + kg * 8;
        LAS const unsigned char* wb = lds + r * 2048;
        v4u ywn[4];
#pragma unroll
        for (int t = 0; t < 4; ++t) ywn[t] = __builtin_nontemporal_load((const GAS v4u*)(yr + 32 * t));
#pragma unroll
        for (int q = 0; q < 8; ++q) {
            f32x4 ga[4], gb[4], ba[4], bb[4]; v4u ywc[4];
#pragma unroll
            for (int t = 0; t < 4; ++t) { const int s = 4 * q + t; ga[t] = *(const GAS f32x4*)(g + 32 * s + kg * 8); gb[t] = *(const GAS f32x4*)(g + 32 * s + kg * 8 + 4); ba[t] = *(const GAS f32x4*)(b + 32 * s + kg * 8); bb[t] = *(const GAS f32x4*)(b + 32 * s + kg * 8 + 4); ywc[t] = ywn[t]; }
            if (q < 7) {
#pragma unroll
                for (int t = 0; t < 4; ++t) ywn[t] = __builtin_nontemporal_load((const GAS v4u*)(yr + 32 * (4 * q + 4 + t))); }
            __builtin_amdgcn_sched_barrier(0);
#pragma unroll
            for (int t = 0; t < 4; ++t) { const int s = 4 * q + t; const v4u yw = ywc[t];
            const f32x4 ya = (f32x4){bflo(yw[0]), bfhi(yw[0]), bflo(yw[1]), bfhi(yw[1])}, yb = (f32x4){bflo(yw[2]), bfhi(yw[2]), bflo(yw[3]), bfhi(yw[3])};
            const f32x4 xa = (ya - mean) * rstd * ga[t] + ba[t], xb = (yb - mean) * rstd * gb[t] + bb[t];
            v4u hi, lo; hi[0] = pk2(xa.x, xa.y); hi[1] = pk2(xa.z, xa.w); hi[2] = pk2(xb.x, xb.y); hi[3] = pk2(xb.z, xb.w);
            lo[0] = pk2(xa.x - bflo(hi[0]), xa.y - bfhi(hi[0])); lo[1] = pk2(xa.z - bflo(hi[1]), xa.w - bfhi(hi[1])); lo[2] = pk2(xb.x - bflo(hi[2]), xb.y - bfhi(hi[2])); lo[3] = pk2(xb.z - bflo(hi[3]), xb.w - bfhi(hi[3]));
            *(GAS v4u*)(xbr + 32 * s) = hi;
            const int co = ((4 * s + kg) ^ r) * 16;
            const bf16x8 bh0 = *(const LAS bf16x8*)(wb + co), bh1 = *(const LAS bf16x8*)(wb + 32768 + co), bl0 = *(const LAS bf16x8*)(wb + 65536 + co), bl1 = *(const LAS bf16x8*)(wb + 98304 + co);
            const bf16x8 ah = __builtin_bit_cast(bf16x8, hi), al = __builtin_bit_cast(bf16x8, lo);
            c0 = __builtin_amdgcn_mfma_f32_16x16x32_bf16(ah, bh0, c0, 0, 0, 0); c1 = __builtin_amdgcn_mfma_f32_16x16x32_bf16(ah, bh1, c1, 0, 0, 0);
            c0 = __builtin_amdgcn_mfma_f32_16x16x32_bf16(al, bh0, c0, 0, 0, 0); c1 = __builtin_amdgcn_mfma_f32_16x16x32_bf16(al, bh1, c1, 0, 0, 0);
            c0 = __builtin_amdgcn_mfma_f32_16x16x32_bf16(ah, bl0, c0, 0, 0, 0); c1 = __builtin_amdgcn_mfma_f32_16x16x32_bf16(ah, bl1, c1, 0, 0, 0); }
            __builtin_amdgcn_sched_barrier(0);
        }
        const float bi0 = br[r], bi1 = br[16 + r];
#pragma unroll
        for (int rr = 0; rr < 4; ++rr) {
            float v0 = c0[rr] + bi0, v1 = c1[rr] + bi1; int ei[4]; float ev[4];
#pragma unroll
            for (int k = 0; k < 4; ++k) { const float m = row_max16(__builtin_fmaxf(v0, v1));
                const unsigned long long m0 = __ballot(v0 == m), m1 = __ballot(v1 == m);
                const unsigned q0b = (unsigned)(m0 >> (16 * kg)) & 0xffffu, q1b = (unsigned)(m1 >> (16 * kg)) & 0xffffu;
                const int idx = q0b ? (__ffs((int)q0b) - 1) : (16 + __ffs((int)q1b) - 1);
                ev[k] = m; ei[k] = idx;
                if (idx < 16) { if (r == idx) v0 = -INFINITY; } else { if (r == idx - 16) v1 = -INFINITY; } }
            const float p1 = __expf(ev[1] - ev[0]), p2 = __expf(ev[2] - ev[0]), p3 = __expf(ev[3] - ev[0]); const float inv = 1.f / (((1.f + p1) + p2) + p3);
            if (r < 4) { const int me = r == 0 ? ei[0] : r == 1 ? ei[1] : r == 2 ? ei[2] : ei[3]; const float mw = (r == 0 ? 1.f : r == 1 ? p1 : r == 2 ? p2 : p3) * inv;
                const int lr = __hip_atomic_fetch_add(lcnt + me, 1, __ATOMIC_RELAXED, __HIP_MEMORY_SCOPE_WORKGROUP);
                rec[(wid * 16 + 4 * kg + rr) * 4 + r] = (v4i_t){me, lr, __float_as_int(mw), 0}; }
        }
        LDS_WAIT(); __syncthreads();
        if (tid < NEXP) { const int c = lcnt[tid]; lcnt[32 + tid] = c ? (int)__hip_atomic_fetch_add(cnt + tid * 64, (unsigned)c, RLX_AGENT) : 0; }
        LDS_WAIT(); __syncthreads();
        { const v4i_t rc = rec[tid]; typedef int v2i_t __attribute__((ext_vector_type(2)));
          *(GAS v2i_t*)(SLOT + (size_t)rc.x * pg8::GCAP_SLOTS + (lcnt[32 + rc.x] + rc.y)) = (v2i_t){(rt * 128 + (tid >> 2)) * 4 + (tid & 3), rc.z}; }
        LDS_WAIT(); __syncthreads();
    }
}
__device__ __forceinline__ void build_tables(Frame& F, gu32* cnt) { LTID();
    LAS int* tb = (LAS int*)(F.lds + TBL_OFF);
    __syncthreads();
    if (tid_ < NEXP) tb[40 + tid_] = (int)__hip_atomic_load(cnt + tid_ * 64, RLX_AGENT);
    LDS_WAIT(); __syncthreads();
    if (tid_ == 0) { int acc = 0; for (int e = 0; e < NEXP; ++e) { tb[e] = acc; acc += (tb[40 + e] + 255) >> 8; } tb[NEXP] = acc; }
    LDS_WAIT(); __syncthreads();
    for (int pm = tid_; pm < MT_MAX; pm += 512) { int e = 0;
#pragma unroll
        for (int j = 1; j < NEXP; ++j) e += (tb[j] <= pm) ? 1 : 0;
        tb[128 + pm] = e; }
    LDS_WAIT(); __syncthreads();
}
__device__ __forceinline__ void gather_phase(Frame& F, const bf16* XB, const int4* ROUTE, bf16* XS, int2* SLOT) { LTID();
    const LAS int* tb = (const LAS int*)(F.lds + TBL_OFF);
    const int gw = F.vcu * NWAVES + wave_, NGW = F.G * NWAVES, lane = lane_;
    for (int t = gw; t < T; t += NGW) {
        const int4 r = ROUTE[(size_t)t * 4 + (lane & 3)];
        const GAS v4u* src = (const GAS v4u*)(XB + (size_t)t * D); const v4u a = src[lane], c = src[64 + lane];
#pragma unroll
        for (int k = 0; k < 4; ++k) { const int e = __shfl(r.x, k), rk = __shfl(r.y, k), wb = __shfl(r.z, k); const int dest = 256 * tb[e] + rk;
            GAS v4u* dst = (GAS v4u*)(XS + (size_t)dest * D); dst[lane] = a; dst[64 + lane] = c;
            if (lane == 0) SLOT[dest] = make_int2(t * 4 + k, wb); }
    }
}
__device__ __forceinline__ void combine_ln_phase(Frame& F, const bf16* YE, const float* g, const float* b, float* X, bf16* XB) { LTID();
    const int gw = F.vcu * NWAVES + wave_, NGW = F.G * NWAVES, lane = lane_;
    v2u xw[4], yw[4][4];
#define CL_LOAD(r_) do { _Pragma("unroll") for (int j = 0; j < 4; ++j) xw[j] = *((const GAS v2u*)(XB + (size_t)(r_) * D) + lane + 64 * j); \
        _Pragma("unroll") for (int k = 0; k < 4; ++k) { const GAS v2u* yr = (const GAS v2u*)(YE + ((size_t)(r_) * 4 + k) * D) + lane; _Pragma("unroll") for (int j = 0; j < 4; ++j) yw[k][j] = __builtin_nontemporal_load(yr + 64 * j); } } while (0)
    if (gw < T) CL_LOAD(gw);
    for (int row = gw; row < T; row += NGW) {
        f32x4 v[4];
#pragma unroll
        for (int j = 0; j < 4; ++j) { const v2u w = xw[j]; v[j] = (f32x4){bflo(w.x), bfhi(w.x), bflo(w.y), bfhi(w.y)} * DN_ALPHA; }
#pragma unroll
        for (int k = 0; k < 4; ++k) {
#pragma unroll
            for (int j = 0; j < 4; ++j) { const v2u w = yw[k][j]; v[j].x += bflo(w.x); v[j].y += bfhi(w.x); v[j].z += bflo(w.y); v[j].w += bfhi(w.y); } }
        if (row + NGW < T) CL_LOAD(row + NGW);
        __builtin_amdgcn_sched_barrier(0);
        ln_apply(v, g, b, lane);
        store_x(v, X, XB, (size_t)row, lane);
    }
#undef CL_LOAD
}

struct GroupedOrder {
    const LAS int* tb; int NT, GM, G, bx;
    __device__ __forceinline__ bool next(int i, pg8::Unit& u) const {
        const int MT = tb[NEXP]; int pm, pn;
        if (G == 256) { const int x = bx & 7, j = bx >> 3, s = i * 8 + x; pm = s * GM + j / NT; pn = j % NT; }
        else { const int L = i * G + bx; pm = L / NT; pn = L % NT; }
        if (pm >= MT) return false;
        const int e = tb[128 + pm];
        int rows = tb[40 + e] - 256 * (pm - tb[e]); rows = rows > 256 ? 256 : rows;
        u.pm = __builtin_amdgcn_readfirstlane(pm); u.pn = __builtin_amdgcn_readfirstlane(pn); u.pb = __builtin_amdgcn_readfirstlane(e * NT + pn); u.aux = __builtin_amdgcn_readfirstlane(e); u.rows = __builtin_amdgcn_readfirstlane(rows); u.lt = __builtin_amdgcn_readfirstlane(pm - tb[e]);
        return true;
    }
    __device__ __forceinline__ void a_ready(const pg8::Unit&) const {}
    __device__ __forceinline__ void done(const pg8::Unit&) const {}
};

__device__ __forceinline__ void glds16(const void* gsrc, unsigned lds_dst) { unsigned keep;
    asm volatile("s_mov_b32 %0, m0\n\ts_mov_b32 m0, %2\n\ts_nop 0\n\tglobal_load_lds_dwordx4 %1, off\n\ts_mov_b32 m0, %0" : "=&s"(keep) : "v"(gsrc), "s"(lds_dst) : "memory"); }
struct ConvJob { const float* wgu; bf16* wgu_t; const float* wdn; bf16* wdn_t; int nmat; int every; };
__device__ __forceinline__ void da_attn_phase(Frame& F, const bf16* QKV, bf16* AO, float lam, float one_m_li, const float* subg, const unsigned* kmax, gu32* qctr, const ConvJob& cj) { LTID();
    LAS unsigned char* lds = F.lds;
    if (cj.nmat > 0 && (F.vcu % cj.every) == 0) {
        p0_family<1>(F, cj.wgu, cj.wgu_t, cj.nmat, D, 2 * FF, F.vcu / cj.every, (F.G + cj.every - 1) / cj.every);
        p0_family<0>(F, cj.wdn, cj.wdn_t, cj.nmat, FF, D, F.vcu / cj.every, (F.G + cj.every - 1) / cj.every);
        LDS_WAIT(); __syncthreads();
    }
    LAS volatile int* qslot = (LAS volatile int*)(lds + TBL_OFF + 3072);
    LAS float* wred = (LAS float*)(lds + TBL_OFF + 3136);
    if (tid_ == 0) *qslot = (int)__hip_atomic_fetch_add(qctr, 1u, RLX_AGENT);
    LDS_WAIT(); __syncthreads();
    int U = __builtin_amdgcn_readfirstlane(*qslot);
    __syncthreads();
    while (U < 2048) {
        int tid = tid_; asm volatile("" : "+v"(tid));
        const int lane = tid & 63, r32 = lane & 31, hh = lane >> 5, wid = __builtin_amdgcn_readfirstlane(tid >> 6), mp = wid & 1, rg = wid >> 1;
        LAS float* wsf = (LAS float*)(lds + 98304 + wid * 256);
        const int voff = (4 * hh + ((lane & 15) >> 2)) * 64 + ((lane >> 4) & 1) * 32 + (lane & 3) * 8;
        unsigned nxtU = 0u; if (tid == 0) nxtU = __hip_atomic_fetch_add(qctr, 1u, RLX_AGENT);
        const int h = 7 - (U >> 8), qb = 63 - ((U & 255) >> 2), b = U & 3;
        const int q0 = qb * 128, NT = 2 * qb + 2;
        const float sl2 = __builtin_amdgcn_exp2f(-(float)(h + 1)) * LOG2E;
        const size_t rowbase = (size_t)b * SEQ;
        const unsigned* kmp = kmax + ((b * 16 + h * 2 + mp) * 2);
        const float km2 = __builtin_bit_cast(float, __hip_atomic_load(kmp, RLX_AGENT)) + __builtin_bit_cast(float, __hip_atomic_load(kmp + 1, RLX_AGENT));
        bf16x8 qr[4];
        { const bf16* qp = QKV + (rowbase + q0 + rg * 32 + r32) * 3072 + h * 128 + mp * 64 + hh * 8;
#pragma unroll
          for (int d0 = 0; d0 < 4; ++d0) qr[d0] = *(const GAS bf16x8*)(qp + d0 * 16); }
        int t_min = 0; float qkw = 0.f;
        { float qs = 0.f;
#pragma unroll
          for (int d0 = 0; d0 < 4; ++d0)
#pragma unroll
              for (int j = 0; j < 8; ++j) { const float qv = bf2f((unsigned short)qr[d0][j]); qs += qv * qv; }
          qs = xor32_sum(qs); qs = half_max32(qs);
          const float bw = 2.0f * sqrtf(qs * km2) * 1.02f;
          qkw = 0.5f * bw;
          if (lane == 0) wred[wid] = bw;
          LDS_WAIT(); __syncthreads();
          float bm = wred[0];
#pragma unroll
          for (int w8 = 1; w8 < 8; ++w8) bm = __builtin_fmaxf(bm, wred[w8]);
          const float Wk = (bm + 38.0f) / sl2, xx = ((float)q0 - Wk - 63.0f) * (1.0f / 64.0f);
          t_min = (xx > 0.f) ? (int)ceilf(xx) : 0; t_min = __builtin_amdgcn_readfirstlane(t_min); }
        int NIT = NT - t_min;
        const bf16* kg0 = QKV + (rowbase + lane) * 3072 + 1024 + h * 128 + wid * 8;
        const bf16* vg0 = QKV + (rowbase + 16 * (wid & 3) + (lane >> 2)) * 3072 + 2048 + h * 128 + (wid >> 2) * 32 + (lane & 3) * 8;
        const unsigned ldsb = (unsigned)(uintptr_t)lds, kd0 = ldsb + wid * 1024, vd0 = ldsb + 49152 + (wid >> 2) * 4096 + (wid & 3) * 1024;
#define DMA_K(it_, ks) do { const size_t to_ = (size_t)(NT - 1 - (it_)) * 64 * 3072; const unsigned sb_ = (unsigned)(ks) * 16384u; \
        glds16(kg0 + to_, (unsigned)__builtin_amdgcn_readfirstlane(kd0 + sb_)); glds16(kg0 + to_ + 64, (unsigned)__builtin_amdgcn_readfirstlane(kd0 + sb_ + 8192)); } while (0)
#define DMA_V(it_, vs) do { const size_t to_ = (size_t)(NT - 1 - (it_)) * 64 * 3072; const unsigned sb_ = (unsigned)(vs) * 16384u; \
        glds16(vg0 + to_, (unsigned)__builtin_amdgcn_readfirstlane(vd0 + sb_)); glds16(vg0 + to_ + 64, (unsigned)__builtin_amdgcn_readfirstlane(vd0 + sb_ + 8192)); } while (0)
#define DA_QK(P0, P1, it_, ks) do { const int t_ = NT - 1 - (it_), krel0_ = 64 * t_ - q0; const float cb0_ = sl2 * (float)krel0_ + hb - m_ref; LAS const unsigned char* Kb_ = lds + (ks) * 16384; \
        _Pragma("unroll") for (int i = 0; i < 16; ++i) { P0[i] = cb0_ + sl2 * (float)((i & 3) + 8 * (i >> 2)); P1[i] = cb0_ + sl2 * (float)(32 + (i & 3) + 8 * (i >> 2)); } \
        _Pragma("unroll") for (int d0 = 0; d0 < 4; ++d0) { \
            const bf16x8 a0 = *(const LAS bf16x8*)(Kb_ + (mp * 8 + 2 * d0 + hh) * 1024 + r32 * 16), a1 = *(const LAS bf16x8*)(Kb_ + (mp * 8 + 2 * d0 + hh) * 1024 + 512 + r32 * 16); \
            P0 = __builtin_amdgcn_mfma_f32_32x32x16_bf16(a0, qr[d0], P0, 0, 0, 0); P1 = __builtin_amdgcn_mfma_f32_32x32x16_bf16(a1, qr[d0], P1, 0, 0, 0); } \
        if ((it_) < 2) { const int qrel = rg * 32 + r32; \
            _Pragma("unroll") for (int i = 0; i < 16; ++i) { const int kr = krel0_ + crow(i, hh); if (kr > qrel) P0[i] = -INFINITY; if (kr + 32 > qrel) P1[i] = -INFINITY; } } } while (0)
        float tmax = -INFINITY;
        float m_ref = -qkw, l_run = 0.f; f32x16 o[4];
#pragma unroll
        for (int eb = 0; eb < 4; ++eb) o[eb] = (f32x16){0.f, 0.f, 0.f, 0.f, 0.f, 0.f, 0.f, 0.f, 0.f, 0.f, 0.f, 0.f, 0.f, 0.f, 0.f, 0.f};
        const float hb = sl2 * (float)(4 * hh);
        DMA_K(0, 0); DMA_K(1, 1); DMA_V(0, 0);
        if (NIT > 2) { DMA_K(2, 2); DMA_V(1, 1); asm volatile("s_waitcnt vmcnt(8)\n\ts_barrier" ::: "memory"); }
        else { DMA_V(1, 1); asm volatile("s_waitcnt vmcnt(6)\n\ts_barrier" ::: "memory"); }
        f32x16 p0, p1, n0, n1;
        DA_QK(p0, p1, 0, 0);
        n0 = p0; n1 = p1;
        int s3 = 0;
#define DA_MAX3(a, b, c) ({ float r_; asm("v_max3_f32 %0, %1, %2, %3" : "=v"(r_) : "v"(a), "v"(b), "v"(c)); r_; })
#define DA_ITER(P0, P1, N0, N1, it_) do { \
              \
            if ((it_) + 2 < NIT) asm volatile("s_waitcnt vmcnt(4) lgkmcnt(0)\n\ts_barrier" ::: "memory"); \
            else if ((it_) + 1 < NIT) asm volatile("s_waitcnt vmcnt(2) lgkmcnt(0)\n\ts_barrier" ::: "memory"); \
            else asm volatile("s_waitcnt vmcnt(0) lgkmcnt(0)\n\ts_barrier" ::: "memory"); \
            if ((it_) == 2 && NIT > 3) {                           \
                float xm = wred[8]; _Pragma("unroll") for (int w8 = 1; w8 < 8; ++w8) xm = __builtin_fminf(xm, wred[8 + w8]); \
                const int tdrop = (int)floorf(xm * (1.0f / 64.0f)); int nit2 = NT - (tdrop + 1); nit2 = nit2 < 4 ? 4 : nit2; nit2 = __builtin_amdgcn_readfirstlane(nit2); \
                if (nit2 < NIT) NIT = nit2; } \
            const int s3n = (s3 == 2) ? 0 : s3 + 1, s3p = (s3 == 0) ? 2 : s3 - 1; \
            if ((it_) + 3 < NIT) DMA_K((it_) + 3, s3); \
            if ((it_) + 2 < NIT) DMA_V((it_) + 2, s3p); \
            if ((it_) + 1 < NIT) DA_QK(N0, N1, (it_) + 1, s3n); \
            __builtin_amdgcn_sched_barrier(0); \
            float mx = DA_MAX3(P0[0], P1[0], P0[1]); mx = DA_MAX3(mx, P1[1], P0[2]); mx = DA_MAX3(mx, P1[2], P0[3]); mx = DA_MAX3(mx, P1[3], P0[4]); \
            float my = DA_MAX3(P1[4], P0[5], P1[5]); my = DA_MAX3(my, P0[6], P1[6]); my = DA_MAX3(my, P0[7], P1[7]); my = DA_MAX3(my, P0[8], P1[8]); \
            mx = DA_MAX3(mx, P0[9], P1[9]); mx = DA_MAX3(mx, P0[10], P1[10]); mx = DA_MAX3(mx, P0[11], P1[11]); mx = DA_MAX3(mx, P0[12], P1[12]); \
            my = DA_MAX3(my, P0[13], P1[13]); my = DA_MAX3(my, P0[14], P1[14]); my = DA_MAX3(my, P0[15], P1[15]); mx = DA_MAX3(mx, my, my); \
            { float sf_; const float ot_ = swap32_other(mx, sf_); mx = DA_MAX3(sf_, ot_, ot_); } \
            tmax = __builtin_fmaxf(tmax, mx + m_ref);              \
            if (__any(mx > 8.0f)) {                                \
                const float dlt = (mx > 0.f) ? mx : 0.f; m_ref += dlt; \
                _Pragma("unroll") for (int i = 0; i < 16; ++i) { P0[i] -= dlt; P1[i] -= dlt; N0[i] -= dlt; N1[i] -= dlt; } \
                const float f = __builtin_amdgcn_exp2f(-dlt); l_run *= f; \
                if (hh == 0) wsf[r32] = f; \
                LDS_WAIT(); \
                _Pragma("unroll") for (int i = 0; i < 16; ++i) { const float af = wsf[crow(i, hh)]; \
                    _Pragma("unroll") for (int eb = 0; eb < 4; ++eb) o[eb][i] *= af; } \
            } \
            float rs0 = 0.f, rs1 = 0.f; \
            _Pragma("unroll") for (int i = 0; i < 16; ++i) { P0[i] = __builtin_amdgcn_exp2f(P0[i]); P1[i] = __builtin_amdgcn_exp2f(P1[i]); rs0 += P0[i]; rs1 += P1[i]; } \
            l_run += rs0 + rs1; \
            bf16x8 pa[4]; \
            pa[0] = pack8f(P0[0], P0[1], P0[2], P0[3], P0[4], P0[5], P0[6], P0[7]); pa[1] = pack8f(P0[8], P0[9], P0[10], P0[11], P0[12], P0[13], P0[14], P0[15]); \
            pa[2] = pack8f(P1[0], P1[1], P1[2], P1[3], P1[4], P1[5], P1[6], P1[7]); pa[3] = pack8f(P1[8], P1[9], P1[10], P1[11], P1[12], P1[13], P1[14], P1[15]); \
            LAS const unsigned char* Vb = lds + 49152 + s3 * 16384; \
              \
            _Pragma("unroll") for (int ks = 0; ks < 4; ++ks) { bf16x8 vf[4]; \
                _Pragma("unroll") for (int eb = 0; eb < 4; ++eb) vf[eb] = cat8(vtr(Vb + eb * 4096 + ks * 1024 + voff), vtr(Vb + eb * 4096 + ks * 1024 + 512 + voff)); \
                __builtin_amdgcn_sched_barrier(0); \
                _Pragma("unroll") for (int eb = 0; eb < 4; ++eb) o[eb] = __builtin_amdgcn_mfma_f32_32x32x16_bf16(pa[ks], vf[eb], o[eb], 0, 0, 0); \
                __builtin_amdgcn_sched_barrier(0); } \
            if ((it_) == 1) { float tm = tmax; tm = -half_max32(-tm); tm = -xor32_max(-tm);                   \
                if (lane == 0) wred[8 + wid] = (tm - qkw - 38.0f) / sl2 + (float)q0 - 63.0f; }                  \
            s3 = s3n; } while (0)
        int it = 0;
        for (; it + 1 < NIT; it += 2) { DA_ITER(p0, p1, n0, n1, it); DA_ITER(n0, n1, p0, p1, it + 1); }
        if (it < NIT) DA_ITER(p0, p1, n0, n1, it);
#undef DA_ITER
#undef DA_MAX3
#undef DMA_K
#undef DMA_V
#undef DA_QK
        asm volatile("s_waitcnt vmcnt(0)" ::: "memory");
        LDS_WAIT(); __syncthreads();
        const float l_tot = xor32_sum(l_run);
        if (hh == 0) wsf[r32] = 1.f / l_tot;
        LDS_WAIT();
        float rinv[16];
#pragma unroll
        for (int i = 0; i < 16; ++i) rinv[i] = wsf[crow(i, hh)];
        LAS float* comb = (LAS float*)lds + rg * 4096;
        if (mp == 1) {
#pragma unroll
            for (int eb = 0; eb < 4; ++eb)
#pragma unroll
                for (int i = 0; i < 16; ++i) comb[crow(i, hh) * 128 + eb * 32 + r32] = o[eb][i] * rinv[i];
        }
        LDS_WAIT(); __syncthreads();
        if (mp == 0) {
            float ss[16];
#pragma unroll
            for (int i = 0; i < 16; ++i) { float s = 0.f;
#pragma unroll
                for (int eb = 0; eb < 4; ++eb) { const float dlt = o[eb][i] * rinv[i] - lam * comb[crow(i, hh) * 128 + eb * 32 + r32]; o[eb][i] = dlt; s += dlt * dlt; }
                ss[i] = half_sum32(s); }
            float gsc[4];
#pragma unroll
            for (int eb = 0; eb < 4; ++eb) gsc[eb] = subg[eb * 32 + r32] * one_m_li;
#pragma unroll
            for (int i = 0; i < 16; ++i) { const float rr = 1.f / sqrtf(ss[i] * (1.f / 128.f) + LN_EPS);
                LAS bf16* tp = (LAS bf16*)(lds + 65536) + (rg * 32 + crow(i, hh)) * 128 + r32;
#pragma unroll
                for (int eb = 0; eb < 4; ++eb) tp[eb * 32] = (bf16)pk2(o[eb][i] * rr * gsc[eb], 0.f); }
        }
        if (tid == 0) *qslot = (int)nxtU;
        LDS_WAIT(); __syncthreads();
        U = __builtin_amdgcn_readfirstlane(*qslot);
#pragma unroll
        for (int k = 0; k < 4; ++k) { const int idx = tid + 512 * k, row = idx >> 4, c16 = idx & 15;
            *(GAS v4u*)(AO + (rowbase + q0 + row) * 1024 + h * 128 + c16 * 8) = *(const LAS v4u*)(lds + 65536 + idx * 16); }
        LDS_WAIT(); __syncthreads();
    }
}

__device__ __forceinline__ void ret_scan_phase(Frame& F, const bf16* PROJ, bf16* ST, const float (&lg2)[4]) { LTID();
    LAS unsigned char* lds = F.lds;
    for (int L = F.vcu; L < 256; L += F.G) {
        int tid = tid_; asm volatile("" : "+v"(tid));
        const int lane = tid & 63, r32 = lane & 31, hh = lane >> 5, wid = __builtin_amdgcn_readfirstlane(tid >> 6);
        const int voff = (4 * hh + ((lane & 15) >> 2)) * 64 + ((lane >> 4) & 1) * 32 + (lane & 3) * 8;
        const int bh = L >> 4, dkh = (L >> 3) & 1, e8 = L & 7, h = bh & 3;
        const float lgh = h == 0 ? lg2[0] : h == 1 ? lg2[1] : h == 2 ? lg2[2] : lg2[3];
        const float gC = __builtin_amdgcn_exp2f(128.f * lgh);
        const int trow = lane >> 2, chl = lane & 3;
        const bf16* ksrc0 = PROJ + (size_t)T * 1024 + ((size_t)bh * SEQ + 16 * ((2 * wid) & 3) + trow) * 256 + dkh * 128 + ((2 * wid) >> 2) * 32 + chl * 8;
        const bf16* ksrc1 = PROJ + (size_t)T * 1024 + ((size_t)bh * SEQ + 16 * ((2 * wid + 1) & 3) + trow) * 256 + dkh * 128 + ((2 * wid + 1) >> 2) * 32 + chl * 8;
        const bf16* vsrc = PROJ + (size_t)2 * T * 1024 + ((size_t)bh * SEQ + 16 * (wid & 3) + trow) * 512 + e8 * 64 + (wid >> 2) * 32 + chl * 8;
        const unsigned ldsb = (unsigned)(uintptr_t)lds;
#define RS_DMA(m, slot) do { const size_t mk_ = (size_t)(m) * 64 * 256, mv_ = (size_t)(m) * 64 * 512; const unsigned sb_ = ldsb + (unsigned)(slot) * 24576u; \
        glds16(ksrc0 + mk_, (unsigned)__builtin_amdgcn_readfirstlane(sb_ + (2 * wid) * 1024)); glds16(ksrc1 + mk_, (unsigned)__builtin_amdgcn_readfirstlane(sb_ + (2 * wid + 1) * 1024)); \
        glds16(vsrc + mv_, (unsigned)__builtin_amdgcn_readfirstlane(sb_ + 16384 + wid * 1024)); } while (0)
        f32x16 st = (f32x16){0.f, 0.f, 0.f, 0.f, 0.f, 0.f, 0.f, 0.f, 0.f, 0.f, 0.f, 0.f, 0.f, 0.f, 0.f, 0.f};
        const int el = (wid >> 2) * 32 + r32;
        bf16* stg = ST + ((size_t)bh * 64 * 512 + e8 * 64) * 256 + dkh * 128;
        RS_DMA(0, 0); RS_DMA(1, 1); RS_DMA(2, 2);
#pragma unroll 1
        for (int m = 0; m < 128; ++m) {
            const int slot = m & 3, n = m >> 1;
            if (m >= 3 && m + 2 < 128) asm volatile("s_waitcnt vmcnt(8) lgkmcnt(0)\n\ts_barrier" ::: "memory");
            else if (m + 2 < 128) asm volatile("s_waitcnt vmcnt(6) lgkmcnt(0)\n\ts_barrier" ::: "memory");
            else if (m + 1 < 128) asm volatile("s_waitcnt vmcnt(3) lgkmcnt(0)\n\ts_barrier" ::: "memory");
            else asm volatile("s_waitcnt vmcnt(0) lgkmcnt(0)\n\ts_barrier" ::: "memory");
            if (m + 3 < 128) RS_DMA(m + 3, (m + 3) & 3);
            if ((m & 1) == 0) {
                const int bf = n & 1;
                if (n > 0) {
#pragma unroll
                    for (int k2 = 0; k2 < 2; ++k2) { const int p = tid + 512 * k2, e = p >> 4, c = (p & 15) ^ (e & 15);
                        *(GAS v4u*)(stg + ((size_t)(n - 1) * 512 + e) * 256 + c * 8) = *(const LAS v4u*)(lds + 98304 + (bf ^ 1) * 16384 + p * 16); } }
#pragma unroll
                for (int g4 = 0; g4 < 4; ++g4) { v2u w; w.x = pk2(st[4 * g4], st[4 * g4 + 1]); w.y = pk2(st[4 * g4 + 2], st[4 * g4 + 3]);
                    *(LAS v2u*)(lds + 98304 + bf * 16384 + el * 256 + ((((wid & 3) * 4 + g4) ^ (el & 15)) * 16) + hh * 8) = w; }
            }
            LAS const unsigned char* kb = lds + slot * 24576 + (wid & 3) * 4096; LAS const unsigned char* vb = lds + slot * 24576 + 16384 + (wid >> 2) * 4096;
#pragma unroll
            for (int s = 0; s < 4; ++s) { const bf16x8 a = cat8(vtr(kb + s * 1024 + voff), vtr(kb + s * 1024 + 512 + voff)), bb = cat8(vtr(vb + s * 1024 + voff), vtr(vb + s * 1024 + 512 + voff));
                st = __builtin_amdgcn_mfma_f32_32x32x16_bf16(a, bb, st, 0, 0, 0); }
            if (m & 1) {
#pragma unroll
                for (int i = 0; i < 16; ++i) st[i] *= gC; }
        }
#undef RS_DMA
        asm volatile("s_waitcnt vmcnt(0) lgkmcnt(0)\n\ts_barrier" ::: "memory");
#pragma unroll
        for (int k2 = 0; k2 < 2; ++k2) { const int p = tid + 512 * k2, e = p >> 4, c = (p & 15) ^ (e & 15);
            *(GAS v4u*)(stg + ((size_t)63 * 512 + e) * 256 + c * 8) = *(const LAS v4u*)(lds + 98304 + 16384 + p * 16); }
        LDS_WAIT(); __syncthreads();
    }
}
__device__ __forceinline__ void ret_main_phase(Frame& F, const bf16* PROJ, const bf16* ST, bf16* AO) { LTID();
    LAS unsigned char* lds = F.lds;
    LAS float* part = (LAS float*)(lds + TBL_OFF + 512);
    for (int L = F.vcu * 4; L < 1024; L += F.G * 4) for (int uu = 0; uu < 4; ++uu) {
        int tid = tid_; asm volatile("" : "+v"(tid));
        const int lane = tid & 63, r32 = lane & 31, hh = lane >> 5, wid = __builtin_amdgcn_readfirstlane(tid >> 6), rg = wid & 3, e2 = wid >> 2;
        const int voff = (4 * hh + ((lane & 15) >> 2)) * 64 + ((lane >> 4) & 1) * 32 + (lane & 3) * 8;
        const int U = L + uu, bh = U >> 6, n = U & 63, b = bh >> 2, h = bh & 3;
        const size_t tokbase = (size_t)b * SEQ + (size_t)n * 128, hb0 = (size_t)bh * SEQ + (size_t)n * 128;
        const bf16* qrow = PROJ + (hb0 + rg * 32 + r32) * 256 + 8 * hh;
        const bf16* stb = ST + ((size_t)bh * 64 + n) * 512 * 256;
        const unsigned ldsb = (unsigned)(uintptr_t)lds + wid * 1024;
#define RM_WAITBAR() asm volatile("s_waitcnt vmcnt(0) lgkmcnt(0)\n\ts_barrier" ::: "memory")
#define RM_DMA_KS(buf) do { _Pragma("unroll") for (int i = 0; i < 8; ++i) { const int idx = tid + 512 * i, tok = idx >> 5, c = (idx & 31) ^ (tok & 31); \
        glds16(PROJ + (size_t)T * 1024 + (hb0 + tok) * 256 + c * 8, (unsigned)__builtin_amdgcn_readfirstlane(ldsb + (buf) * 65536 + i * 8192)); } } while (0)
#define RM_DMA_V(p, buf) do { _Pragma("unroll") for (int i = 0; i < 8; ++i) { const int idx = tid + 512 * i, tok = (idx >> 2) & 127; \
        glds16(PROJ + (size_t)2 * T * 1024 + (hb0 + tok) * 512 + (p) * 256 + (idx >> 9) * 32 + (idx & 3) * 8, (unsigned)__builtin_amdgcn_readfirstlane(ldsb + (buf) * 65536 + i * 8192)); } } while (0)
#define RM_DMA_ST(p, dkh, buf) do { _Pragma("unroll") for (int i = 0; i < 8; ++i) { const int idx = tid + 512 * i, e = idx >> 4, c = (idx & 15) ^ (e & 15); \
        glds16(stb + (size_t)((p) * 256 + e) * 256 + (dkh) * 128 + c * 8, (unsigned)__builtin_amdgcn_readfirstlane(ldsb + (buf) * 65536 + i * 8192)); } } while (0)
        RM_DMA_KS(0);
        bf16x8 pa[4][2];
        {
            bf16x8 qf[16];
#pragma unroll
            for (int s = 0; s < 16; ++s) qf[s] = *(const GAS bf16x8*)(qrow + 16 * s);
            RM_WAITBAR();
            asm volatile("" :: "v"(qf[0]), "v"(qf[1]), "v"(qf[2]), "v"(qf[3]), "v"(qf[4]), "v"(qf[5]), "v"(qf[6]), "v"(qf[7]), "v"(qf[8]), "v"(qf[9]), "v"(qf[10]), "v"(qf[11]), "v"(qf[12]), "v"(qf[13]), "v"(qf[14]), "v"(qf[15]));
            RM_DMA_V(0, 1);
#pragma unroll
            for (int jb = 0; jb < 4; ++jb) {
                f32x16 S = (f32x16){0.f, 0.f, 0.f, 0.f, 0.f, 0.f, 0.f, 0.f, 0.f, 0.f, 0.f, 0.f, 0.f, 0.f, 0.f, 0.f};
                if (jb <= rg) {
#pragma unroll
                    for (int s = 0; s < 16; ++s) { const bf16x8 a = *(const LAS bf16x8*)(lds + (32 * jb + r32) * 512 + (((2 * s + hh) ^ r32) * 16)); S = __builtin_amdgcn_mfma_f32_32x32x16_bf16(a, qf[s], S, 0, 0, 0); }
                    if (jb == rg) {
#pragma unroll
                        for (int i = 0; i < 16; ++i) if (crow(i, hh) > r32) S[i] = 0.f; }
                }
                pa[jb][0] = pack8f(S[0], S[1], S[2], S[3], S[4], S[5], S[6], S[7]); pa[jb][1] = pack8f(S[8], S[9], S[10], S[11], S[12], S[13], S[14], S[15]);
            }
        }
        f32x16 o[8];
#pragma unroll
        for (int eb = 0; eb < 8; ++eb) o[eb] = (f32x16){0.f, 0.f, 0.f, 0.f, 0.f, 0.f, 0.f, 0.f, 0.f, 0.f, 0.f, 0.f, 0.f, 0.f, 0.f, 0.f};
#define RM_PV(BUF, OB) do { _Pragma("unroll") for (int jb = 0; jb < 4; ++jb) if (jb <= rg) { _Pragma("unroll") for (int s2 = 0; s2 < 2; ++s2) { \
            _Pragma("unroll") for (int j = 0; j < 4; ++j) { LAS const unsigned char* vb = lds + (BUF) * 65536 + (e2 * 4 + j) * 8192 + (32 * jb + 16 * s2) * 64 + voff; \
                o[(OB) + j] = __builtin_amdgcn_mfma_f32_32x32x16_bf16(pa[jb][s2], cat8(vtr(vb), vtr(vb + 512)), o[(OB) + j], 0, 0, 0); } \
            __builtin_amdgcn_sched_barrier(0); } } } while (0)
#define RM_QA(DKH) do { _Pragma("unroll") for (int sl = 0; sl < 8; ++sl) qa[sl] = *(const GAS bf16x8*)(qrow + 16 * ((DKH) * 8 + sl)); } while (0)
#define RM_QA_USE() asm volatile("" :: "v"(qa[0]), "v"(qa[1]), "v"(qa[2]), "v"(qa[3]), "v"(qa[4]), "v"(qa[5]), "v"(qa[6]), "v"(qa[7]))
#define RM_CROSS(BUF, OB) do { \
            _Pragma("unroll") for (int sl = 0; sl < 8; ++sl) { \
                _Pragma("unroll") for (int j = 0; j < 4; ++j) { const bf16x8 bb = *(const LAS bf16x8*)(lds + (BUF) * 65536 + ((e2 * 4 + j) * 32 + r32) * 256 + (((2 * sl + hh) ^ (r32 & 15)) * 16)); \
                    o[(OB) + j] = __builtin_amdgcn_mfma_f32_32x32x16_bf16(qa[sl], bb, o[(OB) + j], 0, 0, 0); } \
                __builtin_amdgcn_sched_barrier(0); } } while (0)
        bf16x8 qa[8];
        RM_WAITBAR(); RM_DMA_V(1, 0);      RM_PV(1, 0);
        RM_WAITBAR(); RM_DMA_ST(0, 0, 1);  RM_PV(0, 4);
        RM_QA(0); RM_WAITBAR(); RM_QA_USE(); RM_DMA_ST(0, 1, 0);  RM_CROSS(1, 0);
        RM_QA(1); RM_WAITBAR(); RM_QA_USE(); RM_DMA_ST(1, 0, 1);  RM_CROSS(0, 0);
        RM_QA(0); RM_WAITBAR(); RM_QA_USE(); RM_DMA_ST(1, 1, 0);  RM_CROSS(1, 4);
        RM_QA(1); RM_WAITBAR(); RM_QA_USE();                      RM_CROSS(0, 4);
#undef RM_QA
#undef RM_QA_USE
#undef RM_DMA_KS
#undef RM_DMA_V
#undef RM_DMA_ST
#undef RM_PV
#undef RM_CROSS
#pragma unroll
        for (int i = 0; i < 16; ++i) { float s1 = 0.f, s2 = 0.f;
#pragma unroll
            for (int eb = 0; eb < 8; ++eb) { s1 += o[eb][i]; s2 += o[eb][i] * o[eb][i]; }
            s1 = half_sum32(s1); s2 = half_sum32(s2);
            if (r32 == 0) { part[(e2 * 128 + rg * 32 + crow(i, hh)) * 2] = s1; part[(e2 * 128 + rg * 32 + crow(i, hh)) * 2 + 1] = s2; } }
        asm volatile("s_waitcnt lgkmcnt(0)\n\ts_barrier" ::: "memory");
#undef RM_WAITBAR
#pragma unroll
        for (int i = 0; i < 16; ++i) { const int rl = rg * 32 + crow(i, hh);
            const float s1 = part[rl * 2] + part[(128 + rl) * 2], s2 = part[rl * 2 + 1] + part[(128 + rl) * 2 + 1];
            const float mean = s1 * (1.f / 512.f), var = __builtin_fmaxf(s2 * (1.f / 512.f) - mean * mean, 0.f), rstd = 1.f / sqrtf(var + LN_EPS);
            LAS bf16* tp = (LAS bf16*)(lds + rl * 1024) + e2 * 128 + r32;
#pragma unroll
            for (int eb = 0; eb < 8; ++eb) tp[(eb >> 2) * 256 + (eb & 3) * 32] = (bf16)pk2((o[eb][i] - mean) * rstd, 0.f); }
        v4u gv[16];
#pragma unroll
        for (int k = 0; k < 16; ++k) { const int p = tid + 512 * k, row = p >> 6, c16 = p & 63; gv[k] = __builtin_nontemporal_load((const GAS v4u*)(PROJ + (size_t)4 * T * 1024 + (hb0 + row) * 512 + c16 * 8)); }
        __builtin_amdgcn_sched_barrier(0);
        LDS_WAIT(); __syncthreads();
#pragma unroll
        for (int k = 0; k < 16; ++k) { const int p = tid + 512 * k, row = p >> 6, c16 = p & 63;
            const v4u ov = *(const LAS v4u*)(lds + p * 16); v4u r;
#pragma unroll
            for (int q = 0; q < 4; ++q) { const float g0 = bflo(gv[k][q]), g1 = bfhi(gv[k][q]);
                const float s0 = g0 * __builtin_amdgcn_rcpf(1.0f + __builtin_amdgcn_exp2f(-g0 * LOG2E)), s1 = g1 * __builtin_amdgcn_rcpf(1.0f + __builtin_amdgcn_exp2f(-g1 * LOG2E));
                r[q] = pk2(bflo(ov[q]) * s0, bfhi(ov[q]) * s1); }
            *(GAS v4u*)(AO + (tokbase + row) * 2048 + h * 512 + c16 * 8) = r; }
        LDS_WAIT(); __syncthreads();
    }
}
struct Args { const float* in[20]; float* out; unsigned char* ws; int ph_lo, ph_hi; };
constexpr int N_PHASES = 1 + 2 * (3 + 4) + 2 * (4 + 4);

__global__ void __launch_bounds__(NWAVES * 64, 2) mega_fwd(Args args) {
    extern __shared__ __attribute__((aligned(16))) unsigned char lds[];
    Frame F;
    F.lds = (LAS unsigned char*)lds;
    F.MISC = (volatile LAS unsigned*)(F.lds + MISC_OFF);
    F.G = gridDim.x; { const int bx = blockIdx.x; F.vcu = (F.G % 8 == 0) ? (bx % 8) * (F.G / 8) + bx / 8 : bx; }
    F.ctl = (gu32*)(args.ws + WS_CTL);
    for (int u = threadIdx.x; u < (LDS_BYTES - RING_BYTES) / 4; u += NWAVES * 64) ((LAS unsigned*)(F.lds + RING_BYTES))[u] = 0u;
    __syncthreads();
    if ((threadIdx.x & 63) == 0) *(LAS int*)(F.lds + WAVETBL_OFF + ((int)__builtin_amdgcn_s_getreg((5 << 11) | 4) & 63) * 4) = (int)(threadIdx.x >> 6);
    __syncthreads();
    XcdBarrier bar = xcd_barrier_post((unsigned*)(F.ctl + CW_BAR), F.MISC + 8);

    typedef __attribute__((address_space(4))) const unsigned char* kptr_t;
#define KP() kptr_t kp_ = (kptr_t)__builtin_amdgcn_kernarg_segment_ptr(); asm volatile("" : "+s"(kp_))
#define IN_(i) ((const float*)(*(const GAS float* __attribute__((address_space(4))) const*)(kp_ + 8 * (i))))
#define OUT_() ((float*)(*(GAS float* __attribute__((address_space(4))) const*)(kp_ + 160)))
#define WS_(off) ((unsigned char*)(*(GAS unsigned char* __attribute__((address_space(4))) const*)(kp_ + 168)) + (off))
    const int lo = args.ph_lo, hi = args.ph_hi;
    int ph = 0;
#define RUN() (lo <= ph && ph < hi)
#define REP(k) for (int rep_ = 0; rep_ < ((PROBE_DOUBLE == (k)) ? 2 : 1); ++rep_)
#define SEAM() do { for (int sr_ = 0; sr_ < ((PROBE_DOUBLE == 10) ? 2 : 1); ++sr_) if (ph + 1 < hi) { XcdBarrier b_ = bar; asm volatile("" : "+s"(b_.bar), "+s"(b_.x)); b_.bar = (unsigned*)(GAS unsigned*)b_.bar; xcd_barrier(b_); } } while (0)

    if (RUN()) {
        REP(1) { KP();
        p0_family<0>(F, IN_(1), (bf16*)WS_(WS_WDAIN), 2, D, 3072);
        p0_family<0>(F, IN_(2), (bf16*)WS_(WS_WDAOUT), 2, D, D);
        p0_family<0>(F, IN_(8), (bf16*)WS_(WS_WRETIN), 2, D, 6144);
        p0_family<0>(F, IN_(9), (bf16*)WS_(WS_WRETOUT), 2, 2048, D);
        p0_router_image(F, IN_(10), WS_(WS_WIMG));
        p0_x_to_bf16(F, IN_(0), (bf16*)WS_(WS_XB)); }
        SEAM();
    }
    ++ph;

#pragma unroll 1
    for (int layer = 0; layer < DEPTH; ++layer) {
        const int jm = layer >> 1;
        if ((layer & 1) == 0) {
            if (RUN()) {
                KP(); pg8::Gemm g{(bf16*)WS_(WS_XB), (bf16*)WS_(WS_WDAIN) + (size_t)jm * 3072 * D, T, 3072, D}; pg8::StaticOrder S; S.init(T, 3072, F.G, (int)blockIdx.x);
                pg8::EpiScaleBf16 E{(bf16*)WS_(WS_PROJ), 3072, 1024, 0.125f * LOG2E, (unsigned*)(GAS unsigned*)(F.ctl + CW_KMAX + jm * 256)};

REP(2) {
pg8::gemm_phase<pg8::EpiScaleBf16, pg8::StaticOrder, PG8_ALIGN, PG8_SP2>(F.lds, g, S, E);
}

                SEAM();
            }
            ++ph;
            if (RUN()) {
                KP(); float d1 = 0.f, d2 = 0.f;
                { const float* lq1 = IN_(3) + jm * 64; const float* lk1 = IN_(4) + jm * 64; const float* lq2 = IN_(5) + jm * 64; const float* lk2 = IN_(6) + jm * 64;
                  for (int i = 0; i < 64; ++i) { d1 += lq1[i] * lk1[i]; d2 += lq2[i] * lk2[i]; } }
                const float li = (layer == 0) ? 0.2f : 0.47071301834148437f;
                const float lam = __expf(d1) - __expf(d2) + li;

REP(3)
                {
                  const int l0 = (layer == 0) ? 0 : 2, nl = 2;
                  const ConvJob cj{IN_(12) + (size_t)l0 * NEXP * D * 2 * FF, (bf16*)WS_(WS_WGU) + (size_t)l0 * NEXP * D * 2 * FF, IN_(14) + (size_t)l0 * NEXP * FF * D, (bf16*)WS_(WS_WDN) + (size_t)l0 * NEXP * FF * D, (rep_ == 0) ? nl * NEXP : 0, 2};
                  da_attn_phase(F, (const bf16*)WS_(WS_PROJ), (bf16*)WS_(WS_AO), lam, 1.0f - li, IN_(7) + jm * 128, (const unsigned*)(GAS unsigned*)(F.ctl + CW_KMAX + jm * 256), F.ctl + CW_QCTR + jm * 64 + rep_ * 8, cj); }

                SEAM();
            }
            ++ph;
            if (RUN()) {
                KP(); pg8::Gemm g{(bf16*)WS_(WS_AO), (bf16*)WS_(WS_WDAOUT) + (size_t)jm * D * D, T, D, D}; pg8::StaticOrder S; S.init(T, D, F.G, (int)blockIdx.x);
                pg8::EpiRes E{(bf16*)WS_(WS_XB), (bf16*)WS_(WS_Y), D, DN_ALPHA, (float*)WS_(WS_STATS)};

REP(2) {
pg8::gemm_phase<pg8::EpiRes, pg8::StaticOrder, PG8_ALIGN, PG8_SP2>(F.lds, g, S, E);
}

                SEAM();
            }
            ++ph;
        } else {
            const float lg2[4] = {-0.045803689613124784f, -0.022720076500083584f, -0.011315313227834068f, -0.0056465631411835116f};
            if (RUN()) {
                KP(); pg8::Gemm g{(bf16*)WS_(WS_XB), (bf16*)WS_(WS_WRETIN) + (size_t)jm * 6144 * D, T, 6144, D}; pg8::StaticOrder S; S.init(T, 6144, F.G, (int)blockIdx.x);
                pg8::EpiRetProj E{(bf16*)WS_(WS_PROJ), 6144, {lg2[0], lg2[1], lg2[2], lg2[3]}};

REP(2) {
pg8::gemm_phase<pg8::EpiRetProj, pg8::StaticOrder, PG8_ALIGN, PG8_SP2>(F.lds, g, S, E);
}

                SEAM();
            }
            ++ph;
            if (RUN()) {
 KP(); REP(4) ret_scan_phase(F, (const bf16*)WS_(WS_PROJ), (bf16*)WS_(WS_STATE), lg2);
 SEAM(); }
            ++ph;
            if (RUN()) {
 KP(); REP(5) ret_main_phase(F, (const bf16*)WS_(WS_PROJ), (const bf16*)WS_(WS_STATE), (bf16*)WS_(WS_AO));
 SEAM(); }
            ++ph;
            if (RUN()) {
                KP(); pg8::Gemm g{(bf16*)WS_(WS_AO), (bf16*)WS_(WS_WRETOUT) + (size_t)jm * D * 2048, T, D, 2048}; pg8::StaticOrder S; S.init(T, D, F.G, (int)blockIdx.x);
                pg8::EpiRes E{(bf16*)WS_(WS_XB), (bf16*)WS_(WS_Y), D, DN_ALPHA, (float*)WS_(WS_STATS)};

REP(2) {
pg8::gemm_phase<pg8::EpiRes, pg8::StaticOrder, PG8_ALIGN, PG8_SP2>(F.lds, g, S, E);
}

                SEAM();
            }
            ++ph;
        }
        gu32* cnt = F.ctl + CW_CNT + layer * NEXP * 64;
        if (RUN()) {

            KP();
            ln_router_phase(F, (const bf16*)WS_(WS_Y), (const float*)WS_(WS_STATS), IN_(16) + layer * D, IN_(17) + layer * D, (const unsigned char*)WS_(WS_WIMG) + (size_t)layer * 131072, IN_(11) + layer * NEXP, (bf16*)WS_(WS_XB), (int2*)WS_(WS_SLOT), cnt);
            SEAM();
        }
        ++ph;
        if (RUN()) {
            KP(); build_tables(F, cnt);
            pg8::Gemm g{(bf16*)WS_(WS_XB), (bf16*)WS_(WS_WGU) + (size_t)layer * NEXP * 2048 * D, MT_MAX * 256, 2048, D};
            GroupedOrder S{(const LAS int*)(F.lds + TBL_OFF), 8, 4, F.G, (int)blockIdx.x};
            pg8::EpiSwiGLU E{(bf16*)WS_(WS_ACT), IN_(13) + (size_t)layer * NEXP * 2048};

REP(6) {
pg8::gemm_phase<pg8::EpiSwiGLU, GroupedOrder, PG8_ALIGN, PG8_SP2, true>(F.lds, g, S, E, (const int2*)WS_(WS_SLOT), F.lds + TBL_OFF + 4096);
}

            SEAM();
        }
        ++ph;
        if (RUN()) {
            KP(); build_tables(F, cnt);
            pg8::Gemm g{(bf16*)WS_(WS_ACT), (bf16*)WS_(WS_WDN) + (size_t)layer * NEXP * D * FF, MT_MAX * 256, D, FF};
            GroupedOrder S{(const LAS int*)(F.lds + TBL_OFF), 4, 8, F.G, (int)blockIdx.x};
            pg8::EpiDown E{(bf16*)WS_(WS_YE), IN_(15) + (size_t)layer * NEXP * D, (const int2*)WS_(WS_SLOT), T * TOPK};

REP(6) {
pg8::gemm_phase<pg8::EpiDown, GroupedOrder, PG8_ALIGN, PG8_SP2>(F.lds, g, S, E);
}

            SEAM();
        }
        ++ph;
        if (RUN()) { KP(); combine_ln_phase(F, (const bf16*)WS_(WS_YE), IN_(18) + layer * D, IN_(19) + layer * D, (layer == DEPTH - 1) ? OUT_() : (float*)nullptr, (bf16*)WS_(WS_XB)); SEAM(); }
        ++ph;
    }
#undef RUN
#undef SEAM
}

extern "C" void kernel_launch(void* const* d_in, const int* in_sizes, int n_in, void* d_out, int out_size, void* d_ws, size_t ws_size, hipStream_t stream) {
    static int grid = 0;
    if (grid == 0) {
        if (n_in != 20 || in_sizes[0] != T * D || out_size != T * D || ws_size < WS_END) { fprintf(stderr, "kernel_launch: unexpected shapes (n_in %d, in0 %d, out %d, ws %zu); nothing launched\n", n_in, n_in > 0 ? in_sizes[0] : -1, out_size, ws_size); grid = -1; return; }
        int dev = 0, cus = 0, per_cu = 0;
        if (hipGetDevice(&dev) != hipSuccess || hipDeviceGetAttribute(&cus, hipDeviceAttributeMultiprocessorCount, dev) != hipSuccess) { grid = -1; return; }
        if (hipFuncSetAttribute((const void*)mega_fwd, hipFuncAttributeMaxDynamicSharedMemorySize, LDS_BYTES) != hipSuccess) { fprintf(stderr, "kernel_launch: hipFuncSetAttribute failed\n"); grid = -1; return; }
        if (hipOccupancyMaxActiveBlocksPerMultiprocessor(&per_cu, (const void*)mega_fwd, NWAVES * 64, LDS_BYTES) != hipSuccess || per_cu < 1)
            fprintf(stderr, "kernel_launch: note: occupancy query reports %d workgroups per CU\n", per_cu);
        (void)hipGetLastError();
        grid = cus;
    }
    if (grid < 0) return;
    if (hipMemsetAsync((char*)d_ws + WS_CTL, 0, CTL_ZERO_BYTES, stream) != hipSuccess) return;
    Args a{};
    for (int i = 0; i < 20; ++i) a.in[i] = (const float*)d_in[i];
    a.out = (float*)d_out; a.ws = (unsigned char*)d_ws;
#if MK_N_LAUNCHES == 1
    a.ph_lo = 0; a.ph_hi = N_PHASES;
    hipLaunchKernelGGL(mega_fwd, dim3(grid), dim3(NWAVES * 64), LDS_BYTES, stream, a);
#else
    for (int p = 0; p < N_PHASES; ++p) { a.ph_lo = p; a.ph_hi = p + 1; hipLaunchKernelGGL(mega_fwd, dim3(grid), dim3(NWAVES * 64), LDS_BYTES, stream, a); }
#endif
    const hipError_t le = hipPeekAtLastError();
    if (le != hipSuccess) fprintf(stderr, "kernel_launch: launch failed: %s\n", hipGetErrorName(le));
}
```
